# Optimizing an MI355X kernel written in HIP

```python
import math
import jax
import jax.numpy as jnp
from jax import lax
import numpy as np

D_MODEL = 1024
BATCH = 2
SEQ = 8192
DEPTH = 2

GRID_W = 64
CTX_LEN = 256
HEAD_DIM = 64
GROUP_WIDTH = D_MODEL // 4
MIX_WIDTH = 4 * GROUP_WIDTH
S5_WIDTH = GROUP_WIDTH
S5_CH = 16
S5_GROUPS = S5_WIDTH // S5_CH
S5_STATE = 64
NA_HEADS = GROUP_WIDTH // HEAD_DIM
NA_KR = 8
NA_KC = 16
GQA_Q_HEADS = GROUP_WIDTH // HEAD_DIM
GQA_KV_HEADS = max(GQA_Q_HEADS // 2, 1)
GQA_GROUP = GQA_Q_HEADS // GQA_KV_HEADS
GQA_BLOCK = 128
LRU_WIDTH = GROUP_WIDTH
LRU_BLOCKS = GROUP_WIDTH // HEAD_DIM
LRU_BLOCK_DIM = LRU_WIDTH // LRU_BLOCKS
LRU_CONV = 4
LRU_C = 8.0
D_FF = ((8 * D_MODEL // 3 + 127) // 128) * 128
FFN_RES = 0.5
ROPE_BASE = 10000.0
EPS = 1e-6
N_MOD = 9
IN_SPLITS = (S5_WIDTH,
             NA_HEADS * HEAD_DIM, NA_HEADS * HEAD_DIM, NA_HEADS * HEAD_DIM,
             GQA_Q_HEADS * HEAD_DIM, GQA_KV_HEADS * HEAD_DIM, GQA_KV_HEADS * HEAD_DIM,
             LRU_WIDTH, LRU_WIDTH)
IN_COLS = sum(IN_SPLITS)

kernel_name = 'hybrid_s5_natten_gqa_rglru_macaron_dit'


def rms_norm(x, g):
    xf = x.astype(jnp.float32)
    y = xf * lax.rsqrt(jnp.mean(xf * xf, axis=-1, keepdims=True) + EPS)
    return (y * g.astype(jnp.float32)).astype(x.dtype)


def modulate(x, shift, scale):
    return x * (1 + scale) + shift


def ada_mods(s, w, b, dt):
    m = (s @ w.astype(jnp.float32) + b.astype(jnp.float32)).astype(dt)
    m = m.reshape(m.shape[0], N_MOD, D_MODEL)
    return [m[:, k, None, :] for k in range(N_MOD)]


def ffn_half(h, g, w_i, w_o, shift, scale, gate):
    y = modulate(rms_norm(h, g), shift, scale)
    a, b = jnp.split(y @ w_i, 2, axis=-1)
    return h + FFN_RES * gate * ((jax.nn.silu(a) * b) @ w_o)


def rope_1d(x, pos):
    half = x.shape[-1] // 2
    freqs = ROPE_BASE ** (-jnp.arange(half, dtype=jnp.float32) / half)
    ang = pos.astype(jnp.float32)[:, None] * freqs[None, :]
    cos = jnp.cos(ang)[None, :, None, :]
    sin = jnp.sin(ang)[None, :, None, :]
    xf = x.astype(jnp.float32)
    x1, x2 = xf[..., :half], xf[..., half:]
    return jnp.concatenate([x1 * cos - x2 * sin, x2 * cos + x1 * sin], axis=-1).astype(x.dtype)


def rope_2d(x, row, col):
    half = x.shape[-1] // 2
    return jnp.concatenate([rope_1d(x[..., :half], row), rope_1d(x[..., half:], col)], axis=-1)


def grouped_attn(q, k, v):
    s = jnp.einsum('bqhgd,bkhd->bhgqk', q, k).astype(jnp.float32)
    p = jax.nn.softmax(s, axis=-1).astype(v.dtype)
    return jnp.einsum('bhgqk,bkhd->bqhgd', p, v)


def _combine_real(left, right):
    a1, b1 = left
    a2, b2 = right
    return a1 * a2, a2 * b1 + b2


def _combine_complex(left, right):
    ar1, ai1, br1, bi1 = left
    ar2, ai2, br2, bi2 = right
    return (ar1 * ar2 - ai1 * ai2, ar1 * ai2 + ai1 * ar2,
            ar2 * br1 - ai2 * bi1 + br2, ar2 * bi1 + ai2 * br1 + bi2)


def real_scan(a, b, h0, reverse):
    if h0 is not None:
        end = -1 if reverse else 0
        b = b.at[:, end].add(a[:, end] * h0)
    _, h = lax.associative_scan(_combine_real, (a, b), reverse=reverse, axis=1)
    return h


def s5_discretize(lam_re, lam_im, log_step, b_re, b_im):
    f32 = jnp.float32
    lr, li = lam_re.astype(f32), lam_im.astype(f32)
    dt = jnp.exp(log_step.astype(f32))[:, None]
    mag = jnp.exp(lr * dt)
    ar, ai = mag * jnp.cos(li * dt), mag * jnp.sin(li * dt)
    den = lr * lr + li * li
    fr = ((ar - 1) * lr + ai * li) / den
    fi = (ai * lr - (ar - 1) * li) / den
    br, bi = b_re.astype(f32), b_im.astype(f32)
    bbr = fr[..., None] * br - fi[..., None] * bi
    bbi = fr[..., None] * bi + fi[..., None] * br
    return ar, ai, bbr, bbi


def s5_scan(u, ar, ai, bbr, bbi, h0, reverse):
    xr = jnp.einsum('btgh,gph->btgp', u, bbr)
    xi = jnp.einsum('btgh,gph->btgp', u, bbi)
    if h0 is not None:
        end = -1 if reverse else 0
        h0r, h0i = h0
        xr = xr.at[:, end].add(ar * h0r - ai * h0i)
        xi = xi.at[:, end].add(ar * h0i + ai * h0r)
    a_r = jnp.broadcast_to(ar, xr.shape)
    a_i = jnp.broadcast_to(ai, xr.shape)
    _, _, hr, hi = lax.associative_scan(_combine_complex, (a_r, a_i, xr, xi), reverse=reverse, axis=1)
    return hr, hi


def s5_readout(hr, hi, c_re, c_im):
    return (jnp.einsum('btgp,ghp->btgh', hr, c_re.astype(jnp.float32))
            - jnp.einsum('btgp,ghp->btgh', hi, c_im.astype(jnp.float32)))


def s5_mixer(u_c, u_l, lam_re, lam_im, log_step, b_re, b_im, c_re, c_im, d_skip, w_glu, need_ctx):
    def groups(u):
        return u.astype(jnp.float32).reshape(u.shape[0], u.shape[1], S5_GROUPS, S5_CH)

    def glu(y, dt):
        y = jax.nn.gelu(y.reshape(y.shape[0], y.shape[1], S5_WIDTH)).astype(dt)
        return y * jax.nn.sigmoid(y @ w_glu)

    d = d_skip.astype(jnp.float32).reshape(S5_GROUPS, S5_CH)
    uc, ul = groups(u_c), groups(u_l)
    y_l = d * ul
    y_c = d * uc if need_ctx else None
    for dr, reverse in ((0, False), (1, True)):
        ar, ai, bbr, bbi = s5_discretize(lam_re[dr], lam_im[dr], log_step[dr], b_re[dr], b_im[dr])
        hcr, hci = s5_scan(uc, ar, ai, bbr, bbi, None, reverse)
        end = 0 if reverse else -1
        hlr, hli = s5_scan(ul, ar, ai, bbr, bbi, (hcr[:, end], hci[:, end]), reverse)
        y_l = y_l + s5_readout(hlr, hli, c_re[dr], c_im[dr])
        if need_ctx:
            y_c = y_c + s5_readout(hcr, hci, c_re[dr], c_im[dr])
    return glu(y_l, u_l.dtype), (glu(y_c, u_c.dtype) if need_ctx else None)


def natten_mixer(q_c, k_c, v_c, q_l, k_l, v_l, rpb, need_ctx):
    B_, T, _ = q_l.shape
    rows = T // GRID_W
    kr = min(NA_KR, rows)
    nw = kr * NA_KC
    scale = HEAD_DIM ** -0.5

    def heads(t):
        return t.reshape(t.shape[0], t.shape[1], NA_HEADS, HEAD_DIM)

    qc, kc, vc = heads(q_c), heads(k_c), heads(v_c)
    qg = (heads(q_l) * scale).reshape(B_, rows, GRID_W, NA_HEADS, HEAD_DIM)
    kg = heads(k_l).reshape(B_, rows, GRID_W, NA_HEADS, HEAD_DIM)
    vg = heads(v_l).reshape(B_, rows, GRID_W, NA_HEADS, HEAD_DIM)
    col = jnp.arange(GRID_W)
    col_start = jnp.clip(col - NA_KC // 2, 0, GRID_W - NA_KC)
    col_idx = col_start[:, None] + jnp.arange(NA_KC)[None, :]
    col_off = col_idx - col[:, None] + (NA_KC - 1)
    rpb_f = rpb.astype(jnp.float32)

    def row_block(r):
        rs = jnp.clip(r - NA_KR // 2, 0, rows - kr)
        q_r = lax.dynamic_index_in_dim(qg, r, axis=1, keepdims=False)
        kb = lax.dynamic_slice_in_dim(kg, rs, kr, axis=1)[:, :, col_idx]
        vb = lax.dynamic_slice_in_dim(vg, rs, kr, axis=1)[:, :, col_idx]
        row_off = rs + jnp.arange(kr) - r + (NA_KR - 1)
        bias = rpb_f[:, row_off][:, :, col_off]
        s_win = (jnp.einsum('bwhd,brwkhd->bhwrk', q_r, kb).astype(jnp.float32)
                 + jnp.transpose(bias, (0, 2, 1, 3))[None])
        s_ctx = jnp.einsum('bwhd,bnhd->bhwn', q_r, kc).astype(jnp.float32)
        s = jnp.concatenate([s_win.reshape(B_, NA_HEADS, GRID_W, nw), s_ctx], axis=-1)
        p = jax.nn.softmax(s, axis=-1).astype(v_l.dtype)
        p_win = p[..., :nw].reshape(B_, NA_HEADS, GRID_W, kr, NA_KC)
        return (jnp.einsum('bhwrk,brwkhd->bwhd', p_win, vb)
                + jnp.einsum('bhwn,bnhd->bwhd', p[..., nw:], vc))

    o = lax.map(row_block, jnp.arange(rows))
    y_l = jnp.transpose(o, (1, 0, 2, 3, 4)).reshape(B_, T, NA_HEADS * HEAD_DIM)
    y_c = None
    if need_ctx:
        y_c = grouped_attn((qc * scale)[:, :, :, None, :], kc, vc).reshape(B_, qc.shape[1], NA_HEADS * HEAD_DIM)
    return y_l, y_c


def gqa_mixer(q_c, k_c, v_c, q_l, k_l, v_l, gq, gk, need_ctx):
    B_, T, _ = q_l.shape
    Tc = q_c.shape[1]
    scale = HEAD_DIM ** -0.5

    def prep(q, k, v):
        b, t, _ = q.shape
        q = rms_norm(q.reshape(b, t, GQA_Q_HEADS, HEAD_DIM), gq)
        k = rms_norm(k.reshape(b, t, GQA_KV_HEADS, HEAD_DIM), gk)
        return q, k, v.reshape(b, t, GQA_KV_HEADS, HEAD_DIM)

    qc, kc, vc = prep(q_c, k_c, v_c)
    ql, kl, vl = prep(q_l, k_l, v_l)
    t = jnp.arange(T)
    row, col = t // GRID_W, t % GRID_W
    ql = rope_2d(ql, row, col)
    kl = rope_2d(kl, row, col)
    k_all = jnp.concatenate([kc, kl], axis=1)
    v_all = jnp.concatenate([vc, vl], axis=1)
    nb = T // GQA_BLOCK
    qb = jnp.moveaxis((ql * scale).reshape(B_, nb, GQA_BLOCK, GQA_KV_HEADS, GQA_GROUP, HEAD_DIM), 1, 0)
    ob = lax.map(lambda qblk: grouped_attn(qblk, k_all, v_all), qb)
    y_l = jnp.moveaxis(ob, 0, 1).reshape(B_, T, GQA_Q_HEADS * HEAD_DIM)
    y_c = None
    if need_ctx:
        qcg = (qc * scale).reshape(B_, Tc, GQA_KV_HEADS, GQA_GROUP, HEAD_DIM)
        y_c = grouped_attn(qcg, kc, vc).reshape(B_, Tc, GQA_Q_HEADS * HEAD_DIM)
    return y_l, y_c


def centred_dwconv(x, w, b):
    cdim = x.shape[-1]
    y = lax.conv_general_dilated(
        x.astype(jnp.float32), w.astype(jnp.float32)[:, None, :], window_strides=(1,),
        padding=[(LRU_CONV // 2, LRU_CONV - 1 - LRU_CONV // 2)],
        dimension_numbers=('NWC', 'WIO', 'NWC'), feature_group_count=cdim)
    return y + b.astype(jnp.float32)


def rglru_coeffs(x, w_a, b_a, w_x, b_x, lam):
    f32 = jnp.float32
    B_, T, _ = x.shape
    xs = x.reshape(B_, T, LRU_BLOCKS, LRU_BLOCK_DIM)
    r = jax.nn.sigmoid(jnp.einsum('btnd,nde->btne', xs, w_a.astype(f32)).reshape(B_, T, LRU_WIDTH) + b_a.astype(f32))
    i = jax.nn.sigmoid(jnp.einsum('btnd,nde->btne', xs, w_x.astype(f32)).reshape(B_, T, LRU_WIDTH) + b_x.astype(f32))
    log_a = -LRU_C * r * jax.nn.softplus(-lam.astype(f32))
    return jnp.exp(log_a), jnp.sqrt(-jnp.expm1(2.0 * log_a)) * (i * x)


def rglru_mixer(x_c, g_c, x_l, g_l, conv_w, conv_b, w_a, b_a, w_x, b_x, lam, need_ctx):
    xc = centred_dwconv(x_c, conv_w, conv_b)
    xl = centred_dwconv(x_l, conv_w, conv_b)
    y_l = 0.0
    y_c = 0.0
    for dr, reverse in ((0, False), (1, True)):
        a_c, b_c = rglru_coeffs(xc, w_a[dr], b_a[dr], w_x[dr], b_x[dr], lam[dr])
        h_c = real_scan(a_c, b_c, None, reverse)
        a_l, b_l = rglru_coeffs(xl, w_a[dr], b_a[dr], w_x[dr], b_x[dr], lam[dr])
        h_l = real_scan(a_l, b_l, h_c[:, 0 if reverse else -1], reverse)
        y_l = y_l + h_l
        if need_ctx:
            y_c = y_c + h_c
    out_l = y_l.astype(x_l.dtype) * jax.nn.gelu(g_l)
    out_c = (y_c.astype(x_c.dtype) * jax.nn.gelu(g_c)) if need_ctx else None
    return out_l, out_c


def setup_inputs(seed: int = 0) -> dict:
    key = jax.random.key(seed)
    ks = iter(jax.random.split(key, 48))
    f32 = jnp.float32
    L, D = DEPTH, D_MODEL

    def nrm(shape, std):
        return std * jax.random.normal(next(ks), shape, f32)

    def gain(shape):
        return 1.0 + nrm(shape, 0.1)

    n = jnp.arange(S5_STATE, dtype=f32)
    a0 = jax.random.uniform(next(ks), (L, 2, LRU_WIDTH), f32, 0.9, 0.999)
    a_root = a0 ** (1.0 / LRU_C)
    lru_lambda = jnp.log(a_root) - jnp.log1p(-a_root)
    s5_log_step = jax.random.uniform(next(ks), (L, 2, S5_GROUPS), f32, math.log(1e-3), math.log(1e-1))
    return {
        'x': nrm((BATCH, SEQ, D), 1.0),
        'c': nrm((BATCH, D), 1.0),
        'ctx': nrm((BATCH, CTX_LEN, D), 1.0),
        'c_ctx': nrm((D,), 1.0),
        'w_ada': nrm((L, D, N_MOD * D), 0.5 * D ** -0.5),
        'b_ada': nrm((L, N_MOD * D), 0.02),
        'g_ffn1': gain((L, D)),
        'w_ffn1_in': nrm((L, D, 2 * D_FF), D ** -0.5),
        'w_ffn1_out': nrm((L, D_FF, D), D_FF ** -0.5),
        'g_mix': gain((L, D)),
        'w_in': nrm((L, D, IN_COLS), D ** -0.5),
        'w_out': nrm((L, MIX_WIDTH, D), MIX_WIDTH ** -0.5),
        's5_lambda_re': -0.5 + nrm((L, 2, S5_GROUPS, S5_STATE), 0.01),
        's5_lambda_im': math.pi * n + nrm((L, 2, S5_GROUPS, S5_STATE), 0.01),
        's5_log_step': s5_log_step,
        's5_b_re': nrm((L, 2, S5_GROUPS, S5_STATE, S5_CH), (2 * S5_CH) ** -0.5),
        's5_b_im': nrm((L, 2, S5_GROUPS, S5_STATE, S5_CH), (2 * S5_CH) ** -0.5),
        's5_c_re': nrm((L, 2, S5_GROUPS, S5_CH, S5_STATE), S5_STATE ** -0.5),
        's5_c_im': nrm((L, 2, S5_GROUPS, S5_CH, S5_STATE), S5_STATE ** -0.5),
        's5_d': nrm((L, S5_WIDTH), 0.5),
        's5_w_glu': nrm((L, S5_WIDTH, S5_WIDTH), S5_WIDTH ** -0.5),
        'na_rpb': nrm((L, NA_HEADS, 2 * NA_KR - 1, 2 * NA_KC - 1), 0.02),
        'gqa_q_norm': gain((L, HEAD_DIM)),
        'gqa_k_norm': gain((L, HEAD_DIM)),
        'lru_conv_w': nrm((L, LRU_CONV, LRU_WIDTH), LRU_CONV ** -0.5),
        'lru_conv_b': nrm((L, LRU_WIDTH), 0.02),
        'lru_w_a': nrm((L, 2, LRU_BLOCKS, LRU_BLOCK_DIM, LRU_BLOCK_DIM), LRU_BLOCK_DIM ** -0.5),
        'lru_b_a': nrm((L, 2, LRU_WIDTH), 0.02),
        'lru_w_x': nrm((L, 2, LRU_BLOCKS, LRU_BLOCK_DIM, LRU_BLOCK_DIM), LRU_BLOCK_DIM ** -0.5),
        'lru_b_x': nrm((L, 2, LRU_WIDTH), 0.02),
        'lru_lambda': lru_lambda,
        'g_ffn2': gain((L, D)),
        'w_ffn2_in': nrm((L, D, 2 * D_FF), D ** -0.5),
        'w_ffn2_out': nrm((L, D_FF, D), D_FF ** -0.5),
        'g_final': gain((D,)),
    }


def reference(x, c, ctx, c_ctx, w_ada, b_ada, g_ffn1, w_ffn1_in, w_ffn1_out, g_mix, w_in, w_out,
              s5_lambda_re, s5_lambda_im, s5_log_step, s5_b_re, s5_b_im, s5_c_re, s5_c_im, s5_d, s5_w_glu,
              na_rpb, gqa_q_norm, gqa_k_norm,
              lru_conv_w, lru_conv_b, lru_w_a, lru_b_a, lru_w_x, lru_b_x, lru_lambda,
              g_ffn2, w_ffn2_in, w_ffn2_out, g_final):
    dt = x.dtype
    split_at = [int(o) for o in np.cumsum(IN_SPLITS)[:-1]]
    s_lat = jax.nn.silu(c.astype(jnp.float32))
    s_ctx = jax.nn.silu(c_ctx.astype(jnp.float32))[None]
    h_lat, h_ctx = x, ctx
    for l in range(DEPTH):
        need_ctx = l < DEPTH - 1
        ml = ada_mods(s_lat, w_ada[l], b_ada[l], dt)
        mc = ada_mods(s_ctx, w_ada[l], b_ada[l], dt)
        h_lat = ffn_half(h_lat, g_ffn1[l], w_ffn1_in[l], w_ffn1_out[l], ml[0], ml[1], ml[2])
        h_ctx = ffn_half(h_ctx, g_ffn1[l], w_ffn1_in[l], w_ffn1_out[l], mc[0], mc[1], mc[2])
        p_l = jnp.split(modulate(rms_norm(h_lat, g_mix[l]), ml[3], ml[4]) @ w_in[l], split_at, axis=-1)
        p_c = jnp.split(modulate(rms_norm(h_ctx, g_mix[l]), mc[3], mc[4]) @ w_in[l], split_at, axis=-1)
        ya_l, ya_c = s5_mixer(p_c[0], p_l[0], s5_lambda_re[l], s5_lambda_im[l], s5_log_step[l],
                              s5_b_re[l], s5_b_im[l], s5_c_re[l], s5_c_im[l], s5_d[l], s5_w_glu[l], need_ctx)
        yb_l, yb_c = natten_mixer(p_c[1], p_c[2], p_c[3], p_l[1], p_l[2], p_l[3], na_rpb[l], need_ctx)
        yc_l, yc_c = gqa_mixer(p_c[4], p_c[5], p_c[6], p_l[4], p_l[5], p_l[6],
                               gqa_q_norm[l], gqa_k_norm[l], need_ctx)
        yd_l, yd_c = rglru_mixer(p_c[7], p_c[8], p_l[7], p_l[8], lru_conv_w[l], lru_conv_b[l],
                                 lru_w_a[l], lru_b_a[l], lru_w_x[l], lru_b_x[l], lru_lambda[l], need_ctx)
        h_lat = h_lat + ml[5] * (jnp.concatenate([ya_l, yb_l, yc_l, yd_l], axis=-1) @ w_out[l])
        h_lat = ffn_half(h_lat, g_ffn2[l], w_ffn2_in[l], w_ffn2_out[l], ml[6], ml[7], ml[8])
        if need_ctx:
            h_ctx = h_ctx + mc[5] * (jnp.concatenate([ya_c, yb_c, yc_c, yd_c], axis=-1) @ w_out[l])
            h_ctx = ffn_half(h_ctx, g_ffn2[l], w_ffn2_in[l], w_ffn2_out[l], mc[6], mc[7], mc[8])
    return rms_norm(h_lat, g_final)
```

```cpp
#ifndef HOST_EMU
#include <hip/hip_runtime.h>
#include <cstdio>
#include <cstdint>
#define LAS __attribute__((address_space(3)))
#define GAS __attribute__((address_space(1)))
#else
#define LAS
#define GAS
#endif
#ifdef HOST_EMU
#define WAVE_SYNC() emu_yield(EMU_WAVE)
#else
#define WAVE_SYNC() __builtin_amdgcn_wave_barrier()
#endif

#ifndef CFG_DM
#define CFG_DM 1024
#define CFG_T 8192
#define CFG_TC 256
#define CFG_GW 64
#endif
constexpr int DM = CFG_DM, NB = 2, T = CFG_T, TC = CFG_TC, GW = CFG_GW, NROWS = T / GW, NL = 2;
constexpr int GWD = DM / 4, NH = GWD / 64, NKV = (NH / 2 > 0) ? NH / 2 : 1, GQG = NH / NKV, S5G = GWD / 16;
constexpr int DFF = ((8 * DM / 3 + 127) / 128) * 128;
constexpr int INC = 7 * GWD + 2 * NKV * 64;
constexpr int MLAT = NB * T, MCTX = NB * TC, M = MLAT + MCTX;
constexpr int PC_S5 = 0, PC_NAQ = GWD, PC_NAK = 2 * GWD, PC_NAV = 3 * GWD, PC_GQ = 4 * GWD, PC_GK = 5 * GWD, PC_GV = 5 * GWD + NKV * 64, PC_LX = 5 * GWD + 2 * NKV * 64, PC_LG = PC_LX + GWD;
constexpr int NMOD = 9;
constexpr float EPS = 1e-6f;
constexpr int NT = 512, NWAVES = 8;
constexpr int LS5 = 64;
constexpr int NCH5 = (TC + T) / LS5;
constexpr int LL = 32;
constexpr int NCT = TC / LL, NLT = T / LL, NTL = NCT + NLT;
constexpr int ADA_KC = DM / 64;
static_assert(T % LS5 == 0 && TC % LS5 == 0 && T % LL == 0 && TC % LL == 0 && GWD % 64 == 0 && DM % 256 == 0, "shape");

enum { I_X = 0, I_C, I_CTX, I_CCTX, I_WADA, I_BADA, I_GFFN1, I_W1I, I_W1O, I_GMIX, I_WIN, I_WOUT, I_S5LRE, I_S5LIM, I_S5STEP, I_S5BRE, I_S5BIM, I_S5CRE, I_S5CIM,
       I_S5D, I_S5GLU, I_RPB, I_GQN, I_GKN, I_LCW, I_LCB, I_LWA, I_LBA, I_LWX, I_LBX, I_LLAM, I_GFFN2, I_W2I, I_W2O, I_GFINAL, N_IN };

typedef unsigned short bf16;
typedef float f32x4 __attribute__((ext_vector_type(4)));
typedef unsigned u32x4 __attribute__((ext_vector_type(4)));
typedef unsigned u32x2 __attribute__((ext_vector_type(2)));

constexpr size_t MiB = 1u << 20;
constexpr size_t al(size_t x) { return (x + 255) & ~(size_t)255; }
constexpr size_t WS_CTL = 0, CTL_ZERO_BYTES = 1 * MiB;
constexpr size_t WS_MODS = WS_CTL + CTL_ZERO_BYTES;
constexpr size_t WS_MODP = WS_MODS + al((size_t)NL * 3 * NMOD * DM * 4);
constexpr size_t WS_S5E = WS_MODP + al((size_t)ADA_KC * NL * 3 * NMOD * DM * 4);
constexpr size_t WS_LRUE = WS_S5E + al((size_t)NB * S5G * 2 * NCH5 * 64 * 2 * 4);
constexpr size_t WS_HCTX = WS_LRUE + al((size_t)NB * 2 * NTL * GWD * 2 * 4);
constexpr size_t W_1I = 0, W_1O = W_1I + (size_t)2 * DFF * DM * 2, W_IN = W_1O + (size_t)DM * DFF * 2, W_OUT = W_IN + (size_t)INC * DM * 2,
                 W_2I = W_OUT + (size_t)DM * DM * 2, W_2O = W_2I + (size_t)2 * DFF * DM * 2, W_GLU = W_2O + (size_t)DM * DFF * 2, W_LAYER = al(W_GLU + (size_t)GWD * GWD * 2);
constexpr size_t WS_W = WS_HCTX + al((size_t)MCTX * DM * 4);
constexpr size_t WS_XN = WS_W + NL * W_LAYER;
constexpr size_t WS_Y = WS_XN + al((size_t)M * DM * 2);
constexpr size_t WS_BIG = WS_Y + al((size_t)M * DM * 2);
constexpr size_t BIG_P = 0, BIG_QN = al((size_t)M * INC * 2), BIG_KN = BIG_QN + al((size_t)M * GWD * 2), BIG_END = BIG_KN + al((size_t)M * NKV * 64 * 2);
constexpr size_t BIG_BYTES = ((size_t)M * DFF * 2 > BIG_END) ? al((size_t)M * DFF * 2) : BIG_END;
constexpr size_t WS_END = WS_BIG + BIG_BYTES;
static_assert((size_t)2 * M * GWD * 4 <= (size_t)M * DM * 2, "YS5 overlay fits XN");
static_assert(CFG_DM != 1024 || WS_END <= 290 * MiB, "workspace budget");

constexpr int LDS_BYTES = 147456;
constexpr int LDS_MISC = 131072;

__device__ __forceinline__ unsigned f2bf(float f) { unsigned u = __builtin_bit_cast(unsigned, f); return (u + 0x7fffu + ((u >> 16) & 1u)) >> 16; }
__device__ __forceinline__ float bf2f(unsigned h) { return __builtin_bit_cast(float, h << 16); }
__device__ __forceinline__ unsigned pk2(float lo, float hi) { return f2bf(lo) | (f2bf(hi) << 16); }
__device__ __forceinline__ float bflo(unsigned w) { return __builtin_bit_cast(float, w << 16); }
__device__ __forceinline__ float bfhi(unsigned w) { return __builtin_bit_cast(float, w & 0xffff0000u); }
__device__ __forceinline__ float wave_sum(float v) {
#pragma unroll
    for (int o = 1; o < 64; o <<= 1) v += __shfl_xor(v, o);
    return v;
}
__device__ __forceinline__ float sigmoidf_(float x) { return 1.f / (1.f + expf(-x)); }
__device__ __forceinline__ float siluf_(float x) { return x / (1.f + expf(-x)); }
__device__ __forceinline__ float geluf_(float x) { const float u = 0.7978845608028654f * (x + 0.044715f * x * x * x); return 0.5f * x * (1.f + tanhf(u)); }
__device__ __forceinline__ float softplusf_(float x) { return x > 20.f ? x : log1pf(expf(x)); }
__device__ __forceinline__ void ld8bf(const bf16* p, float (&v)[8]) { const u32x4 w = *(const u32x4*)p; v[0] = bflo(w.x); v[1] = bfhi(w.x); v[2] = bflo(w.y); v[3] = bfhi(w.y); v[4] = bflo(w.z); v[5] = bfhi(w.z); v[6] = bflo(w.w); v[7] = bfhi(w.w); }
__device__ __forceinline__ void st8bf(bf16* p, const float (&v)[8]) { u32x4 w; w.x = pk2(v[0], v[1]); w.y = pk2(v[2], v[3]); w.z = pk2(v[4], v[5]); w.w = pk2(v[6], v[7]); *(u32x4*)p = w; }

struct Params { const float* in[N_IN]; float* out; unsigned char* ws; int ph_lo, ph_hi, pad0, pad1; };

struct Ctx {
    const Params* p; unsigned char* ws; LAS unsigned char* lds; int tid, lane, wave, G, bx, gw, NGW, gt, NGT;
    __device__ __forceinline__ const float* in(int i) const { return p->in[i]; }
    __device__ __forceinline__ float* hrow(int row) const { return row < MLAT ? p->out + (size_t)row * DM : (float*)(ws + WS_HCTX) + (size_t)(row - MLAT) * DM; }
    __device__ __forceinline__ const float* mods(int l, int which, int k) const { return (const float*)(ws + WS_MODS) + ((size_t)(l * 3 + which) * NMOD + k) * DM; }
    __device__ __forceinline__ bf16* wl(int l, size_t off) const { return (bf16*)(ws + WS_W + (size_t)l * W_LAYER + off); }
};
__device__ __forceinline__ int row_mi(int row) { return row < MLAT ? row / T : 2; }

__device__ __forceinline__ void ph_ada_partial(const Ctx& c) {
    constexpr int NJB = NMOD * DM / 256; const int nitems = NL * NJB * ADA_KC;
    const float* cc = c.in(I_C); const float* cctx = c.in(I_CCTX);
    for (int it = c.gw; it < nitems; it += c.NGW) {
        const int kc = it % ADA_KC, jb = (it / ADA_KC) % NJB, l = it / (ADA_KC * NJB);
        const float* w = c.in(I_WADA) + (size_t)l * DM * NMOD * DM + (size_t)(kc * 64) * NMOD * DM + jb * 256 + c.lane * 4;
        f32x4 a0 = {0, 0, 0, 0}, a1 = a0, a2 = a0;
#pragma unroll 8
        for (int k = 0; k < 64; ++k) { const f32x4 wv = *(const f32x4*)(w + (size_t)k * NMOD * DM); const int kk = kc * 64 + k;
            const float s0 = siluf_(cc[kk]), s1 = siluf_(cc[DM + kk]), s2 = siluf_(cctx[kk]); a0 += wv * s0; a1 += wv * s1; a2 += wv * s2; }
        float* mp = (float*)(c.ws + WS_MODP) + ((size_t)(kc * NL + l) * 3) * NMOD * DM + jb * 256 + c.lane * 4;
        *(f32x4*)(mp) = a0; *(f32x4*)(mp + NMOD * DM) = a1; *(f32x4*)(mp + 2 * NMOD * DM) = a2;
    }
}
__device__ __forceinline__ void ph_mods_reduce(const Ctx& c) {
    const int n = NL * 3 * NMOD * DM;
    for (int i = c.gt; i < n; i += c.NGT) { const int j = i % (NMOD * DM), l = i / (3 * NMOD * DM);
        float s = c.in(I_BADA)[(size_t)l * NMOD * DM + j];
#pragma unroll
        for (int kc = 0; kc < ADA_KC; ++kc) { const int lw = i / (NMOD * DM); s += ((const float*)(c.ws + WS_MODP))[((size_t)kc * NL * 3 + lw) * NMOD * DM + j]; }
        ((float*)(c.ws + WS_MODS))[i] = s; }
}
__device__ __forceinline__ void cvt_weight(const Ctx& c, const float* W, int K, int N, bf16* WT, int kind, int start, int& cursor) {
    const int nitems = N * (K / 8);
    (void)start;
    for (int it = c.gt; it < nitems; it += c.NGT) { const int n = it % N, k0 = (it / N) * 8; float v[8];
#pragma unroll
        for (int i = 0; i < 8; ++i) v[i] = W[(size_t)(k0 + i) * N + n];
        int r = n; if (kind == 1) { const int j = n < DFF ? n : n - DFF; r = (j / 128) * 256 + (n < DFF ? 0 : 128) + (j % 128); }
        st8bf(WT + (size_t)r * K + k0, v); }
    (void)cursor;
}
__device__ __forceinline__ void ph_cvt_all(const Ctx& c) {
    int cur = 0;
    for (int l = 0; l < NL; ++l) {
        cvt_weight(c, c.in(I_W1I) + (size_t)l * DM * 2 * DFF, DM, 2 * DFF, c.wl(l, W_1I), 1, 0, cur);
        cvt_weight(c, c.in(I_W1O) + (size_t)l * DFF * DM, DFF, DM, c.wl(l, W_1O), 0, 0, cur);
        cvt_weight(c, c.in(I_WIN) + (size_t)l * DM * INC, DM, INC, c.wl(l, W_IN), 0, 0, cur);
        cvt_weight(c, c.in(I_WOUT) + (size_t)l * DM * DM, DM, DM, c.wl(l, W_OUT), 0, 0, cur);
        cvt_weight(c, c.in(I_W2I) + (size_t)l * DM * 2 * DFF, DM, 2 * DFF, c.wl(l, W_2I), 1, 0, cur);
        cvt_weight(c, c.in(I_W2O) + (size_t)l * DFF * DM, DFF, DM, c.wl(l, W_2O), 0, 0, cur);
        cvt_weight(c, c.in(I_S5GLU) + (size_t)l * GWD * GWD, GWD, GWD, c.wl(l, W_GLU), 0, 0, cur);
    }
}
__device__ __forceinline__ void ph_h_init(const Ctx& c) {
    const size_t n4 = (size_t)M * DM / 4;
    for (size_t i = c.gt; i < n4; i += c.NGT) { const size_t e = i * 4; const int row = (int)(e / DM), col = (int)(e % DM);
        const f32x4 v = row < MLAT ? *(const f32x4*)(c.in(I_X) + e) : *(const f32x4*)(c.in(I_CTX) + (e - (size_t)MLAT * DM));
        *(f32x4*)(c.hrow(row) + col) = v; }
}

__device__ __forceinline__ void ph_norm_mod(const Ctx& c, int l, const float* g, int k_shift, int k_scale, int mrows) {
    constexpr int NV = DM / 256; bf16* XN = (bf16*)(c.ws + WS_XN);
    for (int row = c.gw; row < mrows; row += c.NGW) {
        const float* h = c.hrow(row); f32x4 v[NV]; float s = 0.f;
#pragma unroll
        for (int j = 0; j < NV; ++j) { v[j] = *(const f32x4*)(h + j * 256 + c.lane * 4); s += v[j].x * v[j].x + v[j].y * v[j].y + v[j].z * v[j].z + v[j].w * v[j].w; }
        const float rstd = 1.f / sqrtf(wave_sum(s) * (1.f / DM) + EPS);
        const int mi = row_mi(row); const float* sh = c.mods(l, mi, k_shift); const float* sc = c.mods(l, mi, k_scale);
#pragma unroll
        for (int j = 0; j < NV; ++j) { const int col = j * 256 + c.lane * 4; const f32x4 gv = *(const f32x4*)(g + col), shv = *(const f32x4*)(sh + col), scv = *(const f32x4*)(sc + col);
            const f32x4 y = v[j] * rstd * gv * (scv + 1.f) + shv; u32x2 w; w.x = pk2(y.x, y.y); w.y = pk2(y.z, y.w); *(u32x2*)(XN + (size_t)row * DM + col) = w; }
    }
}
__device__ __forceinline__ void ph_norm_final(const Ctx& c) {
    constexpr int NV = DM / 256; const float* g = c.in(I_GFINAL);
    for (int row = c.gw; row < MLAT; row += c.NGW) {
        float* h = c.p->out + (size_t)row * DM; f32x4 v[NV]; float s = 0.f;
#pragma unroll
        for (int j = 0; j < NV; ++j) { v[j] = *(const f32x4*)(h + j * 256 + c.lane * 4); s += v[j].x * v[j].x + v[j].y * v[j].y + v[j].z * v[j].z + v[j].w * v[j].w; }
        const float rstd = 1.f / sqrtf(wave_sum(s) * (1.f / DM) + EPS);
#pragma unroll
        for (int j = 0; j < NV; ++j) { const int col = j * 256 + c.lane * 4; *(f32x4*)(h + col) = v[j] * rstd * *(const f32x4*)(g + col); }
    }
}

struct EpiSwiglu { bf16* G;
    __device__ __forceinline__ void operator()(int row, int j0, const float (&a)[8], const float (&b)[8]) const { float o[8];
#pragma unroll
        for (int i = 0; i < 8; ++i) o[i] = siluf_(a[i]) * b[i];
        st8bf(G + (size_t)row * DFF + j0, o); } };
struct EpiResid { const Ctx* c; int l, k_gate; float scale;
    __device__ __forceinline__ void operator()(int row, int c0, const float (&v)[8]) const { float* h = c->hrow(row) + c0; const float* g = c->mods(l, row_mi(row), k_gate) + c0;
        f32x4 h0 = *(f32x4*)h, h1 = *(f32x4*)(h + 4); const f32x4 g0 = *(const f32x4*)g, g1 = *(const f32x4*)(g + 4);
        h0 += (f32x4){v[0], v[1], v[2], v[3]} * g0 * scale; h1 += (f32x4){v[4], v[5], v[6], v[7]} * g1 * scale; *(f32x4*)h = h0; *(f32x4*)(h + 4) = h1; } };
struct EpiP { bf16* P;
    __device__ __forceinline__ void operator()(int row, int c0, const float (&v)[8]) const { st8bf(P + (size_t)row * INC + c0, v); } };

template <class Epi> __device__ __forceinline__ void gemm_naive(const Ctx& c, const bf16* A, const bf16* Bt, int mrows, int N, int K, const Epi& E) {
    const int ncg = N / 8; const long nitems = (long)mrows * ncg;
    for (long it = c.gt; it < nitems; it += c.NGT) { const int row = (int)(it / ncg), c0 = (int)(it % ncg) * 8; float acc[8];
#pragma unroll
        for (int i = 0; i < 8; ++i) acc[i] = 0.f;
        const bf16* a = A + (size_t)row * K;
        for (int k = 0; k < K; k += 8) { float av[8]; ld8bf(a + k, av);
#pragma unroll
            for (int i = 0; i < 8; ++i) { float bv[8]; ld8bf(Bt + (size_t)(c0 + i) * K + k, bv);
#pragma unroll
                for (int j = 0; j < 8; ++j) acc[i] += av[j] * bv[j]; } }
        E(row, c0, acc); }
}
__device__ __forceinline__ void gemm_naive_swiglu(const Ctx& c, const bf16* A, const bf16* Bt, int mrows, int K, const EpiSwiglu& E) {
    const int ncg = DFF / 8; const long nitems = (long)mrows * ncg;
    for (long it = c.gt; it < nitems; it += c.NGT) { const int row = (int)(it / ncg), j0 = (int)(it % ncg) * 8; float aa[8], ab[8];
#pragma unroll
        for (int i = 0; i < 8; ++i) { aa[i] = 0.f; ab[i] = 0.f; }
        const bf16* a = A + (size_t)row * K; const int ra = (j0 / 128) * 256 + (j0 % 128);
        for (int k = 0; k < K; k += 8) { float av[8]; ld8bf(a + k, av);
#pragma unroll
            for (int i = 0; i < 8; ++i) { float bv[8]; ld8bf(Bt + (size_t)(ra + i) * K + k, bv);
#pragma unroll
                for (int j = 0; j < 8; ++j) aa[i] += av[j] * bv[j];
                ld8bf(Bt + (size_t)(ra + 128 + i) * K + k, bv);
#pragma unroll
                for (int j = 0; j < 8; ++j) ab[i] += av[j] * bv[j]; } }
        E(row, j0, aa, ab); }
}

struct S5Lane { float ar, ai, fr, fi; float bre[16], bim[16], cre[16], cim[16]; };
__device__ __forceinline__ void s5_load(const Ctx& c, int l, int dir, int g, int p, S5Lane& S) {
    const size_t gi = ((size_t)(l * 2 + dir) * S5G + g);
    const float lr = c.in(I_S5LRE)[gi * 64 + p], li = c.in(I_S5LIM)[gi * 64 + p], dt = expf(c.in(I_S5STEP)[gi]);
    const float th = li * dt, em1 = expm1f(lr * dt), cs = cosf(th), sn = sinf(th), sh = sinf(0.5f * th);
    const float arm1 = em1 * cs - 2.f * sh * sh;
    S.ar = 1.f + arm1; S.ai = (em1 + 1.f) * sn;
    const float den = lr * lr + li * li; S.fr = (arm1 * lr + S.ai * li) / den; S.fi = (S.ai * lr - arm1 * li) / den;
    const float* br = c.in(I_S5BRE) + (gi * 64 + p) * 16; const float* bi = c.in(I_S5BIM) + (gi * 64 + p) * 16;
#pragma unroll
    for (int h = 0; h < 16; ++h) { S.bre[h] = br[h]; S.bim[h] = bi[h]; S.cre[h] = c.in(I_S5CRE)[(gi * 16 + h) * 64 + p]; S.cim[h] = c.in(I_S5CIM)[(gi * 16 + h) * 64 + p]; }
}
__device__ __forceinline__ int s5_row(int b, int dir, int i) {
    if (i < TC) return MLAT + b * TC + (dir ? TC - 1 - i : i);
    const int t = i - TC; return b * T + (dir ? T - 1 - t : t);
}
__device__ __forceinline__ void s5_step(const S5Lane& S, const bf16* urow, float& sr, float& si) {
    float u[16]; { float t0[8], t1[8]; ld8bf(urow, t0); ld8bf(urow + 8, t1);
#pragma unroll
        for (int i = 0; i < 8; ++i) { u[i] = t0[i]; u[8 + i] = t1[i]; } }
    float wr = 0.f, wi = 0.f;
#pragma unroll
    for (int h = 0; h < 16; ++h) { wr += S.bre[h] * u[h]; wi += S.bim[h] * u[h]; }
    const float xr = S.fr * wr - S.fi * wi, xi = S.fr * wi + S.fi * wr;
    const float nr = S.ar * sr - S.ai * si + xr, ni = S.ar * si + S.ai * sr + xi; sr = nr; si = ni;
}
__device__ __forceinline__ void ph_s5_a(const Ctx& c, int l) {
    const bf16* P = (const bf16*)(c.ws + WS_BIG + BIG_P); float* E = (float*)(c.ws + WS_S5E);
    const int nitems = NB * S5G * 2 * (NCH5 - 1);
    for (int it = c.gw; it < nitems; it += c.NGW) { const int ch = it % (NCH5 - 1), dir = (it / (NCH5 - 1)) % 2, g = (it / (2 * (NCH5 - 1))) % S5G, b = it / (2 * (NCH5 - 1) * S5G);
        S5Lane S; s5_load(c, l, dir, g, c.lane, S); float sr = 0.f, si = 0.f;
        for (int i = ch * LS5; i < (ch + 1) * LS5; ++i) s5_step(S, P + (size_t)s5_row(b, dir, i) * INC + PC_S5 + g * 16, sr, si);
        float* e = E + ((((size_t)(b * S5G + g) * 2 + dir) * NCH5 + ch) * 64 + c.lane) * 2; e[0] = sr; e[1] = si; }
}
__device__ __forceinline__ void ph_s5_b(const Ctx& c, int l) {
    const bf16* P = (const bf16*)(c.ws + WS_BIG + BIG_P); const float* E = (const float*)(c.ws + WS_S5E); float* YS = (float*)(c.ws + WS_XN);
    const int nitems = NB * S5G * 2 * NCH5;
    for (int it = c.gw; it < nitems; it += c.NGW) { const int ch = it % NCH5, dir = (it / NCH5) % 2, g = (it / (2 * NCH5)) % S5G, b = it / (2 * NCH5 * S5G);
        S5Lane S; s5_load(c, l, dir, g, c.lane, S);
        float pr = S.ar, pi = S.ai;
#pragma unroll
        for (int s = 1; s < LS5; s <<= 1) { const float nr = pr * pr - pi * pi, ni = 2.f * pr * pi; pr = nr; pi = ni; }
        float sr = 0.f, si = 0.f; const float* e = E + ((((size_t)(b * S5G + g) * 2 + dir) * NCH5) * 64 + c.lane) * 2;
        for (int j = 0; j < ch; ++j) { const float er = e[(size_t)j * 128], ei = e[(size_t)j * 128 + 1]; const float nr = pr * sr - pi * si + er, ni = pr * si + pi * sr + ei; sr = nr; si = ni; }
        for (int i = ch * LS5; i < (ch + 1) * LS5; ++i) { const int row = s5_row(b, dir, i);
            s5_step(S, P + (size_t)row * INC + PC_S5 + g * 16, sr, si);
            float v[16];
#pragma unroll
            for (int h = 0; h < 16; ++h) v[h] = S.cre[h] * sr - S.cim[h] * si;
            float w8[8];
            { const bool hi = (c.lane & 32) != 0;
#pragma unroll
              for (int k = 0; k < 8; ++k) { const float send = hi ? v[k] : v[8 + k]; const float keep = hi ? v[8 + k] : v[k]; w8[k] = keep + __shfl_xor(send, 32); } }
            float w4[4];
            { const bool hi = (c.lane & 16) != 0;
#pragma unroll
              for (int k = 0; k < 4; ++k) { const float send = hi ? w8[k] : w8[4 + k]; const float keep = hi ? w8[4 + k] : w8[k]; w4[k] = keep + __shfl_xor(send, 16); } }
            float w2[2];
            { const bool hi = (c.lane & 8) != 0;
#pragma unroll
              for (int k = 0; k < 2; ++k) { const float send = hi ? w4[k] : w4[2 + k]; const float keep = hi ? w4[2 + k] : w4[k]; w2[k] = keep + __shfl_xor(send, 8); } }
            float w1;
            { const bool hi = (c.lane & 4) != 0; const float send = hi ? w2[0] : w2[1]; const float keep = hi ? w2[1] : w2[0]; w1 = keep + __shfl_xor(send, 4); }
            w1 += __shfl_xor(w1, 2); w1 += __shfl_xor(w1, 1);
            if ((c.lane & 3) == 0) YS[((size_t)dir * M + row) * GWD + g * 16 + (c.lane >> 2)] = w1;
        } }
}
__device__ __forceinline__ void ph_s5_glu(const Ctx& c, int l, int mrows) {
    constexpr int ZPL = GWD / 64; const bf16* P = (const bf16*)(c.ws + WS_BIG + BIG_P); const float* YS = (const float*)(c.ws + WS_XN); bf16* Y = (bf16*)(c.ws + WS_Y);
    LAS float* zs = (LAS float*)(c.lds) + c.wave * GWD; const bf16* Wt = c.wl(l, W_GLU); const float* d = c.in(I_S5D) + (size_t)l * GWD;
    for (int row = c.gw; row < mrows; row += c.NGW) { float z[ZPL];
#pragma unroll
        for (int i = 0; i < ZPL; ++i) { const int ch = c.lane * ZPL + i; const float u = bf2f(P[(size_t)row * INC + PC_S5 + ch]);
            z[i] = geluf_(d[ch] * u + YS[(size_t)row * GWD + ch] + YS[((size_t)M + row) * GWD + ch]); zs[ch] = z[i]; }
        WAVE_SYNC();
        float acc[ZPL];
#pragma unroll
        for (int i = 0; i < ZPL; ++i) acc[i] = 0.f;
        for (int k = 0; k < GWD; k += 8) { float zv[8];
#pragma unroll
            for (int j = 0; j < 8; ++j) zv[j] = zs[k + j];
#pragma unroll
            for (int i = 0; i < ZPL; ++i) { float wv[8]; ld8bf(Wt + (size_t)(c.lane * ZPL + i) * GWD + k, wv);
#pragma unroll
                for (int j = 0; j < 8; ++j) acc[i] += zv[j] * wv[j]; } }
#pragma unroll
        for (int i = 0; i < ZPL; ++i) Y[(size_t)row * DM + c.lane * ZPL + i] = (bf16)f2bf(z[i] * sigmoidf_(acc[i]));
        WAVE_SYNC();
    }
}

__device__ __forceinline__ int lru_tile_row0(int b, int tile) { return tile < NCT ? MLAT + b * TC + tile * LL : b * T + (tile - NCT) * LL; }
template <bool PASS_B> __device__ __forceinline__ void ph_lru(const Ctx& c, int l, bool need_ctx) {
    const bf16* P = (const bf16*)(c.ws + WS_BIG + BIG_P); float* E = (float*)(c.ws + WS_LRUE); bf16* Y = (bf16*)(c.ws + WS_Y);
    LAS float* XC = (LAS float*)c.lds;
    LAS float* HT = XC + LL * GWD;
    const int e = c.tid % GWD, dir = (c.tid / GWD) & 1; const bool active = c.tid < 2 * GWD;
    const int blk = e / 64, el = e % 64;
    float wa[64], wx[64];
    { const float* pa = c.in(I_LWA) + (((size_t)(l * 2 + dir) * NH + blk) * 64) * 64 + el; const float* px = c.in(I_LWX) + (((size_t)(l * 2 + dir) * NH + blk) * 64) * 64 + el;
#pragma unroll
      for (int d = 0; d < 64; ++d) { wa[d] = pa[d * 64]; wx[d] = px[d * 64]; } }
    const float ba = c.in(I_LBA)[(size_t)(l * 2 + dir) * GWD + e], bx = c.in(I_LBX)[(size_t)(l * 2 + dir) * GWD + e];
    const float sp = softplusf_(-c.in(I_LLAM)[(size_t)(l * 2 + dir) * GWD + e]);
    const int nitems = NB * NTL;
    for (int it = c.bx; it < nitems; it += c.G) { const int tile = it % NTL, b = it / NTL; const bool is_ctx = tile < NCT;
        const int row0 = lru_tile_row0(b, tile); const int t0 = (is_ctx ? tile : tile - NCT) * LL, tlen = is_ctx ? TC : T; const int seq0 = row0 - t0;
        __syncthreads();
        for (int i = c.tid; i < LL * GWD; i += NT) { const int t = i / GWD, ch = i % GWD; float s = c.in(I_LCB)[(size_t)l * GWD + ch];
#pragma unroll
            for (int k = 0; k < 4; ++k) { const int tt = t0 + t + k - 2; if (tt >= 0 && tt < tlen) s += c.in(I_LCW)[((size_t)l * 4 + k) * GWD + ch] * bf2f(P[(size_t)(seq0 + tt) * INC + PC_LX + ch]); }
            XC[i] = s; }
        __syncthreads();
        if (active) {
            float h = 0.f, pa = 1.f;
            if (PASS_B) {
                const float* eb = E + ((size_t)(b * 2 + dir) * NTL) * GWD * 2 + e * 2;
                if (dir == 0) { for (int j = 0; j < tile; ++j) h = eb[(size_t)j * GWD * 2] * h + eb[(size_t)j * GWD * 2 + 1]; }
                else { if (is_ctx) { for (int j = NCT - 1; j > tile; --j) h = eb[(size_t)j * GWD * 2] * h + eb[(size_t)j * GWD * 2 + 1]; }
                       else { for (int j = NCT - 1; j >= 0; --j) h = eb[(size_t)j * GWD * 2] * h + eb[(size_t)j * GWD * 2 + 1];
                              for (int j = NTL - 1; j > tile; --j) h = eb[(size_t)j * GWD * 2] * h + eb[(size_t)j * GWD * 2 + 1]; } }
            }
            for (int s = 0; s < LL; ++s) { const int t = dir ? LL - 1 - s : s; const LAS float* xr = XC + t * GWD + blk * 64;
                float r = ba, ig = bx;
#pragma unroll
                for (int d = 0; d < 64; ++d) { const float xv = xr[d]; r += xv * wa[d]; ig += xv * wx[d]; }
                r = sigmoidf_(r); ig = sigmoidf_(ig);
                const float la = -8.f * r * sp, a = expf(la), bb = sqrtf(-expm1f(2.f * la)) * (ig * xr[el]);
                h = a * h + bb; pa *= a;
                if (PASS_B) HT[(dir * LL + t) * GWD + e] = h; }
            if (!PASS_B) { float* eo = E + (((size_t)(b * 2 + dir) * NTL + tile) * GWD + e) * 2; eo[0] = pa; eo[1] = h; }
        }
        if (PASS_B) { __syncthreads();
            if (!is_ctx || need_ctx) for (int i = c.tid; i < LL * GWD; i += NT) { const int t = i / GWD, ch = i % GWD; const int row = row0 + t;
                const float gt = bf2f(P[(size_t)row * INC + PC_LG + ch]); Y[(size_t)row * DM + 3 * GWD + ch] = (bf16)f2bf((HT[t * GWD + ch] + HT[(LL + t) * GWD + ch]) * geluf_(gt)); } }
    }
}

__device__ __forceinline__ void ph_gqa_prep(const Ctx& c, int l) {
    const bf16* P = (const bf16*)(c.ws + WS_BIG + BIG_P); bf16* QN = (bf16*)(c.ws + WS_BIG + BIG_QN); bf16* KN = (bf16*)(c.ws + WS_BIG + BIG_KN);
    const float* gq = c.in(I_GQN) + l * 64; const float* gk = c.in(I_GKN) + l * 64;
    const int nitems = M * (NH + NKV);
    for (int it = c.gw; it < nitems; it += c.NGW) { const int hs = it % (NH + NKV), row = it / (NH + NKV); const bool isq = hs < NH; const int hh = isq ? hs : hs - NH;
        const float x = bf2f(P[(size_t)row * INC + (isq ? PC_GQ : PC_GK) + hh * 64 + c.lane]);
        const float rstd = 1.f / sqrtf(wave_sum(x * x) * (1.f / 64.f) + EPS);
        float y = x * rstd * (isq ? gq[c.lane] : gk[c.lane]);
        if (row < MLAT) {
            const int t = row % T; const float pos = (float)((c.lane < 32) ? t / GW : t % GW); const int i16 = c.lane & 15;
            const float freq = powf(10000.f, -(float)i16 / 16.f), ang = pos * freq, cs = cosf(ang), sn = sinf(ang);
            const float partner = __shfl_xor(y, 16); const bool second = (c.lane & 16) != 0;
            y = second ? (y * cs + partner * sn) : (y * cs - partner * sn);
        }
        if (isq) QN[(size_t)row * GWD + hh * 64 + c.lane] = (bf16)f2bf(y * 0.125f); else KN[(size_t)row * (NKV * 64) + hh * 64 + c.lane] = (bf16)f2bf(y);
    }
}

__device__ __forceinline__ void attn_key(const bf16* k, const bf16* v, float bias, const float (&q)[64], float& m, float& lsum, float (&o)[64]) {
    float s = bias;
#pragma unroll
    for (int d8 = 0; d8 < 8; ++d8) { float kv[8]; ld8bf(k + d8 * 8, kv);
#pragma unroll
        for (int j = 0; j < 8; ++j) s += q[d8 * 8 + j] * kv[j]; }
    const float mn = fmaxf(m, s), corr = expf(m - mn), pp = expf(s - mn); m = mn; lsum = lsum * corr + pp;
#pragma unroll
    for (int d8 = 0; d8 < 8; ++d8) { float vv[8]; ld8bf(v + d8 * 8, vv);
#pragma unroll
        for (int j = 0; j < 8; ++j) o[d8 * 8 + j] = o[d8 * 8 + j] * corr + pp * vv[j]; }
}
__device__ __forceinline__ void attn_store(bf16* dst, float lsum, const float (&o)[64]) {
    const float inv = 1.f / lsum;
#pragma unroll
    for (int d8 = 0; d8 < 8; ++d8) { float t[8];
#pragma unroll
        for (int j = 0; j < 8; ++j) t[j] = o[d8 * 8 + j] * inv;
        st8bf(dst + d8 * 8, t); }
}
__device__ __forceinline__ void ph_gqa_naive(const Ctx& c, bool need_ctx) {
    const bf16* P = (const bf16*)(c.ws + WS_BIG + BIG_P); const bf16* QN = (const bf16*)(c.ws + WS_BIG + BIG_QN); const bf16* KN = (const bf16*)(c.ws + WS_BIG + BIG_KN); bf16* Y = (bf16*)(c.ws + WS_Y);
    const int nq = need_ctx ? M : MLAT; const long nitems = (long)nq * NH;
    for (long it = c.gt; it < nitems; it += c.NGT) { const int h = (int)(it / nq), row = (int)(it % nq); const int kvh = h / GQG;
        const int b = row < MLAT ? row / T : (row - MLAT) / TC;
        float q[64], o[64]; float m = -1e30f, ls = 0.f;
#pragma unroll
        for (int d8 = 0; d8 < 8; ++d8) { float t[8]; ld8bf(QN + (size_t)row * GWD + h * 64 + d8 * 8, t);
#pragma unroll
            for (int j = 0; j < 8; ++j) { q[d8 * 8 + j] = t[j]; o[d8 * 8 + j] = 0.f; } }
        for (int n = 0; n < TC; ++n) { const int kr = MLAT + b * TC + n; attn_key(KN + (size_t)kr * (NKV * 64) + kvh * 64, P + (size_t)kr * INC + PC_GV + kvh * 64, 0.f, q, m, ls, o); }
        if (row < MLAT) for (int t = 0; t < T; ++t) { const int kr = b * T + t; attn_key(KN + (size_t)kr * (NKV * 64) + kvh * 64, P + (size_t)kr * INC + PC_GV + kvh * 64, 0.f, q, m, ls, o); }
        attn_store(Y + (size_t)row * DM + 2 * GWD + h * 64, ls, o); }
}
__device__ __forceinline__ void ph_na_naive(const Ctx& c, int l, bool need_ctx) {
    const bf16* P = (const bf16*)(c.ws + WS_BIG + BIG_P); bf16* Y = (bf16*)(c.ws + WS_Y); const float* rpb = c.in(I_RPB) + (size_t)l * NH * 15 * 31;
    constexpr int KR = NROWS < 8 ? NROWS : 8;
    const int nq = need_ctx ? M : MLAT; const long nitems = (long)nq * NH;
    for (long it = c.gt; it < nitems; it += c.NGT) { const int h = (int)(it / nq), row = (int)(it % nq);
        const int b = row < MLAT ? row / T : (row - MLAT) / TC;
        float q[64], o[64]; float m = -1e30f, ls = 0.f;
#pragma unroll
        for (int d8 = 0; d8 < 8; ++d8) { float t[8]; ld8bf(P + (size_t)row * INC + PC_NAQ + h * 64 + d8 * 8, t);
#pragma unroll
            for (int j = 0; j < 8; ++j) { q[d8 * 8 + j] = t[j] * 0.125f; o[d8 * 8 + j] = 0.f; } }
        if (row < MLAT) { const int t = row % T, r = t / GW, cc = t % GW;
            int rs = r - 4; rs = rs < 0 ? 0 : (rs > NROWS - KR ? NROWS - KR : rs); int cs = cc - 8; cs = cs < 0 ? 0 : (cs > GW - 16 ? GW - 16 : cs);
            for (int i = 0; i < KR; ++i) for (int j = 0; j < 16; ++j) { const int kr = b * T + (rs + i) * GW + cs + j; const float bias = rpb[((size_t)h * 15 + (rs + i - r + 7)) * 31 + (cs + j - cc + 15)];
                attn_key(P + (size_t)kr * INC + PC_NAK + h * 64, P + (size_t)kr * INC + PC_NAV + h * 64, bias, q, m, ls, o); } }
        for (int n = 0; n < TC; ++n) { const int kr = MLAT + b * TC + n; attn_key(P + (size_t)kr * INC + PC_NAK + h * 64, P + (size_t)kr * INC + PC_NAV + h * 64, 0.f, q, m, ls, o); }
        attn_store(Y + (size_t)row * DM + GWD + h * 64, ls, o); }
}

constexpr int PH_INIT = 0, PH_MODS = 1, PH_L0 = 2, NPL = 12, PH_FINAL = PH_L0 + NL * NPL, N_PHASES = PH_FINAL + 1;
template <int ph> __device__ __forceinline__ void run_phase(const Ctx& c) {
    if (ph == PH_INIT) { ph_ada_partial(c); ph_cvt_all(c); ph_h_init(c); return; }
    if (ph == PH_MODS) { ph_mods_reduce(c); return; }
    if (ph == PH_FINAL) { ph_norm_final(c); return; }
    constexpr int l = (ph - PH_L0) / NPL, s = (ph - PH_L0) % NPL; constexpr bool need_ctx = l < NL - 1; constexpr int mrows2 = need_ctx ? M : MLAT;
    bf16* XN = (bf16*)(c.ws + WS_XN); bf16* G = (bf16*)(c.ws + WS_BIG); bf16* Pb = (bf16*)(c.ws + WS_BIG + BIG_P); bf16* Y = (bf16*)(c.ws + WS_Y);
    switch (s) {
    case 0: ph_norm_mod(c, l, c.in(I_GFFN1) + (size_t)l * DM, 0, 1, M); break;
    case 1: { EpiSwiglu E{G}; gemm_naive_swiglu(c, XN, c.wl(l, W_1I), M, DM, E); } break;
    case 2: { EpiResid E{&c, l, 2, 0.5f}; gemm_naive(c, G, c.wl(l, W_1O), M, DM, DFF, E); } break;
    case 3: ph_norm_mod(c, l, c.in(I_GMIX) + (size_t)l * DM, 3, 4, M); break;
    case 4: { EpiP E{Pb}; gemm_naive(c, XN, c.wl(l, W_IN), M, INC, DM, E); } break;
    case 5: ph_s5_a(c, l); ph_lru<false>(c, l, need_ctx); ph_gqa_prep(c, l); break;
    case 6: ph_s5_b(c, l); ph_lru<true>(c, l, need_ctx); ph_na_naive(c, l, need_ctx); ph_gqa_naive(c, need_ctx); break;
    case 7: ph_s5_glu(c, l, mrows2); break;
    case 8: { EpiResid E{&c, l, 5, 1.0f}; gemm_naive(c, Y, c.wl(l, W_OUT), mrows2, DM, DM, E); } break;
    case 9: ph_norm_mod(c, l, c.in(I_GFFN2) + (size_t)l * DM, 6, 7, mrows2); break;
    case 10: { EpiSwiglu E{G}; gemm_naive_swiglu(c, XN, c.wl(l, W_2I), mrows2, DM, E); } break;
    case 11: { EpiResid E{&c, l, 8, 0.5f}; gemm_naive(c, G, c.wl(l, W_2O), mrows2, DM, DFF, E); } break;
    }
}

#ifndef HOST_EMU
#define XB_TMO      128
#define XB_XCNT(j)  (256  + 64 * (j))
#define XB_XSUB(j)  (1280 + 64 * (j))
#define XB_XGEN(j)  (2304 + 64 * (j))
#define XB_TOP      3328
#define XB_TOPGEN   3392
#define XCD_BAR_WORDS 3456
#define XB_SPIN_CAP (1u << 22)
__device__ __forceinline__ unsigned xb_ld(unsigned* p)              { return __hip_atomic_load(p, __ATOMIC_RELAXED, __HIP_MEMORY_SCOPE_AGENT); }
__device__ __forceinline__ unsigned xb_add(unsigned* p, unsigned v) { return __hip_atomic_fetch_add(p, v, __ATOMIC_RELAXED, __HIP_MEMORY_SCOPE_AGENT); }
__device__ __forceinline__ unsigned xb_xcc_id() { return (unsigned)__builtin_amdgcn_s_getreg((3 << 11) | 20) & 0xFu; }
#define XB_SPIN(cond, bar) do { unsigned _sp = 0; while (cond) { __builtin_amdgcn_s_sleep(1); \
    if ((++_sp & 255u) == 0u) { if (xb_ld(&(bar)[XB_TMO])) break; if (_sp > XB_SPIN_CAP) { atomicAdd(&(bar)[XB_TMO], 1u); break; } } } } while (0)
struct XcdBarrier { unsigned* bar; unsigned x; volatile LAS unsigned* st; };
__device__ __forceinline__ XcdBarrier xcd_barrier_post(unsigned* bar, volatile LAS unsigned* st) {
    XcdBarrier b; b.bar = bar; b.x = xb_xcc_id(); b.st = st;
    if (threadIdx.x == 0) (void)xb_add(&bar[XB_XCNT(b.x)], 1u);
    return b;
}
__device__ __forceinline__ void xcd_barrier_complete(unsigned* bar, unsigned x, unsigned& nloc, unsigned& nx) {
    const unsigned G = gridDim.x * gridDim.y * gridDim.z;
    unsigned sum, cnt, mine, sp = 0u;
    for (;;) {
        sum = 0u; cnt = 0u; mine = 0u;
#pragma unroll
        for (unsigned j = 0; j < 16; ++j) { const unsigned cj = xb_ld(&bar[XB_XCNT(j)]); sum += cj; cnt += (cj > 0u) ? 1u : 0u; mine = (j == x) ? cj : mine; }
        if (sum == G) break;
        __builtin_amdgcn_s_sleep(1);
        if ((++sp & 255u) == 0u) { if (xb_ld(&bar[XB_TMO])) break; if (sp > XB_SPIN_CAP) { atomicAdd(&bar[XB_TMO], 1u); break; } }
    }
    nloc = mine > 0u ? mine : 1u; nx = cnt > 0u ? cnt : 1u;
}
__device__ __forceinline__ void xcd_barrier(const XcdBarrier& b) {
    asm volatile("s_waitcnt vmcnt(0)" ::: "memory");
    __syncthreads();
    if (threadIdx.x == 0) {
        unsigned* bar = b.bar;
        __builtin_amdgcn_s_waitcnt(0);
        unsigned nloc = b.st[0], nx = b.st[1];
        if (nloc == 0u) { xcd_barrier_complete(bar, b.x, nloc, nx); b.st[0] = nloc; b.st[1] = nx; }
        const unsigned old = xb_add(&bar[XB_XSUB(b.x)], 1u);
        const unsigned gen = old / nloc;
        if (old + 1u == (gen + 1u) * nloc) {
            __builtin_amdgcn_fence(__ATOMIC_RELEASE, "agent");
            asm volatile("s_waitcnt vmcnt(0)" ::: "memory");
            const unsigned og = xb_add(&bar[XB_TOP], 1u);
            const unsigned tg = og / nx;
            if (og + 1u == (tg + 1u) * nx) xb_add(&bar[XB_TOPGEN], 1u);
            else XB_SPIN(xb_ld(&bar[XB_TOPGEN]) == tg, bar);
            __builtin_amdgcn_fence(__ATOMIC_ACQUIRE, "agent");
            xb_add(&bar[XB_XGEN(b.x)], 1u);
            asm volatile("s_waitcnt vmcnt(0)" ::: "memory");
        } else {
            XB_SPIN(xb_ld(&bar[XB_XGEN(b.x)]) == gen, bar);
            __builtin_amdgcn_fence(__ATOMIC_ACQUIRE, "agent");
            asm volatile("s_waitcnt vmcnt(0)" ::: "memory");
        }
    }
    __syncthreads();
}
#endif

#ifdef HOST_EMU
template <int PH> __device__ __forceinline__ void phases_from(const Ctx& c, int lo, int hi) {
    if constexpr (PH < N_PHASES) { if (lo <= PH && PH < hi) run_phase<PH>(c); phases_from<PH + 1>(c, lo, hi); }
}
#else
template <int PH> __device__ __forceinline__ void phases_from(const Ctx& c, int lo, int hi, const XcdBarrier& bar) {
    if constexpr (PH < N_PHASES) { if (lo <= PH && PH < hi) { run_phase<PH>(c); if (PH + 1 < hi) xcd_barrier(bar); } phases_from<PH + 1>(c, lo, hi, bar); }
}
#endif
#ifdef HOST_EMU
static void mega_body(const Params& prm) {
    unsigned char* lds_raw = emu_lds();
#else
__global__ void __launch_bounds__(NT, 2) mega_kernel(Params prm) {
    extern __shared__ __attribute__((aligned(16))) unsigned char lds_raw[];
#endif
    Ctx c; c.p = &prm; c.ws = prm.ws; c.lds = (LAS unsigned char*)lds_raw;
    c.tid = threadIdx.x; c.lane = c.tid & 63; c.wave = __builtin_amdgcn_readfirstlane(c.tid >> 6);
    c.G = gridDim.x; c.bx = blockIdx.x; c.gw = c.bx * NWAVES + c.wave; c.NGW = c.G * NWAVES; c.gt = c.bx * NT + c.tid; c.NGT = c.G * NT;
#ifndef HOST_EMU
    volatile LAS unsigned* misc = (volatile LAS unsigned*)(c.lds + LDS_MISC);
    if (c.tid < 16) misc[c.tid] = 0u;
    __syncthreads();
    XcdBarrier bar; bar.bar = (unsigned*)(c.ws + WS_CTL) + 4096; bar.x = 0; bar.st = nullptr;
    const bool multi = prm.ph_hi - prm.ph_lo > 1;
    if (multi) bar = xcd_barrier_post((unsigned*)(c.ws + WS_CTL) + 4096, misc + 8);
#endif
    phases_from<0>(c, prm.ph_lo, prm.ph_hi
#ifndef HOST_EMU
        , bar
#endif
        );
}

#ifndef HOST_EMU
#ifndef MK_PER_PHASE
#define MK_PER_PHASE 1
#endif
extern "C" void kernel_launch(void* const* d_in, const int* in_sizes, int n_in, void* d_out, int out_size, void* d_ws, size_t ws_size, hipStream_t stream) {
    static int grid = 0;
    if (grid == 0) {
        if (n_in != N_IN || out_size != MLAT * DM || ws_size < WS_END) { fprintf(stderr, "kernel_launch: unexpected shapes (n_in %d out %d ws %zu need %zu)\n", n_in, out_size, ws_size, (size_t)WS_END); grid = -1; return; }
        int dev = 0, cus = 0, per_cu = 0;
        if (hipGetDevice(&dev) != hipSuccess || hipDeviceGetAttribute(&cus, hipDeviceAttributeMultiprocessorCount, dev) != hipSuccess) { grid = -1; return; }
        if (hipFuncSetAttribute((const void*)mega_kernel, hipFuncAttributeMaxDynamicSharedMemorySize, LDS_BYTES) != hipSuccess) { fprintf(stderr, "kernel_launch: hipFuncSetAttribute failed\n"); grid = -1; return; }
        if (hipOccupancyMaxActiveBlocksPerMultiprocessor(&per_cu, (const void*)mega_kernel, NT, LDS_BYTES) != hipSuccess || per_cu < 1) fprintf(stderr, "kernel_launch: occupancy query says %d\n", per_cu);
        (void)hipGetLastError();
        grid = cus;
    }
    if (grid < 0) return;
    (void)hipMemsetAsync((char*)d_ws + WS_CTL, 0, CTL_ZERO_BYTES, stream);
    Params p{};
    for (int i = 0; i < N_IN; ++i) p.in[i] = (const float*)d_in[i];
    p.out = (float*)d_out; p.ws = (unsigned char*)d_ws;
#if MK_PER_PHASE
    for (int ph = 0; ph < N_PHASES; ++ph) { p.ph_lo = ph; p.ph_hi = ph + 1; hipLaunchKernelGGL(mega_kernel, dim3(grid), dim3(NT), LDS_BYTES, stream, p); }
#else
    p.ph_lo = 0; p.ph_hi = N_PHASES; hipLaunchKernelGGL(mega_kernel, dim3(grid), dim3(NT), LDS_BYTES, stream, p);
#endif
}
#endif
```

```cpp
#ifndef HOST_EMU
#include <hip/hip_runtime.h>
#include <cstdio>
#include <cstdint>
#define LAS __attribute__((address_space(3)))
#define GAS __attribute__((address_space(1)))
#else
#define LAS
#define GAS
#endif
#ifdef HOST_EMU
#define WAVE_SYNC() emu_yield(EMU_WAVE)
#else
#define WAVE_SYNC() __builtin_amdgcn_wave_barrier()
#endif

#ifndef CFG_DM
#define CFG_DM 1024
#define CFG_T 8192
#define CFG_TC 256
#define CFG_GW 64
#endif
constexpr int DM = CFG_DM, NB = 2, T = CFG_T, TC = CFG_TC, GW = CFG_GW, NROWS = T / GW, NL = 2;
constexpr int GWD = DM / 4, NH = GWD / 64, NKV = (NH / 2 > 0) ? NH / 2 : 1, GQG = NH / NKV, S5G = GWD / 16;
constexpr int DFF = ((8 * DM / 3 + 127) / 128) * 128;
constexpr int INC = 7 * GWD + 2 * NKV * 64;
constexpr int MLAT = NB * T, MCTX = NB * TC, M = MLAT + MCTX;
constexpr int PC_S5 = 0, PC_NAQ = GWD, PC_NAK = 2 * GWD, PC_NAV = 3 * GWD, PC_GQ = 4 * GWD, PC_GK = 5 * GWD, PC_GV = 5 * GWD + NKV * 64, PC_LX = 5 * GWD + 2 * NKV * 64, PC_LG = PC_LX + GWD;
constexpr int NMOD = 9;
constexpr float EPS = 1e-6f;
constexpr int NT = 512, NWAVES = 8;
constexpr int LS5 = 64;
constexpr int NCH5 = (TC + T) / LS5;
constexpr int LL = 32;
constexpr int NCT = TC / LL, NLT = T / LL, NTL = NCT + NLT;
constexpr int ADA_KC = DM / 64;
static_assert(T % LS5 == 0 && TC % LS5 == 0 && T % LL == 0 && TC % LL == 0 && GWD % 64 == 0 && DM % 256 == 0, "shape");

enum { I_X = 0, I_C, I_CTX, I_CCTX, I_WADA, I_BADA, I_GFFN1, I_W1I, I_W1O, I_GMIX, I_WIN, I_WOUT, I_S5LRE, I_S5LIM, I_S5STEP, I_S5BRE, I_S5BIM, I_S5CRE, I_S5CIM,
       I_S5D, I_S5GLU, I_RPB, I_GQN, I_GKN, I_LCW, I_LCB, I_LWA, I_LBA, I_LWX, I_LBX, I_LLAM, I_GFFN2, I_W2I, I_W2O, I_GFINAL, N_IN };

typedef unsigned short bf16;
typedef float f32x4 __attribute__((ext_vector_type(4)));
typedef unsigned u32x4 __attribute__((ext_vector_type(4)));
typedef unsigned u32x2 __attribute__((ext_vector_type(2)));

constexpr size_t MiB = 1u << 20;
constexpr size_t al(size_t x) { return (x + 255) & ~(size_t)255; }
constexpr size_t WS_CTL = 0, CTL_ZERO_BYTES = 1 * MiB;
constexpr size_t WS_MODS = WS_CTL + CTL_ZERO_BYTES;
constexpr size_t WS_MODP = WS_MODS + al((size_t)NL * 3 * NMOD * DM * 4);
constexpr size_t WS_S5E = WS_MODP + al((size_t)ADA_KC * NL * 3 * NMOD * DM * 4);
constexpr size_t WS_LRUE = WS_S5E + al((size_t)NB * S5G * 2 * NCH5 * 64 * 2 * 4);
constexpr size_t WS_HCTX = WS_LRUE + al((size_t)NB * 2 * NTL * GWD * 2 * 4);
constexpr size_t W_1I = 0, W_1O = W_1I + (size_t)2 * DFF * DM * 2, W_IN = W_1O + (size_t)DM * DFF * 2, W_OUT = W_IN + (size_t)INC * DM * 2,
                 W_2I = W_OUT + (size_t)DM * DM * 2, W_2O = W_2I + (size_t)2 * DFF * DM * 2, W_GLU = W_2O + (size_t)DM * DFF * 2, W_LAYER = al(W_GLU + (size_t)GWD * GWD * 2);
constexpr size_t WS_W = WS_HCTX + al((size_t)MCTX * DM * 4);
constexpr size_t WS_XN = WS_W + NL * W_LAYER;
constexpr size_t WS_Y = WS_XN + al((size_t)M * DM * 2);
constexpr size_t WS_BIG = WS_Y + al((size_t)M * DM * 2);
constexpr size_t BIG_P = 0, BIG_QN = al((size_t)M * INC * 2), BIG_KN = BIG_QN + al((size_t)M * GWD * 2), BIG_END = BIG_KN + al((size_t)M * NKV * 64 * 2);
constexpr size_t BIG_BYTES = ((size_t)M * DFF * 2 > BIG_END) ? al((size_t)M * DFF * 2) : BIG_END;
constexpr size_t WS_END = WS_BIG + BIG_BYTES;
static_assert((size_t)2 * M * GWD * 4 <= (size_t)M * DM * 2, "YS5 overlay fits XN");
static_assert(CFG_DM != 1024 || WS_END <= 290 * MiB, "workspace budget");

constexpr int LDS_BYTES = 147456;
constexpr int LDS_MISC = 131072;

__device__ __forceinline__ unsigned f2bf(float f) { unsigned u = __builtin_bit_cast(unsigned, f); return (u + 0x7fffu + ((u >> 16) & 1u)) >> 16; }
__device__ __forceinline__ float bf2f(unsigned h) { return __builtin_bit_cast(float, h << 16); }
__device__ __forceinline__ unsigned pk2(float lo, float hi) { return f2bf(lo) | (f2bf(hi) << 16); }
__device__ __forceinline__ float bflo(unsigned w) { return __builtin_bit_cast(float, w << 16); }
__device__ __forceinline__ float bfhi(unsigned w) { return __builtin_bit_cast(float, w & 0xffff0000u); }
__device__ __forceinline__ float wave_sum(float v) {
#pragma unroll
    for (int o = 1; o < 64; o <<= 1) v += __shfl_xor(v, o);
    return v;
}
__device__ __forceinline__ float sigmoidf_(float x) { return 1.f / (1.f + expf(-x)); }
__device__ __forceinline__ float siluf_(float x) { return x / (1.f + expf(-x)); }
__device__ __forceinline__ float geluf_(float x) { const float u = 0.7978845608028654f * (x + 0.044715f * x * x * x); return 0.5f * x * (1.f + tanhf(u)); }
__device__ __forceinline__ float softplusf_(float x) { return x > 20.f ? x : log1pf(expf(x)); }
__device__ __forceinline__ void ld8bf(const bf16* p, float (&v)[8]) { const u32x4 w = *(const u32x4*)p; v[0] = bflo(w.x); v[1] = bfhi(w.x); v[2] = bflo(w.y); v[3] = bfhi(w.y); v[4] = bflo(w.z); v[5] = bfhi(w.z); v[6] = bflo(w.w); v[7] = bfhi(w.w); }
__device__ __forceinline__ void st8bf(bf16* p, const float (&v)[8]) { u32x4 w; w.x = pk2(v[0], v[1]); w.y = pk2(v[2], v[3]); w.z = pk2(v[4], v[5]); w.w = pk2(v[6], v[7]); *(u32x4*)p = w; }

struct Params { const float* in[N_IN]; float* out; unsigned char* ws; int ph_lo, ph_hi, pad0, pad1; };

struct Ctx {
    const Params* p; unsigned char* ws; LAS unsigned char* lds; int tid, lane, wave, G, bx, gw, NGW, gt, NGT;
    __device__ __forceinline__ const float* in(int i) const { return p->in[i]; }
    __device__ __forceinline__ float* hrow(int row) const { return row < MLAT ? p->out + (size_t)row * DM : (float*)(ws + WS_HCTX) + (size_t)(row - MLAT) * DM; }
    __device__ __forceinline__ const float* mods(int l, int which, int k) const { return (const float*)(ws + WS_MODS) + ((size_t)(l * 3 + which) * NMOD + k) * DM; }
    __device__ __forceinline__ bf16* wl(int l, size_t off) const { return (bf16*)(ws + WS_W + (size_t)l * W_LAYER + off); }
};
__device__ __forceinline__ int row_mi(int row) { return row < MLAT ? row / T : 2; }

__device__ __forceinline__ void ph_ada_partial(const Ctx& c) {
    constexpr int NJB = NMOD * DM / 256; const int nitems = NL * NJB * ADA_KC;
    const float* cc = c.in(I_C); const float* cctx = c.in(I_CCTX);
    for (int it = c.gw; it < nitems; it += c.NGW) {
        const int kc = it % ADA_KC, jb = (it / ADA_KC) % NJB, l = it / (ADA_KC * NJB);
        const float* w = c.in(I_WADA) + (size_t)l * DM * NMOD * DM + (size_t)(kc * 64) * NMOD * DM + jb * 256 + c.lane * 4;
        f32x4 a0 = {0, 0, 0, 0}, a1 = a0, a2 = a0;
#pragma unroll 8
        for (int k = 0; k < 64; ++k) { const f32x4 wv = *(const f32x4*)(w + (size_t)k * NMOD * DM); const int kk = kc * 64 + k;
            const float s0 = siluf_(cc[kk]), s1 = siluf_(cc[DM + kk]), s2 = siluf_(cctx[kk]); a0 += wv * s0; a1 += wv * s1; a2 += wv * s2; }
        float* mp = (float*)(c.ws + WS_MODP) + ((size_t)(kc * NL + l) * 3) * NMOD * DM + jb * 256 + c.lane * 4;
        *(f32x4*)(mp) = a0; *(f32x4*)(mp + NMOD * DM) = a1; *(f32x4*)(mp + 2 * NMOD * DM) = a2;
    }
}
__device__ __forceinline__ void ph_mods_reduce(const Ctx& c) {
    const int n = NL * 3 * NMOD * DM;
    for (int i = c.gt; i < n; i += c.NGT) { const int j = i % (NMOD * DM), l = i / (3 * NMOD * DM);
        float s = c.in(I_BADA)[(size_t)l * NMOD * DM + j];
#pragma unroll
        for (int kc = 0; kc < ADA_KC; ++kc) { const int lw = i / (NMOD * DM); s += ((const float*)(c.ws + WS_MODP))[((size_t)kc * NL * 3 + lw) * NMOD * DM + j]; }
        ((float*)(c.ws + WS_MODS))[i] = s; }
}
__device__ __forceinline__ void cvt_weight(const Ctx& c, const float* W, int K, int N, bf16* WT, int kind, int start, int& cursor) {
    const int nitems = N * (K / 8);
    (void)start;
    for (int it = c.gt; it < nitems; it += c.NGT) { const int n = it % N, k0 = (it / N) * 8; float v[8];
#pragma unroll
        for (int i = 0; i < 8; ++i) v[i] = W[(size_t)(k0 + i) * N + n];
        int r = n; if (kind == 1) { const int j = n < DFF ? n : n - DFF; r = (j / 128) * 256 + (n < DFF ? 0 : 128) + (j % 128); }
        st8bf(WT + (size_t)r * K + k0, v); }
    (void)cursor;
}
__device__ __forceinline__ void ph_cvt_all(const Ctx& c) {
    int cur = 0;
    for (int l = 0; l < NL; ++l) {
        cvt_weight(c, c.in(I_W1I) + (size_t)l * DM * 2 * DFF, DM, 2 * DFF, c.wl(l, W_1I), 1, 0, cur);
        cvt_weight(c, c.in(I_W1O) + (size_t)l * DFF * DM, DFF, DM, c.wl(l, W_1O), 0, 0, cur);
        cvt_weight(c, c.in(I_WIN) + (size_t)l * DM * INC, DM, INC, c.wl(l, W_IN), 0, 0, cur);
        cvt_weight(c, c.in(I_WOUT) + (size_t)l * DM * DM, DM, DM, c.wl(l, W_OUT), 0, 0, cur);
        cvt_weight(c, c.in(I_W2I) + (size_t)l * DM * 2 * DFF, DM, 2 * DFF, c.wl(l, W_2I), 1, 0, cur);
        cvt_weight(c, c.in(I_W2O) + (size_t)l * DFF * DM, DFF, DM, c.wl(l, W_2O), 0, 0, cur);
        cvt_weight(c, c.in(I_S5GLU) + (size_t)l * GWD * GWD, GWD, GWD, c.wl(l, W_GLU), 0, 0, cur);
    }
}
__device__ __forceinline__ void ph_h_init(const Ctx& c) {
    const size_t n4 = (size_t)M * DM / 4;
    for (size_t i = c.gt; i < n4; i += c.NGT) { const size_t e = i * 4; const int row = (int)(e / DM), col = (int)(e % DM);
        const f32x4 v = row < MLAT ? *(const f32x4*)(c.in(I_X) + e) : *(const f32x4*)(c.in(I_CTX) + (e - (size_t)MLAT * DM));
        *(f32x4*)(c.hrow(row) + col) = v; }
}

__device__ __forceinline__ void ph_norm_mod(const Ctx& c, int l, const float* g, int k_shift, int k_scale, int mrows) {
    constexpr int NV = DM / 256; bf16* XN = (bf16*)(c.ws + WS_XN);
    for (int row = c.gw; row < mrows; row += c.NGW) {
        const float* h = c.hrow(row); f32x4 v[NV]; float s = 0.f;
#pragma unroll
        for (int j = 0; j < NV; ++j) { v[j] = *(const f32x4*)(h + j * 256 + c.lane * 4); s += v[j].x * v[j].x + v[j].y * v[j].y + v[j].z * v[j].z + v[j].w * v[j].w; }
        const float rstd = 1.f / sqrtf(wave_sum(s) * (1.f / DM) + EPS);
        const int mi = row_mi(row); const float* sh = c.mods(l, mi, k_shift); const float* sc = c.mods(l, mi, k_scale);
#pragma unroll
        for (int j = 0; j < NV; ++j) { const int col = j * 256 + c.lane * 4; const f32x4 gv = *(const f32x4*)(g + col), shv = *(const f32x4*)(sh + col), scv = *(const f32x4*)(sc + col);
            const f32x4 y = v[j] * rstd * gv * (scv + 1.f) + shv; u32x2 w; w.x = pk2(y.x, y.y); w.y = pk2(y.z, y.w); *(u32x2*)(XN + (size_t)row * DM + col) = w; }
    }
}
__device__ __forceinline__ void ph_norm_final(const Ctx& c) {
    constexpr int NV = DM / 256; const float* g = c.in(I_GFINAL);
    for (int row = c.gw; row < MLAT; row += c.NGW) {
        float* h = c.p->out + (size_t)row * DM; f32x4 v[NV]; float s = 0.f;
#pragma unroll
        for (int j = 0; j < NV; ++j) { v[j] = *(const f32x4*)(h + j * 256 + c.lane * 4); s += v[j].x * v[j].x + v[j].y * v[j].y + v[j].z * v[j].z + v[j].w * v[j].w; }
        const float rstd = 1.f / sqrtf(wave_sum(s) * (1.f / DM) + EPS);
#pragma unroll
        for (int j = 0; j < NV; ++j) { const int col = j * 256 + c.lane * 4; *(f32x4*)(h + col) = v[j] * rstd * *(const f32x4*)(g + col); }
    }
}

struct EpiSwiglu { bf16* G;
    __device__ __forceinline__ void operator()(int row, int j0, const float (&a)[8], const float (&b)[8]) const { float o[8];
#pragma unroll
        for (int i = 0; i < 8; ++i) o[i] = siluf_(a[i]) * b[i];
        st8bf(G + (size_t)row * DFF + j0, o); } };
struct EpiResid { const Ctx* c; int l, k_gate; float scale;
    __device__ __forceinline__ void operator()(int row, int c0, const float (&v)[8]) const { float* h = c->hrow(row) + c0; const float* g = c->mods(l, row_mi(row), k_gate) + c0;
        f32x4 h0 = *(f32x4*)h, h1 = *(f32x4*)(h + 4); const f32x4 g0 = *(const f32x4*)g, g1 = *(const f32x4*)(g + 4);
        h0 += (f32x4){v[0], v[1], v[2], v[3]} * g0 * scale; h1 += (f32x4){v[4], v[5], v[6], v[7]} * g1 * scale; *(f32x4*)h = h0; *(f32x4*)(h + 4) = h1; } };
struct EpiP { bf16* P;
    __device__ __forceinline__ void operator()(int row, int c0, const float (&v)[8]) const { st8bf(P + (size_t)row * INC + c0, v); } };

template <class Epi> __device__ __forceinline__ void gemm_naive(const Ctx& c, const bf16* A, const bf16* Bt, int mrows, int N, int K, const Epi& E) {
    const int ncg = N / 8; const long nitems = (long)mrows * ncg;
    for (long it = c.gt; it < nitems; it += c.NGT) { const int row = (int)(it / ncg), c0 = (int)(it % ncg) * 8; float acc[8];
#pragma unroll
        for (int i = 0; i < 8; ++i) acc[i] = 0.f;
        const bf16* a = A + (size_t)row * K;
        for (int k = 0; k < K; k += 8) { float av[8]; ld8bf(a + k, av);
#pragma unroll
            for (int i = 0; i < 8; ++i) { float bv[8]; ld8bf(Bt + (size_t)(c0 + i) * K + k, bv);
#pragma unroll
                for (int j = 0; j < 8; ++j) acc[i] += av[j] * bv[j]; } }
        E(row, c0, acc); }
}
__device__ __forceinline__ void gemm_naive_swiglu(const Ctx& c, const bf16* A, const bf16* Bt, int mrows, int K, const EpiSwiglu& E) {
    const int ncg = DFF / 8; const long nitems = (long)mrows * ncg;
    for (long it = c.gt; it < nitems; it += c.NGT) { const int row = (int)(it / ncg), j0 = (int)(it % ncg) * 8; float aa[8], ab[8];
#pragma unroll
        for (int i = 0; i < 8; ++i) { aa[i] = 0.f; ab[i] = 0.f; }
        const bf16* a = A + (size_t)row * K; const int ra = (j0 / 128) * 256 + (j0 % 128);
        for (int k = 0; k < K; k += 8) { float av[8]; ld8bf(a + k, av);
#pragma unroll
            for (int i = 0; i < 8; ++i) { float bv[8]; ld8bf(Bt + (size_t)(ra + i) * K + k, bv);
#pragma unroll
                for (int j = 0; j < 8; ++j) aa[i] += av[j] * bv[j];
                ld8bf(Bt + (size_t)(ra + 128 + i) * K + k, bv);
#pragma unroll
                for (int j = 0; j < 8; ++j) ab[i] += av[j] * bv[j]; } }
        E(row, j0, aa, ab); }
}

struct S5Lane { float ar, ai, fr, fi; float bre[16], bim[16], cre[16], cim[16]; };
__device__ __forceinline__ void s5_load(const Ctx& c, int l, int dir, int g, int p, S5Lane& S) {
    const size_t gi = ((size_t)(l * 2 + dir) * S5G + g);
    const float lr = c.in(I_S5LRE)[gi * 64 + p], li = c.in(I_S5LIM)[gi * 64 + p], dt = expf(c.in(I_S5STEP)[gi]);
    const float th = li * dt, em1 = expm1f(lr * dt), cs = cosf(th), sn = sinf(th), sh = sinf(0.5f * th);
    const float arm1 = em1 * cs - 2.f * sh * sh;
    S.ar = 1.f + arm1; S.ai = (em1 + 1.f) * sn;
    const float den = lr * lr + li * li; S.fr = (arm1 * lr + S.ai * li) / den; S.fi = (S.ai * lr - arm1 * li) / den;
    const float* br = c.in(I_S5BRE) + (gi * 64 + p) * 16; const float* bi = c.in(I_S5BIM) + (gi * 64 + p) * 16;
#pragma unroll
    for (int h = 0; h < 16; ++h) { S.bre[h] = br[h]; S.bim[h] = bi[h]; S.cre[h] = c.in(I_S5CRE)[(gi * 16 + h) * 64 + p]; S.cim[h] = c.in(I_S5CIM)[(gi * 16 + h) * 64 + p]; }
}
__device__ __forceinline__ int s5_row(int b, int dir, int i) {
    if (i < TC) return MLAT + b * TC + (dir ? TC - 1 - i : i);
    const int t = i - TC; return b * T + (dir ? T - 1 - t : t);
}
__device__ __forceinline__ void s5_step(const S5Lane& S, const bf16* urow, float& sr, float& si) {
    float u[16]; { float t0[8], t1[8]; ld8bf(urow, t0); ld8bf(urow + 8, t1);
#pragma unroll
        for (int i = 0; i < 8; ++i) { u[i] = t0[i]; u[8 + i] = t1[i]; } }
    float wr = 0.f, wi = 0.f;
#pragma unroll
    for (int h = 0; h < 16; ++h) { wr += S.bre[h] * u[h]; wi += S.bim[h] * u[h]; }
    const float xr = S.fr * wr - S.fi * wi, xi = S.fr * wi + S.fi * wr;
    const float nr = S.ar * sr - S.ai * si + xr, ni = S.ar * si + S.ai * sr + xi; sr = nr; si = ni;
}
__device__ __forceinline__ void ph_s5_a(const Ctx& c, int l) {
    const bf16* P = (const bf16*)(c.ws + WS_BIG + BIG_P); float* E = (float*)(c.ws + WS_S5E);
    const int nitems = NB * S5G * 2 * (NCH5 - 1);
    for (int it = c.gw; it < nitems; it += c.NGW) { const int ch = it % (NCH5 - 1), dir = (it / (NCH5 - 1)) % 2, g = (it / (2 * (NCH5 - 1))) % S5G, b = it / (2 * (NCH5 - 1) * S5G);
        S5Lane S; s5_load(c, l, dir, g, c.lane, S); float sr = 0.f, si = 0.f;
        for (int i = ch * LS5; i < (ch + 1) * LS5; ++i) s5_step(S, P + (size_t)s5_row(b, dir, i) * INC + PC_S5 + g * 16, sr, si);
        float* e = E + ((((size_t)(b * S5G + g) * 2 + dir) * NCH5 + ch) * 64 + c.lane) * 2; e[0] = sr; e[1] = si; }
}
__device__ __forceinline__ void ph_s5_b(const Ctx& c, int l) {
    const bf16* P = (const bf16*)(c.ws + WS_BIG + BIG_P); const float* E = (const float*)(c.ws + WS_S5E); float* YS = (float*)(c.ws + WS_XN);
    const int nitems = NB * S5G * 2 * NCH5;
    for (int it = c.gw; it < nitems; it += c.NGW) { const int ch = it % NCH5, dir = (it / NCH5) % 2, g = (it / (2 * NCH5)) % S5G, b = it / (2 * NCH5 * S5G);
        S5Lane S; s5_load(c, l, dir, g, c.lane, S);
        float pr = S.ar, pi = S.ai;
#pragma unroll
        for (int s = 1; s < LS5; s <<= 1) { const float nr = pr * pr - pi * pi, ni = 2.f * pr * pi; pr = nr; pi = ni; }
        float sr = 0.f, si = 0.f; const float* e = E + ((((size_t)(b * S5G + g) * 2 + dir) * NCH5) * 64 + c.lane) * 2;
        for (int j = 0; j < ch; ++j) { const float er = e[(size_t)j * 128], ei = e[(size_t)j * 128 + 1]; const float nr = pr * sr - pi * si + er, ni = pr * si + pi * sr + ei; sr = nr; si = ni; }
        for (int i = ch * LS5; i < (ch + 1) * LS5; ++i) { const int row = s5_row(b, dir, i);
            s5_step(S, P + (size_t)row * INC + PC_S5 + g * 16, sr, si);
            float v[16];
#pragma unroll
            for (int h = 0; h < 16; ++h) v[h] = S.cre[h] * sr - S.cim[h] * si;
            float w8[8];
            { const bool hi = (c.lane & 32) != 0;
#pragma unroll
              for (int k = 0; k < 8; ++k) { const float send = hi ? v[k] : v[8 + k]; const float keep = hi ? v[8 + k] : v[k]; w8[k] = keep + __shfl_xor(send, 32); } }
            float w4[4];
            { const bool hi = (c.lane & 16) != 0;
#pragma unroll
              for (int k = 0; k < 4; ++k) { const float send = hi ? w8[k] : w8[4 + k]; const float keep = hi ? w8[4 + k] : w8[k]; w4[k] = keep + __shfl_xor(send, 16); } }
            float w2[2];
            { const bool hi = (c.lane & 8) != 0;
#pragma unroll
              for (int k = 0; k < 2; ++k) { const float send = hi ? w4[k] : w4[2 + k]; const float keep = hi ? w4[2 + k] : w4[k]; w2[k] = keep + __shfl_xor(send, 8); } }
            float w1;
            { const bool hi = (c.lane & 4) != 0; const float send = hi ? w2[0] : w2[1]; const float keep = hi ? w2[1] : w2[0]; w1 = keep + __shfl_xor(send, 4); }
            w1 += __shfl_xor(w1, 2); w1 += __shfl_xor(w1, 1);
            if ((c.lane & 3) == 0) YS[((size_t)dir * M + row) * GWD + g * 16 + (c.lane >> 2)] = w1;
        } }
}
__device__ __forceinline__ void ph_s5_glu(const Ctx& c, int l, int mrows) {
    constexpr int ZPL = GWD / 64; const bf16* P = (const bf16*)(c.ws + WS_BIG + BIG_P); const float* YS = (const float*)(c.ws + WS_XN); bf16* Y = (bf16*)(c.ws + WS_Y);
    LAS float* zs = (LAS float*)(c.lds) + c.wave * GWD; const bf16* Wt = c.wl(l, W_GLU); const float* d = c.in(I_S5D) + (size_t)l * GWD;
    for (int row = c.gw; row < mrows; row += c.NGW) { float z[ZPL];
#pragma unroll
        for (int i = 0; i < ZPL; ++i) { const int ch = c.lane * ZPL + i; const float u = bf2f(P[(size_t)row * INC + PC_S5 + ch]);
            z[i] = geluf_(d[ch] * u + YS[(size_t)row * GWD + ch] + YS[((size_t)M + row) * GWD + ch]); zs[ch] = z[i]; }
        WAVE_SYNC();
        float acc[ZPL];
#pragma unroll
        for (int i = 0; i < ZPL; ++i) acc[i] = 0.f;
        for (int k = 0; k < GWD; k += 8) { float zv[8];
#pragma unroll
            for (int j = 0; j < 8; ++j) zv[j] = zs[k + j];
#pragma unroll
            for (int i = 0; i < ZPL; ++i) { float wv[8]; ld8bf(Wt + (size_t)(c.lane * ZPL + i) * GWD + k, wv);
#pragma unroll
                for (int j = 0; j < 8; ++j) acc[i] += zv[j] * wv[j]; } }
#pragma unroll
        for (int i = 0; i < ZPL; ++i) Y[(size_t)row * DM + c.lane * ZPL + i] = (bf16)f2bf(z[i] * sigmoidf_(acc[i]));
        WAVE_SYNC();
    }
}

__device__ __forceinline__ int lru_tile_row0(int b, int tile) { return tile < NCT ? MLAT + b * TC + tile * LL : b * T + (tile - NCT) * LL; }
template <bool PASS_B> __device__ __forceinline__ void ph_lru(const Ctx& c, int l, bool need_ctx) {
    const bf16* P = (const bf16*)(c.ws + WS_BIG + BIG_P); float* E = (float*)(c.ws + WS_LRUE); bf16* Y = (bf16*)(c.ws + WS_Y);
    LAS float* XC = (LAS float*)c.lds;
    LAS float* HT = XC + LL * GWD;
    const int e = c.tid % GWD, dir = (c.tid / GWD) & 1; const bool active = c.tid < 2 * GWD;
    const int blk = e / 64, el = e % 64;
    float wa[64], wx[64];
    { const float* pa = c.in(I_LWA) + (((size_t)(l * 2 + dir) * NH + blk) * 64) * 64 + el; const float* px = c.in(I_LWX) + (((size_t)(l * 2 + dir) * NH + blk) * 64) * 64 + el;
#pragma unroll
      for (int d = 0; d < 64; ++d) { wa[d] = pa[d * 64]; wx[d] = px[d * 64]; } }
    const float ba = c.in(I_LBA)[(size_t)(l * 2 + dir) * GWD + e], bx = c.in(I_LBX)[(size_t)(l * 2 + dir) * GWD + e];
    const float sp = softplusf_(-c.in(I_LLAM)[(size_t)(l * 2 + dir) * GWD + e]);
    const int nitems = NB * NTL;
    for (int it = c.bx; it < nitems; it += c.G) { const int tile = it % NTL, b = it / NTL; const bool is_ctx = tile < NCT;
        const int row0 = lru_tile_row0(b, tile); const int t0 = (is_ctx ? tile : tile - NCT) * LL, tlen = is_ctx ? TC : T; const int seq0 = row0 - t0;
        __syncthreads();
        for (int i = c.tid; i < LL * GWD; i += NT) { const int t = i / GWD, ch = i % GWD; float s = c.in(I_LCB)[(size_t)l * GWD + ch];
#pragma unroll
            for (int k = 0; k < 4; ++k) { const int tt = t0 + t + k - 2; if (tt >= 0 && tt < tlen) s += c.in(I_LCW)[((size_t)l * 4 + k) * GWD + ch] * bf2f(P[(size_t)(seq0 + tt) * INC + PC_LX + ch]); }
            XC[i] = s; }
        __syncthreads();
        if (active) {
            float h = 0.f, pa = 1.f;
            if (PASS_B) {
                const float* eb = E + ((size_t)(b * 2 + dir) * NTL) * GWD * 2 + e * 2;
                if (dir == 0) { for (int j = 0; j < tile; ++j) h = eb[(size_t)j * GWD * 2] * h + eb[(size_t)j * GWD * 2 + 1]; }
                else { if (is_ctx) { for (int j = NCT - 1; j > tile; --j) h = eb[(size_t)j * GWD * 2] * h + eb[(size_t)j * GWD * 2 + 1]; }
                       else { for (int j = NCT - 1; j >= 0; --j) h = eb[(size_t)j * GWD * 2] * h + eb[(size_t)j * GWD * 2 + 1];
                              for (int j = NTL - 1; j > tile; --j) h = eb[(size_t)j * GWD * 2] * h + eb[(size_t)j * GWD * 2 + 1]; } }
            }
            for (int s = 0; s < LL; ++s) { const int t = dir ? LL - 1 - s : s; const LAS float* xr = XC + t * GWD + blk * 64;
                float r = ba, ig = bx;
#pragma unroll
                for (int d = 0; d < 64; ++d) { const float xv = xr[d]; r += xv * wa[d]; ig += xv * wx[d]; }
                r = sigmoidf_(r); ig = sigmoidf_(ig);
                const float la = -8.f * r * sp, a = expf(la), bb = sqrtf(-expm1f(2.f * la)) * (ig * xr[el]);
                h = a * h + bb; pa *= a;
                if (PASS_B) HT[(dir * LL + t) * GWD + e] = h; }
            if (!PASS_B) { float* eo = E + (((size_t)(b * 2 + dir) * NTL + tile) * GWD + e) * 2; eo[0] = pa; eo[1] = h; }
        }
        if (PASS_B) { __syncthreads();
            if (!is_ctx || need_ctx) for (int i = c.tid; i < LL * GWD; i += NT) { const int t = i / GWD, ch = i % GWD; const int row = row0 + t;
                const float gt = bf2f(P[(size_t)row * INC + PC_LG + ch]); Y[(size_t)row * DM + 3 * GWD + ch] = (bf16)f2bf((HT[t * GWD + ch] + HT[(LL + t) * GWD + ch]) * geluf_(gt)); } }
    }
}

__device__ __forceinline__ void ph_gqa_prep(const Ctx& c, int l) {
    const bf16* P = (const bf16*)(c.ws + WS_BIG + BIG_P); bf16* QN = (bf16*)(c.ws + WS_BIG + BIG_QN); bf16* KN = (bf16*)(c.ws + WS_BIG + BIG_KN);
    const float* gq = c.in(I_GQN) + l * 64; const float* gk = c.in(I_GKN) + l * 64;
    const int nitems = M * (NH + NKV);
    for (int it = c.gw; it < nitems; it += c.NGW) { const int hs = it % (NH + NKV), row = it / (NH + NKV); const bool isq = hs < NH; const int hh = isq ? hs : hs - NH;
        const float x = bf2f(P[(size_t)row * INC + (isq ? PC_GQ : PC_GK) + hh * 64 + c.lane]);
        const float rstd = 1.f / sqrtf(wave_sum(x * x) * (1.f / 64.f) + EPS);
        float y = x * rstd * (isq ? gq[c.lane] : gk[c.lane]);
        if (row < MLAT) {
            const int t = row % T; const float pos = (float)((c.lane < 32) ? t / GW : t % GW); const int i16 = c.lane & 15;
            const float freq = powf(10000.f, -(float)i16 / 16.f), ang = pos * freq, cs = cosf(ang), sn = sinf(ang);
            const float partner = __shfl_xor(y, 16); const bool second = (c.lane & 16) != 0;
            y = second ? (y * cs + partner * sn) : (y * cs - partner * sn);
        }
        if (isq) QN[(size_t)row * GWD + hh * 64 + c.lane] = (bf16)f2bf(y * 0.125f); else KN[(size_t)row * (NKV * 64) + hh * 64 + c.lane] = (bf16)f2bf(y);
    }
}

__device__ __forceinline__ void attn_key(const bf16* k, const bf16* v, float bias, const float (&q)[64], float& m, float& lsum, float (&o)[64]) {
    float s = bias;
#pragma unroll
    for (int d8 = 0; d8 < 8; ++d8) { float kv[8]; ld8bf(k + d8 * 8, kv);
#pragma unroll
        for (int j = 0; j < 8; ++j) s += q[d8 * 8 + j] * kv[j]; }
    const float mn = fmaxf(m, s), corr = expf(m - mn), pp = expf(s - mn); m = mn; lsum = lsum * corr + pp;
#pragma unroll
    for (int d8 = 0; d8 < 8; ++d8) { float vv[8]; ld8bf(v + d8 * 8, vv);
#pragma unroll
        for (int j = 0; j < 8; ++j) o[d8 * 8 + j] = o[d8 * 8 + j] * corr + pp * vv[j]; }
}
__device__ __forceinline__ void attn_store(bf16* dst, float lsum, const float (&o)[64]) {
    const float inv = 1.f / lsum;
#pragma unroll
    for (int d8 = 0; d8 < 8; ++d8) { float t[8];
#pragma unroll
        for (int j = 0; j < 8; ++j) t[j] = o[d8 * 8 + j] * inv;
        st8bf(dst + d8 * 8, t); }
}
__device__ __forceinline__ void ph_gqa_naive(const Ctx& c, bool need_ctx) {
    const bf16* P = (const bf16*)(c.ws + WS_BIG + BIG_P); const bf16* QN = (const bf16*)(c.ws + WS_BIG + BIG_QN); const bf16* KN = (const bf16*)(c.ws + WS_BIG + BIG_KN); bf16* Y = (bf16*)(c.ws + WS_Y);
    const int nq = need_ctx ? M : MLAT; const long nitems = (long)nq * NH;
    for (long it = c.gt; it < nitems; it += c.NGT) { const int h = (int)(it / nq), row = (int)(it % nq); const int kvh = h / GQG;
        const int b = row < MLAT ? row / T : (row - MLAT) / TC;
        float q[64], o[64]; float m = -1e30f, ls = 0.f;
#pragma unroll
        for (int d8 = 0; d8 < 8; ++d8) { float t[8]; ld8bf(QN + (size_t)row * GWD + h * 64 + d8 * 8, t);
#pragma unroll
            for (int j = 0; j < 8; ++j) { q[d8 * 8 + j] = t[j]; o[d8 * 8 + j] = 0.f; } }
        for (int n = 0; n < TC; ++n) { const int kr = MLAT + b * TC + n; attn_key(KN + (size_t)kr * (NKV * 64) + kvh * 64, P + (size_t)kr * INC + PC_GV + kvh * 64, 0.f, q, m, ls, o); }
        if (row < MLAT) for (int t = 0; t < T; ++t) { const int kr = b * T + t; attn_key(KN + (size_t)kr * (NKV * 64) + kvh * 64, P + (size_t)kr * INC + PC_GV + kvh * 64, 0.f, q, m, ls, o); }
        attn_store(Y + (size_t)row * DM + 2 * GWD + h * 64, ls, o); }
}
__device__ __forceinline__ void ph_na_naive(const Ctx& c, int l, bool need_ctx) {
    const bf16* P = (const bf16*)(c.ws + WS_BIG + BIG_P); bf16* Y = (bf16*)(c.ws + WS_Y); const float* rpb = c.in(I_RPB) + (size_t)l * NH * 15 * 31;
    constexpr int KR = NROWS < 8 ? NROWS : 8;
    const int nq = need_ctx ? M : MLAT; const long nitems = (long)nq * NH;
    for (long it = c.gt; it < nitems; it += c.NGT) { const int h = (int)(it / nq), row = (int)(it % nq);
        const int b = row < MLAT ? row / T : (row - MLAT) / TC;
        float q[64], o[64]; float m = -1e30f, ls = 0.f;
#pragma unroll
        for (int d8 = 0; d8 < 8; ++d8) { float t[8]; ld8bf(P + (size_t)row * INC + PC_NAQ + h * 64 + d8 * 8, t);
#pragma unroll
            for (int j = 0; j < 8; ++j) { q[d8 * 8 + j] = t[j] * 0.125f; o[d8 * 8 + j] = 0.f; } }
        if (row < MLAT) { const int t = row % T, r = t / GW, cc = t % GW;
            int rs = r - 4; rs = rs < 0 ? 0 : (rs > NROWS - KR ? NROWS - KR : rs); int cs = cc - 8; cs = cs < 0 ? 0 : (cs > GW - 16 ? GW - 16 : cs);
            for (int i = 0; i < KR; ++i) for (int j = 0; j < 16; ++j) { const int kr = b * T + (rs + i) * GW + cs + j; const float bias = rpb[((size_t)h * 15 + (rs + i - r + 7)) * 31 + (cs + j - cc + 15)];
                attn_key(P + (size_t)kr * INC + PC_NAK + h * 64, P + (size_t)kr * INC + PC_NAV + h * 64, bias, q, m, ls, o); } }
        for (int n = 0; n < TC; ++n) { const int kr = MLAT + b * TC + n; attn_key(P + (size_t)kr * INC + PC_NAK + h * 64, P + (size_t)kr * INC + PC_NAV + h * 64, 0.f, q, m, ls, o); }
        attn_store(Y + (size_t)row * DM + GWD + h * 64, ls, o); }
}

constexpr int PH_INIT = 0, PH_MODS = 1, PH_L0 = 2, NPL = 12, PH_FINAL = PH_L0 + NL * NPL, N_PHASES = PH_FINAL + 1;
template <int ph> __device__ __forceinline__ void run_phase(const Ctx& c) {
    if (ph == PH_INIT) { ph_ada_partial(c); ph_cvt_all(c); ph_h_init(c); return; }
    if (ph == PH_MODS) { ph_mods_reduce(c); return; }
    if (ph == PH_FINAL) { ph_norm_final(c); return; }
    constexpr int l = (ph - PH_L0) / NPL, s = (ph - PH_L0) % NPL; constexpr bool need_ctx = l < NL - 1; constexpr int mrows2 = need_ctx ? M : MLAT;
    bf16* XN = (bf16*)(c.ws + WS_XN); bf16* G = (bf16*)(c.ws + WS_BIG); bf16* Pb = (bf16*)(c.ws + WS_BIG + BIG_P); bf16* Y = (bf16*)(c.ws + WS_Y);
    switch (s) {
    case 0: ph_norm_mod(c, l, c.in(I_GFFN1) + (size_t)l * DM, 0, 1, M); break;
    case 1: { EpiSwiglu E{G}; gemm_naive_swiglu(c, XN, c.wl(l, W_1I), M, DM, E); } break;
    case 2: { EpiResid E{&c, l, 2, 0.5f}; gemm_naive(c, G, c.wl(l, W_1O), M, DM, DFF, E); } break;
    case 3: ph_norm_mod(c, l, c.in(I_GMIX) + (size_t)l * DM, 3, 4, M); break;
    case 4: { EpiP E{Pb}; gemm_naive(c, XN, c.wl(l, W_IN), M, INC, DM, E); } break;
    case 5: ph_s5_a(c, l); ph_lru<false>(c, l, need_ctx); ph_gqa_prep(c, l); break;
    case 6: ph_s5_b(c, l); ph_lru<true>(c, l, need_ctx); ph_na_naive(c, l, need_ctx); ph_gqa_naive(c, need_ctx); break;
    case 7: ph_s5_glu(c, l, mrows2); break;
    case 8: { EpiResid E{&c, l, 5, 1.0f}; gemm_naive(c, Y, c.wl(l, W_OUT), mrows2, DM, DM, E); } break;
    case 9: ph_norm_mod(c, l, c.in(I_GFFN2) + (size_t)l * DM, 6, 7, mrows2); break;
    case 10: { EpiSwiglu E{G}; gemm_naive_swiglu(c, XN, c.wl(l, W_2I), mrows2, DM, E); } break;
    case 11: { EpiResid E{&c, l, 8, 0.5f}; gemm_naive(c, G, c.wl(l, W_2O), mrows2, DM, DFF, E); } break;
    }
}

#ifndef HOST_EMU
#define XB_TMO      128
#define XB_XCNT(j)  (256  + 64 * (j))
#define XB_XSUB(j)  (1280 + 64 * (j))
#define XB_XGEN(j)  (2304 + 64 * (j))
#define XB_TOP      3328
#define XB_TOPGEN   3392
#define XCD_BAR_WORDS 3456
#define XB_SPIN_CAP (1u << 22)
__device__ __forceinline__ unsigned xb_ld(unsigned* p)              { return __hip_atomic_load(p, __ATOMIC_RELAXED, __HIP_MEMORY_SCOPE_AGENT); }
__device__ __forceinline__ unsigned xb_add(unsigned* p, unsigned v) { return __hip_atomic_fetch_add(p, v, __ATOMIC_RELAXED, __HIP_MEMORY_SCOPE_AGENT); }
__device__ __forceinline__ unsigned xb_xcc_id() { return (unsigned)__builtin_amdgcn_s_getreg((3 << 11) | 20) & 0xFu; }
#define XB_SPIN(cond, bar) do { unsigned _sp = 0; while (cond) { __builtin_amdgcn_s_sleep(1); \
    if ((++_sp & 255u) == 0u) { if (xb_ld(&(bar)[XB_TMO])) break; if (_sp > XB_SPIN_CAP) { atomicAdd(&(bar)[XB_TMO], 1u); break; } } } } while (0)
struct XcdBarrier { unsigned* bar; unsigned x; volatile LAS unsigned* st; };
__device__ __forceinline__ XcdBarrier xcd_barrier_post(unsigned* bar, volatile LAS unsigned* st) {
    XcdBarrier b; b.bar = bar; b.x = xb_xcc_id(); b.st = st;
    if (threadIdx.x == 0) (void)xb_add(&bar[XB_XCNT(b.x)], 1u);
    return b;
}
__device__ __forceinline__ void xcd_barrier_complete(unsigned* bar, unsigned x, unsigned& nloc, unsigned& nx) {
    const unsigned G = gridDim.x * gridDim.y * gridDim.z;
    unsigned sum, cnt, mine, sp = 0u;
    for (;;) {
        sum = 0u; cnt = 0u; mine = 0u;
#pragma unroll
        for (unsigned j = 0; j < 16; ++j) { const unsigned cj = xb_ld(&bar[XB_XCNT(j)]); sum += cj; cnt += (cj > 0u) ? 1u : 0u; mine = (j == x) ? cj : mine; }
        if (sum == G) break;
        __builtin_amdgcn_s_sleep(1);
        if ((++sp & 255u) == 0u) { if (xb_ld(&bar[XB_TMO])) break; if (sp > XB_SPIN_CAP) { atomicAdd(&bar[XB_TMO], 1u); break; } }
    }
    nloc = mine > 0u ? mine : 1u; nx = cnt > 0u ? cnt : 1u;
}
__device__ __forceinline__ void xcd_barrier(const XcdBarrier& b) {
    asm volatile("s_waitcnt vmcnt(0)" ::: "memory");
    __syncthreads();
    if (threadIdx.x == 0) {
        unsigned* bar = b.bar;
        __builtin_amdgcn_s_waitcnt(0);
        unsigned nloc = b.st[0], nx = b.st[1];
        if (nloc == 0u) { xcd_barrier_complete(bar, b.x, nloc, nx); b.st[0] = nloc; b.st[1] = nx; }
        const unsigned old = xb_add(&bar[XB_XSUB(b.x)], 1u);
        const unsigned gen = old / nloc;
        if (old + 1u == (gen + 1u) * nloc) {
            __builtin_amdgcn_fence(__ATOMIC_RELEASE, "agent");
            asm volatile("s_waitcnt vmcnt(0)" ::: "memory");
            const unsigned og = xb_add(&bar[XB_TOP], 1u);
            const unsigned tg = og / nx;
            if (og + 1u == (tg + 1u) * nx) xb_add(&bar[XB_TOPGEN], 1u);
            else XB_SPIN(xb_ld(&bar[XB_TOPGEN]) == tg, bar);
            __builtin_amdgcn_fence(__ATOMIC_ACQUIRE, "agent");
            xb_add(&bar[XB_XGEN(b.x)], 1u);
            asm volatile("s_waitcnt vmcnt(0)" ::: "memory");
        } else {
            XB_SPIN(xb_ld(&bar[XB_XGEN(b.x)]) == gen, bar);
            __builtin_amdgcn_fence(__ATOMIC_ACQUIRE, "agent");
            asm volatile("s_waitcnt vmcnt(0)" ::: "memory");
        }
    }
    __syncthreads();
}
#endif

#ifdef HOST_EMU
template <int PH> __device__ __forceinline__ void phases_from(const Ctx& c, int lo, int hi) {
    if constexpr (PH < N_PHASES) { if (lo <= PH && PH < hi) run_phase<PH>(c); phases_from<PH + 1>(c, lo, hi); }
}
#else
template <int PH> __device__ __forceinline__ void phases_from(const Ctx& c, int lo, int hi, const XcdBarrier& bar) {
    if constexpr (PH < N_PHASES) { if (lo <= PH && PH < hi) { run_phase<PH>(c); if (PH + 1 < hi) xcd_barrier(bar); } phases_from<PH + 1>(c, lo, hi, bar); }
}
#endif
#ifdef HOST_EMU
static void mega_body(const Params& prm) {
    unsigned char* lds_raw = emu_lds();
#else
__global__ void __launch_bounds__(NT, 2) mega_kernel(Params prm) {
    extern __shared__ __attribute__((aligned(16))) unsigned char lds_raw[];
#endif
    Ctx c; c.p = &prm; c.ws = prm.ws; c.lds = (LAS unsigned char*)lds_raw;
    c.tid = threadIdx.x; c.lane = c.tid & 63; c.wave = __builtin_amdgcn_readfirstlane(c.tid >> 6);
    c.G = gridDim.x; c.bx = blockIdx.x; c.gw = c.bx * NWAVES + c.wave; c.NGW = c.G * NWAVES; c.gt = c.bx * NT + c.tid; c.NGT = c.G * NT;
#ifndef HOST_EMU
    volatile LAS unsigned* misc = (volatile LAS unsigned*)(c.lds + LDS_MISC);
    if (c.tid < 16) misc[c.tid] = 0u;
    __syncthreads();
    XcdBarrier bar; bar.bar = (unsigned*)(c.ws + WS_CTL) + 4096; bar.x = 0; bar.st = nullptr;
    const bool multi = prm.ph_hi - prm.ph_lo > 1;
    if (multi) bar = xcd_barrier_post((unsigned*)(c.ws + WS_CTL) + 4096, misc + 8);
#endif
    phases_from<0>(c, prm.ph_lo, prm.ph_hi
#ifndef HOST_EMU
        , bar
#endif
        );
}

#ifndef HOST_EMU
#ifndef MK_PER_PHASE
#define MK_PER_PHASE 0
#endif
extern "C" void kernel_launch(void* const* d_in, const int* in_sizes, int n_in, void* d_out, int out_size, void* d_ws, size_t ws_size, hipStream_t stream) {
    static int grid = 0;
    if (grid == 0) {
        if (n_in != N_IN || out_size != MLAT * DM || ws_size < WS_END) { fprintf(stderr, "kernel_launch: unexpected shapes (n_in %d out %d ws %zu need %zu)\n", n_in, out_size, ws_size, (size_t)WS_END); grid = -1; return; }
        int dev = 0, cus = 0, per_cu = 0;
        if (hipGetDevice(&dev) != hipSuccess || hipDeviceGetAttribute(&cus, hipDeviceAttributeMultiprocessorCount, dev) != hipSuccess) { grid = -1; return; }
        if (hipFuncSetAttribute((const void*)mega_kernel, hipFuncAttributeMaxDynamicSharedMemorySize, LDS_BYTES) != hipSuccess) { fprintf(stderr, "kernel_launch: hipFuncSetAttribute failed\n"); grid = -1; return; }
        if (hipOccupancyMaxActiveBlocksPerMultiprocessor(&per_cu, (const void*)mega_kernel, NT, LDS_BYTES) != hipSuccess || per_cu < 1) fprintf(stderr, "kernel_launch: occupancy query says %d\n", per_cu);
        (void)hipGetLastError();
        grid = cus;
    }
    if (grid < 0) return;
    (void)hipMemsetAsync((char*)d_ws + WS_CTL, 0, CTL_ZERO_BYTES, stream);
    Params p{};
    for (int i = 0; i < N_IN; ++i) p.in[i] = (const float*)d_in[i];
    p.out = (float*)d_out; p.ws = (unsigned char*)d_ws;
#if MK_PER_PHASE
    for (int ph = 0; ph < N_PHASES; ++ph) { p.ph_lo = ph; p.ph_hi = ph + 1; hipLaunchKernelGGL(mega_kernel, dim3(grid), dim3(NT), LDS_BYTES, stream, p); }
#else
    p.ph_lo = 0; p.ph_hi = N_PHASES; hipLaunchKernelGGL(mega_kernel, dim3(grid), dim3(NT), LDS_BYTES, stream, p);
#endif
}
#endif
```

```cpp
#ifndef HOST_EMU
#include <hip/hip_runtime.h>
#include <cstdio>
#include <cstdint>
#define LAS __attribute__((address_space(3)))
#define GAS __attribute__((address_space(1)))
#else
#define LAS
#define GAS
#endif
#ifdef HOST_EMU
static inline void emu_atomic_add_f32(float* p, float v) { unsigned* u = (unsigned*)p; unsigned o = __atomic_load_n(u, __ATOMIC_RELAXED), n; do { float f; memcpy(&f, &o, 4); f += v; memcpy(&n, &f, 4); } while (!__atomic_compare_exchange_n(u, &o, n, false, __ATOMIC_RELAXED, __ATOMIC_RELAXED)); }
#define ATOMIC_ADD_F32(p, v) emu_atomic_add_f32((p), (v))
#define WAVE_SYNC() emu_yield(EMU_WAVE)
#else
#define ATOMIC_ADD_F32(p, v) ((void)atomicAdd((p), (v)))
#define WAVE_SYNC() __builtin_amdgcn_wave_barrier()
#endif

#ifndef CFG_DM
#define CFG_DM 1024
#define CFG_T 8192
#define CFG_TC 256
#define CFG_GW 64
#endif
constexpr int DM = CFG_DM, NB = 2, T = CFG_T, TC = CFG_TC, GW = CFG_GW, NROWS = T / GW, NL = 2;
constexpr int GWD = DM / 4, NH = GWD / 64, NKV = (NH / 2 > 0) ? NH / 2 : 1, GQG = NH / NKV, S5G = GWD / 16;
constexpr int DFF = ((8 * DM / 3 + 127) / 128) * 128;
constexpr int INC = 7 * GWD + 2 * NKV * 64;
constexpr int MLAT = NB * T, MCTX = NB * TC, M = MLAT + MCTX;
constexpr int PC_S5 = 0, PC_NAQ = GWD, PC_NAK = 2 * GWD, PC_NAV = 3 * GWD, PC_GQ = 4 * GWD, PC_GK = 5 * GWD, PC_GV = 5 * GWD + NKV * 64, PC_LX = 5 * GWD + 2 * NKV * 64, PC_LG = PC_LX + GWD;
constexpr int NMOD = 9;
constexpr float EPS = 1e-6f;
constexpr int NT = 512, NWAVES = 8;
constexpr int LS5 = 64;
constexpr int NCH5 = (TC + T) / LS5;
constexpr int LL = 32;
constexpr int NCT = TC / LL, NLT = T / LL, NTL = NCT + NLT;
constexpr int ADA_KC = DM / 64;
static_assert(T % LS5 == 0 && TC % LS5 == 0 && T % LL == 0 && TC % LL == 0 && GWD % 64 == 0 && DM % 256 == 0, "shape");

enum { I_X = 0, I_C, I_CTX, I_CCTX, I_WADA, I_BADA, I_GFFN1, I_W1I, I_W1O, I_GMIX, I_WIN, I_WOUT, I_S5LRE, I_S5LIM, I_S5STEP, I_S5BRE, I_S5BIM, I_S5CRE, I_S5CIM,
       I_S5D, I_S5GLU, I_RPB, I_GQN, I_GKN, I_LCW, I_LCB, I_LWA, I_LBA, I_LWX, I_LBX, I_LLAM, I_GFFN2, I_W2I, I_W2O, I_GFINAL, N_IN };

typedef unsigned short bf16;
typedef float f32x4 __attribute__((ext_vector_type(4)));
typedef unsigned u32x4 __attribute__((ext_vector_type(4)));
typedef unsigned u32x2 __attribute__((ext_vector_type(2)));

constexpr size_t MiB = 1u << 20;
constexpr size_t al(size_t x) { return (x + 255) & ~(size_t)255; }
constexpr size_t WS_CTL = 0, CTL_ZERO_BYTES = 1 * MiB;
constexpr size_t WS_MODS = WS_CTL + CTL_ZERO_BYTES;
constexpr size_t WS_MODP = WS_MODS + al((size_t)NL * 3 * NMOD * DM * 4);
constexpr size_t WS_S5E = WS_MODP + al((size_t)ADA_KC * NL * 3 * NMOD * DM * 4);
constexpr size_t WS_LRUE = WS_S5E + al((size_t)NB * S5G * 2 * NCH5 * 64 * 2 * 4);
constexpr int ROPE_NPOS = (NROWS > GW ? NROWS : GW);
constexpr size_t WS_ROPE = WS_LRUE + al((size_t)NB * 2 * NTL * GWD * 2 * 4);
constexpr size_t WS_LRUW = WS_ROPE + al((size_t)ROPE_NPOS * 32 * 4);
constexpr size_t S5T_BYTES = 2 * 12 * 64 * 16 + 2 * 2 * 10 * 64 * 8;
constexpr size_t WS_S5T = WS_LRUW + al((size_t)NL * 2 * 2 * NH * 2 * 4 * 64 * 16);
constexpr size_t WS_HCTX = WS_S5T + al((size_t)NL * S5G * S5T_BYTES);
constexpr size_t W_1I = 0, W_1O = W_1I + (size_t)2 * DFF * DM * 2, W_IN = W_1O + (size_t)DM * DFF * 2, W_OUT = W_IN + (size_t)INC * DM * 2,
                 W_2I = W_OUT + (size_t)DM * DM * 2, W_2O = W_2I + (size_t)2 * DFF * DM * 2, W_GLU = W_2O + (size_t)DM * DFF * 2, W_LAYER = al(W_GLU + (size_t)GWD * GWD * 2);
constexpr size_t WS_W = WS_HCTX + al((size_t)MCTX * DM * 4);
constexpr size_t WS_XN = WS_W + NL * W_LAYER;
constexpr size_t WS_Y = WS_XN + al((size_t)M * DM * 2);
constexpr size_t Y_BYTES = ((size_t)M * DM * 2 > (size_t)(DFF / 256) * MCTX * DM * 4) ? (size_t)M * DM * 2 : (size_t)(DFF / 256) * MCTX * DM * 4;
constexpr size_t WS_BIG = WS_Y + al(Y_BYTES);
constexpr size_t BIG_P = 0, BIG_QN = al((size_t)M * INC * 2), BIG_KN = BIG_QN + al((size_t)M * GWD * 2), BIG_VN = BIG_KN + al((size_t)M * NKV * 64 * 2), BIG_END = BIG_VN + al((size_t)M * NKV * 64 * 2);
constexpr size_t BIG_BYTES = ((size_t)M * DFF * 2 > BIG_END) ? al((size_t)M * DFF * 2) : BIG_END;
constexpr size_t WS_END = WS_BIG + BIG_BYTES;
static_assert((size_t)2 * M * GWD * 4 <= (size_t)M * DM * 2, "YS5 overlay fits XN");
static_assert(CFG_DM != 1024 || WS_END <= 290 * MiB, "workspace budget");

constexpr int LDS_BYTES = 147456;
constexpr int LDS_MISC = 131072;

__device__ __forceinline__ unsigned f2bf(float f) { unsigned u = __builtin_bit_cast(unsigned, f); return (u + 0x7fffu + ((u >> 16) & 1u)) >> 16; }
__device__ __forceinline__ float bf2f(unsigned h) { return __builtin_bit_cast(float, h << 16); }
__device__ __forceinline__ unsigned pk2(float lo, float hi) { return f2bf(lo) | (f2bf(hi) << 16); }
__device__ __forceinline__ float bflo(unsigned w) { return __builtin_bit_cast(float, w << 16); }
__device__ __forceinline__ float bfhi(unsigned w) { return __builtin_bit_cast(float, w & 0xffff0000u); }
__device__ __forceinline__ float wave_sum(float v) {
#pragma unroll
    for (int o = 1; o < 64; o <<= 1) v += __shfl_xor(v, o);
    return v;
}
__device__ __forceinline__ float sigmoidf_(float x) { return __builtin_amdgcn_rcpf(1.f + __builtin_amdgcn_exp2f(-1.4426950408889634f * x)); }
__device__ __forceinline__ float siluf_(float x) { return x * sigmoidf_(x); }
__device__ __forceinline__ float geluf_(float x) { const float u = 0.7978845608028654f * (x + 0.044715f * x * x * x); return x * sigmoidf_(2.f * u); }
__device__ __forceinline__ float softplusf_(float x) { return x > 20.f ? x : log1pf(expf(x)); }
__device__ __forceinline__ void ld8bf(const bf16* p, float (&v)[8]) { const u32x4 w = *(const u32x4*)p; v[0] = bflo(w.x); v[1] = bfhi(w.x); v[2] = bflo(w.y); v[3] = bfhi(w.y); v[4] = bflo(w.z); v[5] = bfhi(w.z); v[6] = bflo(w.w); v[7] = bfhi(w.w); }
__device__ __forceinline__ void st8bf(bf16* p, const float (&v)[8]) { u32x4 w; w.x = pk2(v[0], v[1]); w.y = pk2(v[2], v[3]); w.z = pk2(v[4], v[5]); w.w = pk2(v[6], v[7]); *(u32x4*)p = w; }

struct Params { const float* in[N_IN]; float* out; unsigned char* ws; int ph_lo, ph_hi, pad0, pad1; };

struct Ctx {
    const Params* p; unsigned char* ws; LAS unsigned char* lds; int tid, lane, wave, G, bx, gw, NGW, gt, NGT;
    __device__ __forceinline__ const float* in(int i) const { return p->in[i]; }
    __device__ __forceinline__ float* hrow(int row) const { return row < MLAT ? p->out + (size_t)row * DM : (float*)(ws + WS_HCTX) + (size_t)(row - MLAT) * DM; }
    __device__ __forceinline__ bf16* hb(int row) const { return (bf16*)p->out + (size_t)row * DM; }
    __device__ __forceinline__ bf16* hfin(int row) const { return (bf16*)(ws + WS_XN) + (size_t)row * DM; }
    __device__ __forceinline__ const float* mods(int l, int which, int k) const { return (const float*)(ws + WS_MODS) + ((size_t)(l * 3 + which) * NMOD + k) * DM; }
    __device__ __forceinline__ bf16* wl(int l, size_t off) const { return (bf16*)(ws + WS_W + (size_t)l * W_LAYER + off); }
};
__device__ __forceinline__ int row_mi(int row) { return row < MLAT ? row / T : 2; }

__device__ __forceinline__ void ph_ada_partial(const Ctx& c) {
    constexpr int NJB = NMOD * DM / 256; const int nitems = NL * NJB * ADA_KC;
    const float* cc = c.in(I_C); const float* cctx = c.in(I_CCTX);
    for (int it = c.gw; it < nitems; it += c.NGW) {
        const int kc = it % ADA_KC, jb = (it / ADA_KC) % NJB, l = it / (ADA_KC * NJB);
        const float* w = c.in(I_WADA) + (size_t)l * DM * NMOD * DM + (size_t)(kc * 64) * NMOD * DM + jb * 256 + c.lane * 4;
        f32x4 a0 = {0, 0, 0, 0}, a1 = a0, a2 = a0;
#pragma unroll 8
        for (int k = 0; k < 64; ++k) { const f32x4 wv = *(const f32x4*)(w + (size_t)k * NMOD * DM); const int kk = kc * 64 + k;
            const float s0 = siluf_(cc[kk]), s1 = siluf_(cc[DM + kk]), s2 = siluf_(cctx[kk]); a0 += wv * s0; a1 += wv * s1; a2 += wv * s2; }
        float* mp = (float*)(c.ws + WS_MODP) + ((size_t)(kc * NL + l) * 3) * NMOD * DM + jb * 256 + c.lane * 4;
        *(f32x4*)(mp) = a0; *(f32x4*)(mp + NMOD * DM) = a1; *(f32x4*)(mp + 2 * NMOD * DM) = a2;
    }
}
__device__ __forceinline__ void ph_mods_reduce(const Ctx& c) {
    const int n = NL * 3 * NMOD * DM;
    for (int i = c.gt; i < n; i += c.NGT) { const int j = i % (NMOD * DM), l = i / (3 * NMOD * DM);
        float s = c.in(I_BADA)[(size_t)l * NMOD * DM + j];
#pragma unroll
        for (int kc = 0; kc < ADA_KC; ++kc) { const int lw = i / (NMOD * DM); s += ((const float*)(c.ws + WS_MODP))[((size_t)kc * NL * 3 + lw) * NMOD * DM + j]; }
        ((float*)(c.ws + WS_MODS))[i] = s; }
}
__device__ __forceinline__ int cvt_row(int n, int kind) { if (kind == 0) return n; const int j = n < DFF ? n : n - DFF; return (j / 128) * 256 + (n < DFF ? 0 : 128) + (j % 128); }
__device__ __forceinline__ void cvt_item(const Ctx& c, const float* W, int K, int N, bf16* WT, int kind, int item) {
    LAS float* scr = (LAS float*)(c.lds + c.wave * 16384); const int lane = c.lane;
    const int nblk = N / 32, kb = item / nblk, nb = item % nblk, k0 = 64 * kb, n0 = 32 * nb;
#pragma unroll 8
    for (int i = 0; i < 32; ++i) { const int kk = 2 * i + (lane >> 5); scr[kk * 33 + (lane & 31)] = W[(size_t)(k0 + kk) * N + n0 + (lane & 31)]; }
    WAVE_SYNC();
    const int ch = lane & 7;
#pragma unroll
    for (int j = 0; j < 4; ++j) { const int n = (lane >> 3) + 8 * j; const LAS float* sp = scr + (8 * ch) * 33 + n;
        u32x4 o; o.x = pk2(sp[0 * 33], sp[1 * 33]); o.y = pk2(sp[2 * 33], sp[3 * 33]); o.z = pk2(sp[4 * 33], sp[5 * 33]); o.w = pk2(sp[6 * 33], sp[7 * 33]);
        *(u32x4*)(WT + (size_t)cvt_row(n0 + n, kind) * K + k0 + 8 * ch) = o; }
    WAVE_SYNC();
}
__device__ __forceinline__ void ph_cvt_all(const Ctx& c) {
    static_assert(DM % 64 == 0 && DFF % 64 == 0 && GWD % 64 == 0, "transpose items");
    constexpr int I_1I = (DM / 64) * (2 * DFF / 32), I_1O = (DFF / 64) * (DM / 32), I_IN = (DM / 64) * (INC / 32), I_OUT = (DM / 64) * (DM / 32), I_GL = (GWD / 64) * (GWD / 32);
    constexpr int PER_L = 2 * I_1I + 2 * I_1O + I_IN + I_OUT + I_GL;
    for (int it = c.gw; it < NL * PER_L; it += c.NGW) { const int l = it / PER_L; int r = it % PER_L;
        if (r < I_1I) { cvt_item(c, c.in(I_W1I) + (size_t)l * DM * 2 * DFF, DM, 2 * DFF, c.wl(l, W_1I), 1, r); continue; } r -= I_1I;
        if (r < I_1I) { cvt_item(c, c.in(I_W2I) + (size_t)l * DM * 2 * DFF, DM, 2 * DFF, c.wl(l, W_2I), 1, r); continue; } r -= I_1I;
        if (r < I_1O) { cvt_item(c, c.in(I_W1O) + (size_t)l * DFF * DM, DFF, DM, c.wl(l, W_1O), 0, r); continue; } r -= I_1O;
        if (r < I_1O) { cvt_item(c, c.in(I_W2O) + (size_t)l * DFF * DM, DFF, DM, c.wl(l, W_2O), 0, r); continue; } r -= I_1O;
        if (r < I_IN) { cvt_item(c, c.in(I_WIN) + (size_t)l * DM * INC, DM, INC, c.wl(l, W_IN), 0, r); continue; } r -= I_IN;
        if (r < I_OUT) { cvt_item(c, c.in(I_WOUT) + (size_t)l * DM * DM, DM, DM, c.wl(l, W_OUT), 0, r); continue; } r -= I_OUT;
        cvt_item(c, c.in(I_S5GLU) + (size_t)l * GWD * GWD, GWD, GWD, c.wl(l, W_GLU), 0, r);
    }
}
__device__ __forceinline__ void ph_tables(const Ctx& c) {
    float* rope = (float*)(c.ws + WS_ROPE);
    for (int i = c.gt; i < ROPE_NPOS * 16; i += c.NGT) { const int pos = i / 16, k = i % 16; const float ang = (float)pos * powf(10000.f, -(float)k / 16.f); rope[pos * 32 + k] = cosf(ang); rope[pos * 32 + 16 + k] = sinf(ang); }
    u32x4* lw = (u32x4*)(c.ws + WS_LRUW); const int n = NL * 2 * 2 * NH * 2 * 4 * 64;
    for (int i = c.gt; i < n; i += c.NGT) { const int lane = i & 63, ks = (i >> 6) & 3, half = (i >> 8) & 1, blk = (i >> 9) % NH, gate = (i / (512 * NH)) & 1, ld = i / (1024 * NH);
        const int r32 = lane & 31, hi = lane >> 5; const float* w = c.in(gate ? I_LWX : I_LWA) + (((size_t)ld * NH + blk) * 64) * 64 + half * 32 + r32; u32x4 o;
#pragma unroll
        for (int q = 0; q < 4; ++q) { const int d = 16 * ks + 8 * hi + 2 * q; o[q] = pk2(w[(size_t)d * 64], w[(size_t)(d + 1) * 64]); }
        lw[i] = o; }
}
__device__ __forceinline__ void ph_h_init(const Ctx& c) {
    const size_t n4 = (size_t)M * DM / 4;
    for (size_t i = c.gt; i < n4; i += c.NGT) { const size_t e = i * 4; const int row = (int)(e / DM), col = (int)(e % DM);
        const f32x4 v = row < MLAT ? *(const f32x4*)(c.in(I_X) + e) : *(const f32x4*)(c.in(I_CTX) + (e - (size_t)MLAT * DM));
        *(f32x4*)(c.hrow(row) + col) = v; }
}

struct Pending { const bf16* part; int nks, pl, pgate; float pscale; };
__device__ __forceinline__ void ph_norm_mod(const Ctx& c, int l, const float* g, int k_shift, int k_scale, int mrows, const Pending pend = Pending{nullptr, 0, 0, 0, 0.f}, int src_mode = 0) {
    constexpr int NV = DM / 256, U = 2; bf16* XN = (bf16*)(c.ws + WS_XN);
    for (int row0 = c.gw; row0 < mrows; row0 += U * c.NGW) {
        int row[U]; bool ok[U]; float* h[U]; f32x4 v[U][NV]; float s[U];
#pragma unroll
        for (int u = 0; u < U; ++u) { const int r = row0 + u * c.NGW; ok[u] = r < mrows; row[u] = ok[u] ? r : row0; h[u] = c.hrow(row[u]);
            const float* hs = (src_mode == 1 || (src_mode == 2 && row[u] >= MLAT)) ? (row[u] < MLAT ? c.in(I_X) + (size_t)row[u] * DM : c.in(I_CTX) + (size_t)(row[u] - MLAT) * DM) : h[u];
#pragma unroll
            for (int j = 0; j < NV; ++j) { if (row[u] < MLAT && src_mode != 1) { const u32x2 w = *(const u32x2*)(c.hb(row[u]) + j * 256 + c.lane * 4); v[u][j] = (f32x4){bf2f(w.x & 0xffffu), bf2f(w.x >> 16), bf2f(w.y & 0xffffu), bf2f(w.y >> 16)}; }
                else v[u][j] = *(const f32x4*)(hs + j * 256 + c.lane * 4); } }
#pragma unroll
        for (int u = 0; u < U; ++u) if (pend.part && row[u] >= MLAT) { const float* pg = c.mods(pend.pl, 2, pend.pgate);
#pragma unroll
            for (int j = 0; j < NV; ++j) { const int col = j * 256 + c.lane * 4; f32x4 a = {0.f, 0.f, 0.f, 0.f};
                for (int ks = 0; ks < pend.nks; ++ks) { const u32x2 w = *(const u32x2*)(pend.part + ((size_t)ks * MCTX + (row[u] - MLAT)) * DM + col); a += (f32x4){bf2f(w.x & 0xffffu), bf2f(w.x >> 16), bf2f(w.y & 0xffffu), bf2f(w.y >> 16)}; }
                v[u][j] += a * *(const f32x4*)(pg + col) * pend.pscale; if (ok[u]) *(f32x4*)(h[u] + col) = v[u][j]; } }
#pragma unroll
        for (int u = 0; u < U; ++u) { s[u] = 0.f;
#pragma unroll
            for (int j = 0; j < NV; ++j) s[u] += v[u][j].x * v[u][j].x + v[u][j].y * v[u][j].y + v[u][j].z * v[u][j].z + v[u][j].w * v[u][j].w; }
#pragma unroll
        for (int o = 1; o < 64; o <<= 1) {
#pragma unroll
            for (int u = 0; u < U; ++u) s[u] += __shfl_xor(s[u], o); }
#pragma unroll
        for (int u = 0; u < U; ++u) { const float rstd = 1.f / sqrtf(s[u] * (1.f / DM) + EPS);
            const int mi = row_mi(row[u]); const float* sh = c.mods(l, mi, k_shift); const float* sc = c.mods(l, mi, k_scale);
#pragma unroll
            for (int j = 0; j < NV; ++j) { const int col = j * 256 + c.lane * 4; const f32x4 gv = *(const f32x4*)(g + col), shv = *(const f32x4*)(sh + col), scv = *(const f32x4*)(sc + col);
                const f32x4 y = v[u][j] * rstd * gv * (scv + 1.f) + shv; u32x2 w; w.x = pk2(y.x, y.y); w.y = pk2(y.z, y.w); if (ok[u]) *(u32x2*)(XN + (size_t)row[u] * DM + col) = w; } }
    }
}
__device__ __forceinline__ void ph_norm_final(const Ctx& c) {
    constexpr int NV = DM / 256; const float* g = c.in(I_GFINAL);
    for (int row = c.gw; row < MLAT; row += c.NGW) {
        float* h = c.p->out + (size_t)row * DM; const bf16* hl = c.hfin(row); f32x4 v[NV]; float s = 0.f;
#pragma unroll
        for (int j = 0; j < NV; ++j) { const u32x2 w = *(const u32x2*)(hl + j * 256 + c.lane * 4); v[j] = (f32x4){bf2f(w.x & 0xffffu), bf2f(w.x >> 16), bf2f(w.y & 0xffffu), bf2f(w.y >> 16)}; s += v[j].x * v[j].x + v[j].y * v[j].y + v[j].z * v[j].z + v[j].w * v[j].w; }
        const float rstd = 1.f / sqrtf(wave_sum(s) * (1.f / DM) + EPS);
#pragma unroll
        for (int j = 0; j < NV; ++j) { const int col = j * 256 + c.lane * 4; const f32x4 y = v[j] * rstd * *(const f32x4*)(g + col);
#ifdef HOST_EMU
            *(f32x4*)(h + col) = y;
#else
            __builtin_nontemporal_store(y, (f32x4*)(h + col));
#endif
        }
    }
}

struct EpiSwiglu { bf16* G;
    __device__ __forceinline__ void operator()(int row, int j0, const float (&a)[8], const float (&b)[8]) const { float o[8];
#pragma unroll
        for (int i = 0; i < 8; ++i) o[i] = siluf_(a[i]) * b[i];
        st8bf(G + (size_t)row * DFF + j0, o); } };
template <bool FROMX, bool LAST = false> struct EpiResidT { const Ctx* c; int l, k_gate; float scale;
    __device__ __forceinline__ void operator()(int row, int c0, const float (&v)[8]) const { const float* g = c->mods(l, row_mi(row), k_gate) + c0; float h[8];
        if (FROMX) { const float* x = c->in(I_X) + (size_t)row * DM + c0;
#pragma unroll
            for (int i = 0; i < 8; ++i) h[i] = x[i]; } else ld8bf(c->hb(row) + c0, h);
#pragma unroll
        for (int i = 0; i < 8; ++i) h[i] += v[i] * g[i] * scale;
        st8bf((LAST ? c->hfin(row) : c->hb(row)) + c0, h); } };
struct EpiP { bf16* P;
    __device__ __forceinline__ void operator()(int row, int c0, const float (&v)[8]) const { st8bf(P + (size_t)row * INC + c0, v); } };

template <class Epi> __device__ __forceinline__ void gemm_naive_ld(const Ctx& c, const bf16* A, const bf16* Bt, int mrows, int N, int K, int ld, const Epi& E);
template <class Epi> __device__ __forceinline__ void gemm_naive(const Ctx& c, const bf16* A, const bf16* Bt, int mrows, int N, int K, const Epi& E) { gemm_naive_ld(c, A, Bt, mrows, N, K, K, E); }
template <class Epi> __device__ __forceinline__ void gemm_naive_ld(const Ctx& c, const bf16* A, const bf16* Bt, int mrows, int N, int K, int ld, const Epi& E) {
    const int ncg = N / 8; const long nitems = (long)mrows * ncg;
    for (long it = c.gt; it < nitems; it += c.NGT) { const int row = (int)(it / ncg), c0 = (int)(it % ncg) * 8; float acc[8];
#pragma unroll
        for (int i = 0; i < 8; ++i) acc[i] = 0.f;
        const bf16* a = A + (size_t)row * ld;
        for (int k = 0; k < K; k += 8) { float av[8]; ld8bf(a + k, av);
#pragma unroll
            for (int i = 0; i < 8; ++i) { float bv[8]; ld8bf(Bt + (size_t)(c0 + i) * ld + k, bv);
#pragma unroll
                for (int j = 0; j < 8; ++j) acc[i] += av[j] * bv[j]; } }
        E(row, c0, acc); }
}
__device__ __forceinline__ void gemm_naive_swiglu(const Ctx& c, const bf16* A, const bf16* Bt, int mrows, int K, const EpiSwiglu& E) {
    const int ncg = DFF / 8; const long nitems = (long)mrows * ncg;
    for (long it = c.gt; it < nitems; it += c.NGT) { const int row = (int)(it / ncg), j0 = (int)(it % ncg) * 8; float aa[8], ab[8];
#pragma unroll
        for (int i = 0; i < 8; ++i) { aa[i] = 0.f; ab[i] = 0.f; }
        const bf16* a = A + (size_t)row * K; const int ra = (j0 / 128) * 256 + (j0 % 128);
        for (int k = 0; k < K; k += 8) { float av[8]; ld8bf(a + k, av);
#pragma unroll
            for (int i = 0; i < 8; ++i) { float bv[8]; ld8bf(Bt + (size_t)(ra + i) * K + k, bv);
#pragma unroll
                for (int j = 0; j < 8; ++j) aa[i] += av[j] * bv[j];
                ld8bf(Bt + (size_t)(ra + 128 + i) * K + k, bv);
#pragma unroll
                for (int j = 0; j < 8; ++j) ab[i] += av[j] * bv[j]; } }
        E(row, j0, aa, ab); }
}

namespace pg8 {
#define PG8_LAS LAS
typedef unsigned short bf16_t;
typedef short bf16x8 __attribute__((ext_vector_type(8)));
typedef float f32x4 __attribute__((ext_vector_type(4)));
typedef unsigned u32x4 __attribute__((ext_vector_type(4)));
constexpr int BM = 256, BK = 64, HALF = 128, HTB = HALF * BK * 2  , STAGE_BYTES = 8 * HTB, NXCD = 8, WGM = 8;

__host__ __device__ __forceinline__ int lds_byte(int r, int c) { const int st = (r >> 4) * 2 + (c >> 5), rr = r & 15, cc = c & 31, ob = rr * 64 + cc * 2; return st * 1024 + (ob ^ (((ob >> 9) & 1) << 5)); }
__host__ __device__ __forceinline__ void stage_rc(int b, int& R, int& C) { const int st = b / 1024, sb = b % 1024, swz = sb ^ (((sb >> 9) & 1) << 5); R = (st >> 1) * 16 + swz / 64; C = (st & 1) * 32 + (swz % 64) / 2; }
__host__ __device__ __forceinline__ int perm32(int rho) { const int n = rho >> 4, i = rho & 15; return 8 * (i >> 2) + 4 * n + (i & 3); }

struct Unit { int pm, pn; };
struct Gemm { const bf16_t* A; const bf16_t* Bt; int M, N, K, lda, ldb; };

struct StaticOrder {
    int nM, nN, nwg, G, c;
    __host__ __device__ void init(int M, int N, int G_, int c_) { nM = M / BM; nN = N / BM; nwg = nM * nN; G = G_; c = c_; }
    __host__ __device__ bool next(int i, Unit& u) const {
        const long L = (long)i * G + c; if (L >= nwg) return false;
        int wgid = (int)L; { const int q = nwg / NXCD, r = nwg % NXCD, xcd = wgid % NXCD, off = wgid / NXCD; wgid = (xcd < r ? xcd * (q + 1) : r * (q + 1) + (xcd - r) * q) + off; }
        const int nig = WGM * nN, gid = wgid / nig, fm = gid * WGM, gsz = (nM - fm) < WGM ? (nM - fm) : WGM;
        u.pm = fm + ((wgid % nig) % gsz); u.pn = (wgid % nig) / gsz; return true;
    }
    __device__ __forceinline__ void a_ready(const Unit&) const {}
    __device__ __forceinline__ void done(const Unit&) const {}
};
template <class Epi, class Sched, bool ALIGN_EPI = false, bool SP2 = false>
__device__ __forceinline__ void gemm_phase(PG8_LAS unsigned char* lds, const Gemm g, const Sched& S, const Epi& E) {
    const int tid = threadIdx.x, wid = __builtin_amdgcn_readfirstlane(tid >> 6), lane = tid & 63, wr = wid >> 2, wc = wid & 3, fr = lane & 15, fq = lane >> 4;
    const int K = g.K, nt = K / BK;
    unsigned voffA[2], voffB[2];
#pragma unroll
    for (int i = 0; i < 2; ++i) { int R, C; stage_rc(tid * 16 + i * 8192, R, C); const int Rb = Epi::PERM ? ((R & ~31) + perm32(R & 31)) : R;
        voffA[i] = (unsigned)(R * g.lda + C) * 2u; voffB[i] = (unsigned)(Rb * g.ldb + C) * 2u; }
    const size_t kstep = (size_t)(BK * 2);
    const size_t hstepA = (size_t)HALF * g.lda * 2, hstepB = (size_t)HALF * g.ldb * 2;
    const size_t tstepA = 2 * hstepA, tstepB = 2 * hstepB;
    const unsigned ldsw = (unsigned)wid * 1024u;
    const int aoff = lds_byte(wr * 64 + fr, fq * 8), boff = lds_byte(wc * 32 + fr, fq * 8);
#define PG8_SA(b, h) (((b) * 2 + (h)) * HTB)
#define PG8_SB(b, h) ((4 + (b) * 2 + (h)) * HTB)
#define PG8_STAGE(bufoff, gbase, voff) do { _Pragma("unroll") for (int _i = 0; _i < 2; ++_i) \
        __builtin_amdgcn_global_load_lds((const unsigned*)((const char*)(gbase) + (voff)[_i]), (PG8_LAS unsigned*)(lds + (bufoff) + ldsw + _i * 8192), 16, 0, 0); } while (0)
#define PG8_LDA(dst, b, h) do { _Pragma("unroll") for (int m = 0; m < 4; ++m) _Pragma("unroll") for (int k = 0; k < 2; ++k) dst[m][k] = *(const PG8_LAS bf16x8*)(lds + PG8_SA(b, h) + aoff + m * 2048 + k * 1024); } while (0)
#define PG8_LDB(dst, b, h) do { _Pragma("unroll") for (int n = 0; n < 2; ++n) _Pragma("unroll") for (int k = 0; k < 2; ++k) dst[n][k] = *(const PG8_LAS bf16x8*)(lds + PG8_SB(b, h) + boff + n * 2048 + k * 1024); } while (0)
#define PG8_MMA(ai, bj, At, Bt) do { __builtin_amdgcn_s_setprio(1); _Pragma("unroll") for (int m = 0; m < 4; ++m) _Pragma("unroll") for (int n = 0; n < 2; ++n) _Pragma("unroll") for (int k = 0; k < 2; ++k) \
        acc[ai][bj][m][n] = __builtin_amdgcn_mfma_f32_16x16x32_bf16(Bt[n][k], At[m][k], acc[ai][bj][m][n], 0, 0, 0); __builtin_amdgcn_s_setprio(0); } while (0)
#ifdef HOST_EMU
#define PG8_WAIT_V(n) ((void)0)
#define PG8_WAIT_L(n) ((void)0)
#else
#define PG8_WAIT_V(n) asm volatile("s_waitcnt vmcnt(" #n ")" ::: "memory")
#define PG8_WAIT_L(n) asm volatile("s_waitcnt lgkmcnt(" #n ")" ::: "memory")
#endif
#define PG8_BAR __builtin_amdgcn_s_barrier()
#define PG8_SCHED __builtin_amdgcn_sched_barrier(0)
    Unit cur, nxt; int ui = 0;
    if (!S.next(0, cur)) return;
    f32x4 acc[2][2][4][2];
#pragma unroll
    for (int a = 0; a < 2; ++a)
#pragma unroll
        for (int b = 0; b < 2; ++b)
#pragma unroll
            for (int m = 0; m < 4; ++m)
#pragma unroll
                for (int n = 0; n < 2; ++n) acc[a][b][m][n] = (f32x4){0.f, 0.f, 0.f, 0.f};
    bf16x8 At[4][2], B0[2][2], B1[2][2];
    const char* cA = (const char*)g.A + (size_t)cur.pm * tstepA; const char* cB = (const char*)g.Bt + (size_t)cur.pn * tstepB;
    S.a_ready(cur);
    if constexpr (SP2) {
        PG8_STAGE(PG8_SB(0, 0), cB, voffB); PG8_STAGE(PG8_SB(0, 1), cB + hstepB, voffB); PG8_STAGE(PG8_SA(0, 0), cA, voffA); PG8_STAGE(PG8_SA(0, 1), cA + hstepA, voffA);
        if (wr == 1) PG8_BAR;
        PG8_WAIT_V(2); PG8_BAR;
        PG8_STAGE(PG8_SB(1, 0), cB + kstep, voffB); PG8_STAGE(PG8_SA(1, 0), cA + kstep, voffA); PG8_STAGE(PG8_SB(1, 1), cB + hstepB + kstep, voffB);
        PG8_WAIT_V(6); PG8_BAR;
    } else {
        PG8_STAGE(PG8_SB(0, 0), cB, voffB); PG8_STAGE(PG8_SA(0, 0), cA, voffA); PG8_STAGE(PG8_SB(0, 1), cB + hstepB, voffB); PG8_STAGE(PG8_SA(0, 1), cA + hstepA, voffA);
        if (wr == 1) PG8_BAR;
        PG8_WAIT_V(4); PG8_BAR;
        PG8_STAGE(PG8_SB(1, 0), cB + kstep, voffB); PG8_STAGE(PG8_SA(1, 0), cA + kstep, voffA); PG8_STAGE(PG8_SB(1, 1), cB + hstepB + kstep, voffB);
        PG8_WAIT_V(6); PG8_BAR;
    }
    for (;;) {
        const bool has_next = S.next(ui + 1, nxt);
        const char* nA = has_next ? (const char*)g.A + (size_t)nxt.pm * tstepA : cA; const char* nB = has_next ? (const char*)g.Bt + (size_t)nxt.pn * tstepB : cB;
#pragma unroll 1
        for (int t = 0; t < nt; t += 2) {
            const bool last = (t == nt - 2);
            const char* a1 = cA + (size_t)(t + 1) * kstep;
            const char* a2 = last ? nA : cA + (size_t)(t + 2) * kstep; const char* b2 = last ? nB : cB + (size_t)(t + 2) * kstep;
            const char* a3 = a2 + kstep; const char* b3 = b2 + kstep;
            if (last && has_next) S.a_ready(nxt);
            if constexpr (SP2) {
            PG8_LDB(B0, 0, 0); PG8_LDB(B1, 0, 1); PG8_SCHED; PG8_LDA(At, 0, 0); PG8_STAGE(PG8_SA(1, 1), a1 + hstepA, voffA);
            PG8_WAIT_V(8); PG8_WAIT_L(0); PG8_BAR; PG8_MMA(0, 0, At, B0); PG8_MMA(0, 1, At, B1); PG8_BAR; PG8_SCHED;
            PG8_LDA(At, 0, 1); PG8_STAGE(PG8_SB(0, 0), b2, voffB); PG8_STAGE(PG8_SB(0, 1), b2 + hstepB, voffB); PG8_STAGE(PG8_SA(0, 0), a2, voffA);
            PG8_WAIT_V(8); PG8_WAIT_L(0); PG8_BAR; PG8_MMA(1, 0, At, B0); PG8_MMA(1, 1, At, B1); PG8_BAR; PG8_SCHED;
            PG8_LDB(B0, 1, 0); PG8_LDB(B1, 1, 1); PG8_SCHED; PG8_LDA(At, 1, 0); PG8_STAGE(PG8_SA(0, 1), a2 + hstepA, voffA);
            PG8_WAIT_V(8); PG8_WAIT_L(0); PG8_BAR; PG8_MMA(0, 0, At, B0); PG8_MMA(0, 1, At, B1); PG8_BAR; PG8_SCHED;
            PG8_LDA(At, 1, 1); PG8_STAGE(PG8_SB(1, 0), b3, voffB); PG8_STAGE(PG8_SB(1, 1), b3 + hstepB, voffB); PG8_STAGE(PG8_SA(1, 0), a3, voffA);
            PG8_WAIT_V(8); PG8_WAIT_L(0); PG8_BAR; PG8_MMA(1, 0, At, B0); PG8_MMA(1, 1, At, B1); PG8_BAR; PG8_SCHED;
            } else {
            PG8_LDB(B0, 0, 0); PG8_SCHED; PG8_LDA(At, 0, 0); PG8_STAGE(PG8_SA(1, 1), a1 + hstepA, voffA);
            PG8_WAIT_L(8); PG8_BAR; PG8_WAIT_L(0); PG8_MMA(0, 0, At, B0); PG8_BAR; PG8_SCHED;
            PG8_LDB(B1, 0, 1); PG8_STAGE(PG8_SB(0, 0), b2, voffB);
            PG8_BAR; PG8_WAIT_L(0); PG8_MMA(0, 1, At, B1); PG8_BAR;
            PG8_LDA(At, 0, 1); PG8_STAGE(PG8_SA(0, 0), a2, voffA);
            PG8_BAR; PG8_WAIT_L(0); PG8_MMA(1, 0, At, B0); PG8_BAR; PG8_SCHED;
            PG8_STAGE(PG8_SB(0, 1), b2 + hstepB, voffB);
            PG8_WAIT_V(6); PG8_BAR; PG8_MMA(1, 1, At, B1); PG8_BAR;
            PG8_LDB(B0, 1, 0); PG8_SCHED; PG8_LDA(At, 1, 0); PG8_STAGE(PG8_SA(0, 1), a2 + hstepA, voffA);
            PG8_WAIT_L(8); PG8_BAR; PG8_WAIT_L(0); PG8_MMA(0, 0, At, B0); PG8_BAR; PG8_SCHED;
            PG8_LDB(B1, 1, 1); PG8_STAGE(PG8_SB(1, 0), b3, voffB);
            PG8_BAR; PG8_WAIT_L(0); PG8_MMA(0, 1, At, B1); PG8_BAR;
            PG8_LDA(At, 1, 1); PG8_STAGE(PG8_SA(1, 0), a3, voffA);
            PG8_BAR; PG8_WAIT_L(0); PG8_MMA(1, 0, At, B0); PG8_BAR; PG8_SCHED;
            PG8_STAGE(PG8_SB(1, 1), b3 + hstepB, voffB);
            PG8_WAIT_V(6); PG8_BAR; PG8_MMA(1, 1, At, B1); PG8_BAR;
            }
        }
        if constexpr (ALIGN_EPI) { if (wr == 0) PG8_BAR; }
        if constexpr (!Epi::AFTER_DRAIN) { E(acc, cur, wr, wc, fr, fq); S.done(cur); }
        if (!has_next) break;
#pragma unroll
        for (int a = 0; a < 2; ++a)
#pragma unroll
            for (int b = 0; b < 2; ++b)
#pragma unroll
                for (int m = 0; m < 4; ++m)
#pragma unroll
                    for (int n = 0; n < 2; ++n) acc[a][b][m][n] = (f32x4){0.f, 0.f, 0.f, 0.f};
        cur = nxt; cA = nA; cB = nB; ++ui;
        if constexpr (ALIGN_EPI) { if (wr == 1) PG8_BAR; }
    }
    PG8_WAIT_V(0);
    if constexpr (!ALIGN_EPI) { if (wr == 0) PG8_BAR; }
    PG8_BAR;
    if constexpr (Epi::AFTER_DRAIN) { E.fused(acc, cur, wr, wc, fr, fq, lds, wid, lane); S.done(cur); }
#undef PG8_SA
#undef PG8_SB
#undef PG8_STAGE
#undef PG8_LDA
#undef PG8_LDB
#undef PG8_MMA
#undef PG8_WAIT_V
#undef PG8_WAIT_L
#undef PG8_BAR
#undef PG8_SCHED
}
}

template <class E8> struct PgEpi { static constexpr bool PERM = true, AFTER_DRAIN = false; E8 e;
    __device__ __forceinline__ void operator()(const pg8::f32x4 (&acc)[2][2][4][2], const pg8::Unit& u, int wr, int wc, int fr, int fq) const {
#pragma unroll
        for (int ai = 0; ai < 2; ++ai)
#pragma unroll
            for (int m = 0; m < 4; ++m) { const int row = u.pm * 256 + ai * 128 + wr * 64 + m * 16 + fr;
#pragma unroll
                for (int bj = 0; bj < 2; ++bj) { const int c0 = u.pn * 256 + bj * 128 + wc * 32 + 8 * fq;
                    const float v[8] = {acc[ai][bj][m][0][0], acc[ai][bj][m][0][1], acc[ai][bj][m][0][2], acc[ai][bj][m][0][3], acc[ai][bj][m][1][0], acc[ai][bj][m][1][1], acc[ai][bj][m][1][2], acc[ai][bj][m][1][3]};
                    e(row, c0, v); } } } };
struct PgEpiSwiglu { static constexpr bool PERM = true, AFTER_DRAIN = false; EpiSwiglu e;
    __device__ __forceinline__ void operator()(const pg8::f32x4 (&acc)[2][2][4][2], const pg8::Unit& u, int wr, int wc, int fr, int fq) const {
#pragma unroll
        for (int ai = 0; ai < 2; ++ai)
#pragma unroll
            for (int m = 0; m < 4; ++m) { const int row = u.pm * 256 + ai * 128 + wr * 64 + m * 16 + fr; const int j0 = u.pn * 128 + wc * 32 + 8 * fq;
                const float a[8] = {acc[ai][0][m][0][0], acc[ai][0][m][0][1], acc[ai][0][m][0][2], acc[ai][0][m][0][3], acc[ai][0][m][1][0], acc[ai][0][m][1][1], acc[ai][0][m][1][2], acc[ai][0][m][1][3]};
                const float b[8] = {acc[ai][1][m][0][0], acc[ai][1][m][0][1], acc[ai][1][m][0][2], acc[ai][1][m][0][3], acc[ai][1][m][1][0], acc[ai][1][m][1][1], acc[ai][1][m][1][2], acc[ai][1][m][1][3]};
                e(row, j0, a, b); } } };
template <bool FROMX, bool LAST> struct PgEpi<EpiResidT<FROMX, LAST>> { static constexpr bool PERM = true, AFTER_DRAIN = false; EpiResidT<FROMX, LAST> e;
    __device__ __forceinline__ void operator()(const pg8::f32x4 (&acc)[2][2][4][2], const pg8::Unit& u, int wr, int wc, int fr, int fq) const {
        const int row00 = u.pm * 256 + wr * 64 + fr, c00 = u.pn * 256 + wc * 32 + 8 * fq; const int mi = row_mi(u.pm * 256);
        if constexpr (!FROMX) {
            u32x4 hw[2][2][4];
#pragma unroll
            for (int bj = 0; bj < 2; ++bj)
#pragma unroll
                for (int ai = 0; ai < 2; ++ai)
#pragma unroll
                    for (int m = 0; m < 4; ++m) hw[bj][ai][m] = *(const u32x4*)(e.c->hb(row00 + ai * 128 + m * 16) + c00 + bj * 128);
#pragma unroll
            for (int bj = 0; bj < 2; ++bj) { const int c0 = c00 + bj * 128; const float* g = e.c->mods(e.l, mi, e.k_gate) + c0;
                const f32x4 g0 = *(const f32x4*)g * e.scale, g1 = *(const f32x4*)(g + 4) * e.scale;
#pragma unroll
                for (int ai = 0; ai < 2; ++ai)
#pragma unroll
                    for (int m = 0; m < 4; ++m) { const int row = row00 + ai * 128 + m * 16; const u32x4 w0 = hw[bj][ai][m];
                        const f32x4 a = (f32x4){bf2f(w0.x & 0xffffu), bf2f(w0.x >> 16), bf2f(w0.y & 0xffffu), bf2f(w0.y >> 16)} + acc[ai][bj][m][0] * g0, b = (f32x4){bf2f(w0.z & 0xffffu), bf2f(w0.z >> 16), bf2f(w0.w & 0xffffu), bf2f(w0.w >> 16)} + acc[ai][bj][m][1] * g1;
                        u32x4 w; w.x = pk2(a.x, a.y); w.y = pk2(a.z, a.w); w.z = pk2(b.x, b.y); w.w = pk2(b.z, b.w); *(u32x4*)((LAST ? e.c->hfin(row) : e.c->hb(row)) + c0) = w; } }
        } else {
#pragma unroll
        for (int bj = 0; bj < 2; ++bj) { const int c0 = c00 + bj * 128; const float* g = e.c->mods(e.l, mi, e.k_gate) + c0;
            const f32x4 g0 = *(const f32x4*)g * e.scale, g1 = *(const f32x4*)(g + 4) * e.scale;
#pragma unroll
            for (int ai = 0; ai < 2; ++ai) { f32x4 h0[4], h1[4];
#pragma unroll
                for (int m = 0; m < 4; ++m) { const int row = row00 + ai * 128 + m * 16; const float* hb = e.c->in(I_X) + (size_t)row * DM + c0; h0[m] = *(const f32x4*)hb; h1[m] = *(const f32x4*)(hb + 4); }
#pragma unroll
                for (int m = 0; m < 4; ++m) { const int row = row00 + ai * 128 + m * 16; const f32x4 a = h0[m] + acc[ai][bj][m][0] * g0, b = h1[m] + acc[ai][bj][m][1] * g1;
                    u32x4 w; w.x = pk2(a.x, a.y); w.y = pk2(a.z, a.w); w.z = pk2(b.x, b.y); w.w = pk2(b.z, b.w); *(u32x4*)((LAST ? e.c->hfin(row) : e.c->hb(row)) + c0) = w; } } }
        } } };
#ifndef USE_PG8
#define USE_PG8 1
#endif
template <class E8> __device__ __forceinline__ void gemm_run(const Ctx& c, const bf16* A, const bf16* Bt, int mrows, int N, int K, const E8& e) {
#if USE_PG8
    pg8::Gemm g{A, Bt, mrows, N, K, K, K}; pg8::StaticOrder S; S.init(mrows, N, c.G, c.bx); PgEpi<E8> E{e};
    pg8::gemm_phase<PgEpi<E8>, pg8::StaticOrder, true, true>(c.lds, g, S, E);
#else
    gemm_naive(c, A, Bt, mrows, N, K, e);
#endif
}
__device__ __forceinline__ void gemm_run_swiglu(const Ctx& c, const bf16* A, const bf16* Bt, int mrows, int K, const EpiSwiglu& e) {
#if USE_PG8
    pg8::Gemm g{A, Bt, mrows, 2 * DFF, K, K, K}; pg8::StaticOrder S; S.init(mrows, 2 * DFF, c.G, c.bx); PgEpiSwiglu E{e};
    pg8::gemm_phase<PgEpiSwiglu, pg8::StaticOrder, false, true>(c.lds, g, S, E);
#else
    gemm_naive_swiglu(c, A, Bt, mrows, K, e);
#endif
}

struct EpiPartial { bf16* part;
    __device__ __forceinline__ void operator()(int row, int c0, const float (&v)[8]) const { st8bf(part + (size_t)row * DM + c0, v); } };
struct OneUnit { pg8::Unit u; bool has;
    __device__ __forceinline__ bool next(int i, pg8::Unit& o) const { if (i == 0 && has) { o = u; return true; } return false; }
    __device__ __forceinline__ void a_ready(const pg8::Unit&) const {}
    __device__ __forceinline__ void done(const pg8::Unit&) const {} };
template <bool FROMX = false, bool LAST = false> __device__ __forceinline__ void gemm_resid_all(const Ctx& c, const bf16* A, const bf16* Bt, int N, int K, int l, int k_gate, float scale, bool with_ctx, bf16* part, const float* xin = nullptr) {
    { EpiResidT<FROMX, LAST> E{&c, l, k_gate, scale}; gemm_run(c, A, Bt, MLAT, N, K, E); }
#if USE_PG8
    if (with_ctx) { constexpr int KP = 256; const int nks = K / KP, ncol = N / 256, npieces = (MCTX / 256) * ncol * nks;
        for (int pi = c.G - 1 - c.bx; pi < npieces; pi += c.G) {
        OneUnit S; S.has = true; const int ks = pi % nks, pn = (pi / nks) % ncol, pm = pi / (nks * ncol); S.u.pm = pm; S.u.pn = pn;
        pg8::Gemm g{A + (size_t)MLAT * K + (size_t)ks * KP, Bt + (size_t)ks * KP, MCTX, N, KP, K, K}; PgEpi<EpiPartial> E{EpiPartial{part + (size_t)ks * MCTX * DM}};
        pg8::gemm_phase<PgEpi<EpiPartial>, OneUnit, true, true>(c.lds, g, S, E); } }
#else
    if (with_ctx) { for (int ks = 0; ks < K / 256; ++ks) { EpiPartial E{part + (size_t)ks * MCTX * DM}; gemm_naive_ld(c, A + (size_t)MLAT * K + ks * 256, Bt + ks * 256, MCTX, N, 256, K, E); } }
#endif
}

struct S5Lane { float ar, ai, fr, fi; float bre[16], bim[16], cre[16], cim[16]; };
__device__ __forceinline__ void s5_load(const Ctx& c, int l, int dir, int g, int p, S5Lane& S) {
    const size_t gi = ((size_t)(l * 2 + dir) * S5G + g);
    const float lr = c.in(I_S5LRE)[gi * 64 + p], li = c.in(I_S5LIM)[gi * 64 + p], dt = expf(c.in(I_S5STEP)[gi]);
    const float th = li * dt, em1 = expm1f(lr * dt), cs = cosf(th), sn = sinf(th), sh = sinf(0.5f * th);
    const float arm1 = em1 * cs - 2.f * sh * sh;
    S.ar = 1.f + arm1; S.ai = (em1 + 1.f) * sn;
    const float den = lr * lr + li * li; S.fr = (arm1 * lr + S.ai * li) / den; S.fi = (S.ai * lr - arm1 * li) / den;
    const float* br = c.in(I_S5BRE) + (gi * 64 + p) * 16; const float* bi = c.in(I_S5BIM) + (gi * 64 + p) * 16;
#pragma unroll
    for (int h = 0; h < 16; ++h) { S.bre[h] = br[h]; S.bim[h] = bi[h]; S.cre[h] = c.in(I_S5CRE)[(gi * 16 + h) * 64 + p]; S.cim[h] = c.in(I_S5CIM)[(gi * 16 + h) * 64 + p]; }
}
__device__ __forceinline__ int s5_row(int b, int dir, int i) {
    if (i < TC) return MLAT + b * TC + (dir ? TC - 1 - i : i);
    const int t = i - TC; return b * T + (dir ? T - 1 - t : t);
}
__device__ __forceinline__ void s5_step(const S5Lane& S, const bf16* urow, float& sr, float& si) {
    float u[16]; { float t0[8], t1[8]; ld8bf(urow, t0); ld8bf(urow + 8, t1);
#pragma unroll
        for (int i = 0; i < 8; ++i) { u[i] = t0[i]; u[8 + i] = t1[i]; } }
    float wr = 0.f, wi = 0.f;
#pragma unroll
    for (int h = 0; h < 16; ++h) { wr += S.bre[h] * u[h]; wi += S.bim[h] * u[h]; }
    const float xr = S.fr * wr - S.fi * wi, xi = S.fr * wi + S.fi * wr;
    const float nr = S.ar * sr - S.ai * si + xr, ni = S.ar * si + S.ai * sr + xi; sr = nr; si = ni;
}
__device__ __forceinline__ void ph_s5_a(const Ctx& c, int l) {
    const bf16* P = (const bf16*)(c.ws + WS_BIG + BIG_P); float* E = (float*)(c.ws + WS_S5E);
    const int nitems = NB * S5G * 2 * (NCH5 - 1);
    for (int it = c.gw; it < nitems; it += c.NGW) { const int ch = it % (NCH5 - 1), dir = (it / (NCH5 - 1)) % 2, g = (it / (2 * (NCH5 - 1))) % S5G, b = it / (2 * (NCH5 - 1) * S5G);
        S5Lane S; s5_load(c, l, dir, g, c.lane, S); float sr = 0.f, si = 0.f;
        for (int i = ch * LS5; i < (ch + 1) * LS5; ++i) s5_step(S, P + (size_t)s5_row(b, dir, i) * INC + PC_S5 + g * 16, sr, si);
        float* e = E + ((((size_t)(b * S5G + g) * 2 + dir) * NCH5 + ch) * 64 + c.lane) * 2; e[0] = sr; e[1] = si; }
}
__device__ __forceinline__ void ph_s5_b(const Ctx& c, int l) {
    const bf16* P = (const bf16*)(c.ws + WS_BIG + BIG_P); const float* E = (const float*)(c.ws + WS_S5E); float* YS = (float*)(c.ws + WS_XN);
    const int nitems = NB * S5G * 2 * NCH5;
    for (int it = c.gw; it < nitems; it += c.NGW) { const int ch = it % NCH5, dir = (it / NCH5) % 2, g = (it / (2 * NCH5)) % S5G, b = it / (2 * NCH5 * S5G);
        S5Lane S; s5_load(c, l, dir, g, c.lane, S);
        const float* e = E + ((((size_t)(b * S5G + g) * 2 + dir) * NCH5 + ch) * 64 + c.lane) * 2;
        float sr = e[0], si = e[1];
        for (int i = ch * LS5; i < (ch + 1) * LS5; ++i) { const int row = s5_row(b, dir, i);
            s5_step(S, P + (size_t)row * INC + PC_S5 + g * 16, sr, si);
            float v[16];
#pragma unroll
            for (int h = 0; h < 16; ++h) v[h] = S.cre[h] * sr - S.cim[h] * si;
            float w8[8];
            { const bool hi = (c.lane & 32) != 0;
#pragma unroll
              for (int k = 0; k < 8; ++k) { const float send = hi ? v[k] : v[8 + k]; const float keep = hi ? v[8 + k] : v[k]; w8[k] = keep + __shfl_xor(send, 32); } }
            float w4[4];
            { const bool hi = (c.lane & 16) != 0;
#pragma unroll
              for (int k = 0; k < 4; ++k) { const float send = hi ? w8[k] : w8[4 + k]; const float keep = hi ? w8[4 + k] : w8[k]; w4[k] = keep + __shfl_xor(send, 16); } }
            float w2[2];
            { const bool hi = (c.lane & 8) != 0;
#pragma unroll
              for (int k = 0; k < 2; ++k) { const float send = hi ? w4[k] : w4[2 + k]; const float keep = hi ? w4[2 + k] : w4[k]; w2[k] = keep + __shfl_xor(send, 8); } }
            float w1;
            { const bool hi = (c.lane & 4) != 0; const float send = hi ? w2[0] : w2[1]; const float keep = hi ? w2[1] : w2[0]; w1 = keep + __shfl_xor(send, 4); }
            w1 += __shfl_xor(w1, 2); w1 += __shfl_xor(w1, 1);
            if ((c.lane & 3) == 0) YS[((size_t)dir * M + row) * GWD + g * 16 + (c.lane >> 2)] = w1;
        } }
}
__device__ __forceinline__ void lru_carry_block(const Ctx& c, int it) {
    float* E = (float*)(c.ws + WS_LRUE); constexpr int NEB = GWD / 64, SEG = (NTL + 7) / 8; const int eb = it % NEB, dir = (it / NEB) % 2, b = it / (2 * NEB);
    float* e = E + ((size_t)(b * 2 + dir) * NTL) * GWD * 2 + (eb * 64 + c.lane) * 2; LAS float* sm = (LAS float*)c.lds;
    float pa[SEG], he[SEG]; float A = 1.f, B = 0.f;
#pragma unroll
    for (int j = 0; j < SEG; ++j) { const int i = c.wave * SEG + j; const int ic = i < NTL ? i : NTL - 1; const int tile = dir == 0 ? ic : (ic < NCT ? NCT - 1 - ic : NTL - 1 - (ic - NCT));
        pa[j] = e[(size_t)tile * GWD * 2]; he[j] = e[(size_t)tile * GWD * 2 + 1]; if (i >= NTL) { pa[j] = 1.f; he[j] = 0.f; } }
#pragma unroll
    for (int j = 0; j < SEG; ++j) { B = pa[j] * B + he[j]; A *= pa[j]; }
    sm[(c.wave * 64 + c.lane) * 2] = A; sm[(c.wave * 64 + c.lane) * 2 + 1] = B;
    __syncthreads();
    float h = 0.f;
    for (int w = 0; w < c.wave; ++w) h = sm[(w * 64 + c.lane) * 2] * h + sm[(w * 64 + c.lane) * 2 + 1];
#pragma unroll
    for (int j = 0; j < SEG; ++j) { const int i = c.wave * SEG + j; if (i < NTL) { const int tile = dir == 0 ? i : (i < NCT ? NCT - 1 - i : NTL - 1 - (i - NCT)); e[(size_t)tile * GWD * 2 + 1] = h; h = pa[j] * h + he[j]; } }
    __syncthreads();
}
__device__ __forceinline__ void s5_carry_block(const Ctx& c, int l, int it) {
    float* E = (float*)(c.ws + WS_S5E); const int dir = it % 2, g = (it / 2) % S5G, b = it / (2 * S5G); constexpr int SEG = (NCH5 + 7) / 8;
    const size_t gi = ((size_t)(l * 2 + dir) * S5G + g);
    const float lr = c.in(I_S5LRE)[gi * 64 + c.lane], li = c.in(I_S5LIM)[gi * 64 + c.lane], dt = expf(c.in(I_S5STEP)[gi]);
    const float th = li * dt, em1 = expm1f(lr * dt), sh = sinf(0.5f * th);
    float pr = 1.f + (em1 * cosf(th) - 2.f * sh * sh), pi = (em1 + 1.f) * sinf(th);
#pragma unroll
    for (int s = 1; s < LS5; s <<= 1) { const float nr = pr * pr - pi * pi, ni = 2.f * pr * pi; pr = nr; pi = ni; }
    float* e = E + ((((size_t)(b * S5G + g) * 2 + dir) * NCH5) * 64 + c.lane) * 2; LAS float* sm = (LAS float*)c.lds;
    float er[SEG], ei[SEG]; float Ar = 1.f, Ai = 0.f, Br = 0.f, Bi = 0.f;
#pragma unroll
    for (int j = 0; j < SEG; ++j) { const int ch = c.wave * SEG + j; const int cc = ch < NCH5 ? ch : NCH5 - 1; er[j] = e[(size_t)cc * 128]; ei[j] = e[(size_t)cc * 128 + 1]; }
#pragma unroll
    for (int j = 0; j < SEG; ++j) { const int ch = c.wave * SEG + j; if (ch < NCH5) { const float nr = pr * Br - pi * Bi + er[j], ni = pr * Bi + pi * Br + ei[j]; Br = nr; Bi = ni; const float ar = pr * Ar - pi * Ai, ai = pr * Ai + pi * Ar; Ar = ar; Ai = ai; } }
    { LAS float* q = sm + (c.wave * 64 + c.lane) * 4; q[0] = Ar; q[1] = Ai; q[2] = Br; q[3] = Bi; }
    __syncthreads();
    float sr = 0.f, si = 0.f;
    for (int w = 0; w < c.wave; ++w) { const LAS float* q = sm + (w * 64 + c.lane) * 4; const float nr = q[0] * sr - q[1] * si + q[2], ni = q[0] * si + q[1] * sr + q[3]; sr = nr; si = ni; }
#pragma unroll
    for (int j = 0; j < SEG; ++j) { const int ch = c.wave * SEG + j; if (ch < NCH5) { e[(size_t)ch * 128] = sr; e[(size_t)ch * 128 + 1] = si; const float nr = pr * sr - pi * si + er[j], ni = pr * si + pi * sr + ei[j]; sr = nr; si = ni; } }
    __syncthreads();
}
__device__ __forceinline__ void ph_carries(const Ctx& c, int l) {
    constexpr int N5 = NB * S5G * 2, NLR = NB * 2 * (GWD / 64);
    __syncthreads();
    for (int it = c.bx; it < N5 + NLR; it += c.G) { if (it < N5) s5_carry_block(c, l, it); else lru_carry_block(c, it - N5); }
}
__device__ __forceinline__ void ph_s5_z(const Ctx& c, int l, int mrows) {
    const bf16* P = (const bf16*)(c.ws + WS_BIG + BIG_P); const float* YS = (const float*)(c.ws + WS_XN); bf16* Y = (bf16*)(c.ws + WS_Y); const float* d = c.in(I_S5D) + (size_t)l * GWD;
    const int n8 = mrows * (GWD / 8);
    for (int i = c.gt; i < n8; i += c.NGT) { const int row = i / (GWD / 8), ch = (i % (GWD / 8)) * 8; float u[8], z[8]; ld8bf(P + (size_t)row * INC + PC_S5 + ch, u);
        const f32x4 f0 = *(const f32x4*)(YS + (size_t)row * GWD + ch), f1 = *(const f32x4*)(YS + (size_t)row * GWD + ch + 4), b0 = *(const f32x4*)(YS + ((size_t)M + row) * GWD + ch), b1 = *(const f32x4*)(YS + ((size_t)M + row) * GWD + ch + 4);
        const f32x4 d0 = *(const f32x4*)(d + ch), d1 = *(const f32x4*)(d + ch + 4);
#pragma unroll
        for (int j = 0; j < 4; ++j) { z[j] = geluf_(d0[j] * u[j] + f0[j] + b0[j]); z[4 + j] = geluf_(d1[j] * u[4 + j] + f1[j] + b1[j]); }
        st8bf(Y + (size_t)row * DM + ch, z); }
}
struct EpiGlu { bf16* Y;
    __device__ __forceinline__ void operator()(int row, int c0, const float (&v)[8]) const { float z[8], o[8]; ld8bf(Y + (size_t)row * DM + c0, z);
#pragma unroll
        for (int i = 0; i < 8; ++i) o[i] = z[i] * sigmoidf_(v[i]);
        st8bf(Y + (size_t)row * DM + c0, o); } };

__device__ __forceinline__ int lru_tile_row0(int b, int tile) { return tile < NCT ? MLAT + b * TC + tile * LL : b * T + (tile - NCT) * LL; }
template <bool PASS_B> __device__ __forceinline__ void ph_lru(const Ctx& c, int l, bool need_ctx) {
    const bf16* P = (const bf16*)(c.ws + WS_BIG + BIG_P); float* E = (float*)(c.ws + WS_LRUE); bf16* Y = (bf16*)(c.ws + WS_Y);
    LAS float* XC = (LAS float*)c.lds;
    LAS float* HT = XC + LL * GWD;
    const int e = c.tid % GWD, dir = (c.tid / GWD) & 1; const bool active = c.tid < 2 * GWD;
    const int blk = e / 64, el = e % 64;
    float wa[64], wx[64];
    { const float* pa = c.in(I_LWA) + (((size_t)(l * 2 + dir) * NH + blk) * 64) * 64 + el; const float* px = c.in(I_LWX) + (((size_t)(l * 2 + dir) * NH + blk) * 64) * 64 + el;
#pragma unroll
      for (int d = 0; d < 64; ++d) { wa[d] = pa[d * 64]; wx[d] = px[d * 64]; } }
    const float ba = c.in(I_LBA)[(size_t)(l * 2 + dir) * GWD + e], bx = c.in(I_LBX)[(size_t)(l * 2 + dir) * GWD + e];
    const float sp = softplusf_(-c.in(I_LLAM)[(size_t)(l * 2 + dir) * GWD + e]);
    const int nitems = NB * NTL;
    for (int it = c.bx; it < nitems; it += c.G) { const int tile = it % NTL, b = it / NTL; const bool is_ctx = tile < NCT;
        const int row0 = lru_tile_row0(b, tile); const int t0 = (is_ctx ? tile : tile - NCT) * LL, tlen = is_ctx ? TC : T; const int seq0 = row0 - t0;
        __syncthreads();
        for (int i = c.tid; i < LL * GWD; i += NT) { const int t = i / GWD, ch = i % GWD; float s = c.in(I_LCB)[(size_t)l * GWD + ch];
#pragma unroll
            for (int k = 0; k < 4; ++k) { const int tt = t0 + t + k - 2; if (tt >= 0 && tt < tlen) s += c.in(I_LCW)[((size_t)l * 4 + k) * GWD + ch] * bf2f(P[(size_t)(seq0 + tt) * INC + PC_LX + ch]); }
            XC[i] = s; }
        __syncthreads();
        if (active) {
            float h = 0.f, pa = 1.f;
            if (PASS_B) h = E[(((size_t)(b * 2 + dir) * NTL + tile) * GWD + e) * 2 + 1];
            for (int s = 0; s < LL; ++s) { const int t = dir ? LL - 1 - s : s; const LAS float* xr = XC + t * GWD + blk * 64;
                float r = ba, ig = bx;
#pragma unroll
                for (int d = 0; d < 64; ++d) { const float xv = xr[d]; r += xv * wa[d]; ig += xv * wx[d]; }
                r = sigmoidf_(r); ig = sigmoidf_(ig);
                const float la = -8.f * r * sp, a = expf(la), bb = sqrtf(-expm1f(2.f * la)) * (ig * xr[el]);
                h = a * h + bb; pa *= a;
                if (PASS_B) HT[(dir * LL + t) * GWD + e] = h; }
            if (!PASS_B) { float* eo = E + (((size_t)(b * 2 + dir) * NTL + tile) * GWD + e) * 2; eo[0] = pa; eo[1] = h; }
        }
        if (PASS_B) { __syncthreads();
            if (!is_ctx || need_ctx) for (int i = c.tid; i < LL * GWD; i += NT) { const int t = i / GWD, ch = i % GWD; const int row = row0 + t;
                const float gt = bf2f(P[(size_t)row * INC + PC_LG + ch]); Y[(size_t)row * DM + 3 * GWD + ch] = (bf16)f2bf((HT[t * GWD + ch] + HT[(LL + t) * GWD + ch]) * geluf_(gt)); } }
    }
}

constexpr float ATT_C2 = 0.125f * 1.4426950408889634f;
__device__ __forceinline__ size_t gqa_kv_index(int row, int kvh) {
    const int b = row < MLAT ? row / T : (row - MLAT) / TC; const int pos = row < MLAT ? TC + row % T : (row - MLAT) % TC;
    return ((size_t)(b * NKV + kvh) * (TC + T) + pos) * 64; }
__device__ __forceinline__ void ph_na_kvcopy(const Ctx& c) {
    static_assert((size_t)3 * M * GWD * 2 <= (size_t)M * DM * 2, "NA K/V/Q copies fit the XN region");
    const bf16* P = (const bf16*)(c.ws + WS_BIG + BIG_P); bf16* NK = (bf16*)(c.ws + WS_XN);
    const long nitems = (long)M * 2 * NH * 8;
    constexpr int UN = 4;
    for (long it0 = c.gt; it0 < nitems; it0 += (long)UN * c.NGT) { u32x4 v[UN]; long it[UN];
#pragma unroll
        for (int u = 0; u < UN; ++u) { it[u] = it0 + (long)u * c.NGT; const long ic = it[u] < nitems ? it[u] : nitems - 1; const int w = (int)(ic % (2 * NH * 8)), row = (int)(ic / (2 * NH * 8)); v[u] = *(const u32x4*)(P + (size_t)row * INC + PC_NAK + w * 8); }
#pragma unroll
        for (int u = 0; u < UN; ++u) if (it[u] < nitems) { const int w = (int)(it[u] % (2 * NH * 8)), row = (int)(it[u] / (2 * NH * 8)); const int kv = w / (NH * 8), hh = (w / 8) % NH, j = w & 7;
            const int b = row < MLAT ? row / T : (row - MLAT) / TC; const int pos = row < MLAT ? TC + row % T : (row - MLAT) % TC;
            *(u32x4*)(NK + (size_t)kv * M * GWD + ((size_t)(b * NH + hh) * (TC + T) + pos) * 64 + 8 * j) = v[u]; } }
    bf16* NQ = NK + (size_t)2 * M * GWD;
    for (long it = c.gt; it < (long)M * NH * 8; it += c.NGT) { const int w = (int)(it % (NH * 8)), row = (int)(it / (NH * 8)); float q[8]; ld8bf(P + (size_t)row * INC + PC_NAQ + w * 8, q);
#pragma unroll
        for (int i = 0; i < 8; ++i) q[i] *= ATT_C2;
        st8bf(NQ + (size_t)row * GWD + w * 8, q); }
}
__device__ __forceinline__ void ph_gqa_prep(const Ctx& c, int l) {
    const bf16* P = (const bf16*)(c.ws + WS_BIG + BIG_P); bf16* KN = (bf16*)(c.ws + WS_BIG + BIG_KN);
    const float* gk = c.in(I_GKN) + l * 64; const float* rope = (const float*)(c.ws + WS_ROPE);
    constexpr int NS = NKV; const long nitems = (long)M * NS * 8;
    const long nloop = (nitems + c.NGT - 1) / c.NGT;
    for (long k = 0; k < nloop; ++k) { const long it = k * c.NGT + c.gt; const bool act = it < nitems; const long itc = act ? it : nitems - 1;
        const int j = (int)(itc & 7), hh = (int)((itc >> 3) % NS), row = (int)((itc >> 3) / NS);
        float x[8]; ld8bf(P + (size_t)row * INC + PC_GK + hh * 64 + 8 * j, x);
        float ss = 0.f;
#pragma unroll
        for (int i = 0; i < 8; ++i) ss += x[i] * x[i];
        ss += __shfl_xor(ss, 1); ss += __shfl_xor(ss, 2); ss += __shfl_xor(ss, 4);
        const float rstd = 1.f / sqrtf(ss * (1.f / 64.f) + EPS); const float* gg = gk + 8 * j; float y[8], pr[8];
#pragma unroll
        for (int i = 0; i < 8; ++i) y[i] = x[i] * rstd * gg[i];
#pragma unroll
        for (int i = 0; i < 8; ++i) pr[i] = __shfl_xor(y[i], 2);
        if (row < MLAT) { const int t = row % T; const int pos = (j < 4) ? t / GW : t % GW; const float* tb = rope + pos * 32 + (8 * j & 15); const bool second = (j & 2) != 0;
#pragma unroll
            for (int i = 0; i < 8; ++i) { const float cs = tb[i], sn = tb[16 + i]; y[i] = second ? (y[i] * cs + pr[i] * sn) : (y[i] * cs - pr[i] * sn); } }
        if (act) st8bf(KN + gqa_kv_index(row, hh) + 8 * j, y);
    }
}

template <bool LOG2> __device__ __forceinline__ void attn_key(const bf16* k, const bf16* v, float bias, const float (&q)[64], float& m, float& lsum, float (&o)[64]) {
    float s = bias;
#pragma unroll
    for (int d8 = 0; d8 < 8; ++d8) { float kv[8]; ld8bf(k + d8 * 8, kv);
#pragma unroll
        for (int j = 0; j < 8; ++j) s += q[d8 * 8 + j] * kv[j]; }
    const float mn = fmaxf(m, s), corr = LOG2 ? exp2f(m - mn) : expf(m - mn), pp = LOG2 ? exp2f(s - mn) : expf(s - mn); m = mn; lsum = lsum * corr + pp;
#pragma unroll
    for (int d8 = 0; d8 < 8; ++d8) { float vv[8]; ld8bf(v + d8 * 8, vv);
#pragma unroll
        for (int j = 0; j < 8; ++j) o[d8 * 8 + j] = o[d8 * 8 + j] * corr + pp * vv[j]; }
}
__device__ __forceinline__ void attn_store(bf16* dst, float lsum, const float (&o)[64]) {
    const float inv = 1.f / lsum;
#pragma unroll
    for (int d8 = 0; d8 < 8; ++d8) { float t[8];
#pragma unroll
        for (int j = 0; j < 8; ++j) t[j] = o[d8 * 8 + j] * inv;
        st8bf(dst + d8 * 8, t); }
}
__device__ __forceinline__ void ph_gqa_naive(const Ctx& c, bool need_ctx) {
    const bf16* QN = (const bf16*)(c.ws + WS_BIG + BIG_QN); const bf16* KN = (const bf16*)(c.ws + WS_BIG + BIG_KN); const bf16* VN = (const bf16*)(c.ws + WS_BIG + BIG_VN); bf16* Y = (bf16*)(c.ws + WS_Y);
    const int nq = need_ctx ? M : MLAT; const long nitems = (long)nq * NH;
    for (long it = c.gt; it < nitems; it += c.NGT) { const int h = (int)(it / nq), row = (int)(it % nq); const int kvh = h / GQG;
        const int b = row < MLAT ? row / T : (row - MLAT) / TC;
        float q[64], o[64]; float m = -1e30f, ls = 0.f;
#pragma unroll
        for (int d8 = 0; d8 < 8; ++d8) { float t[8]; ld8bf(QN + (size_t)row * GWD + h * 64 + d8 * 8, t);
#pragma unroll
            for (int j = 0; j < 8; ++j) { q[d8 * 8 + j] = t[j]; o[d8 * 8 + j] = 0.f; } }
        const size_t kb = (size_t)(b * NKV + kvh) * (TC + T) * 64; const int nk = row < MLAT ? TC + T : TC;
        for (int n = 0; n < nk; ++n) attn_key<true>(KN + kb + (size_t)n * 64, VN + kb + (size_t)n * 64, 0.f, q, m, ls, o);
        attn_store(Y + (size_t)row * DM + 2 * GWD + h * 64, ls, o); }
}
__device__ __forceinline__ void ph_na_naive(const Ctx& c, int l, bool need_ctx) {
    const bf16* P = (const bf16*)(c.ws + WS_BIG + BIG_P); bf16* Y = (bf16*)(c.ws + WS_Y); const float* rpb = c.in(I_RPB) + (size_t)l * NH * 15 * 31;
    constexpr int KR = NROWS < 8 ? NROWS : 8;
    const int nq = need_ctx ? M : MLAT; const long nitems = (long)nq * NH;
    for (long it = c.gt; it < nitems; it += c.NGT) { const int h = (int)(it / nq), row = (int)(it % nq);
        const int b = row < MLAT ? row / T : (row - MLAT) / TC;
        float q[64], o[64]; float m = -1e30f, ls = 0.f;
#pragma unroll
        for (int d8 = 0; d8 < 8; ++d8) { float t[8]; ld8bf(P + (size_t)row * INC + PC_NAQ + h * 64 + d8 * 8, t);
#pragma unroll
            for (int j = 0; j < 8; ++j) { q[d8 * 8 + j] = t[j] * 0.125f; o[d8 * 8 + j] = 0.f; } }
        if (row < MLAT) { const int t = row % T, r = t / GW, cc = t % GW;
            int rs = r - 4; rs = rs < 0 ? 0 : (rs > NROWS - KR ? NROWS - KR : rs); int cs = cc - 8; cs = cs < 0 ? 0 : (cs > GW - 16 ? GW - 16 : cs);
            for (int i = 0; i < KR; ++i) for (int j = 0; j < 16; ++j) { const int kr = b * T + (rs + i) * GW + cs + j; const float bias = rpb[((size_t)h * 15 + (rs + i - r + 7)) * 31 + (cs + j - cc + 15)];
                attn_key<false>(P + (size_t)kr * INC + PC_NAK + h * 64, P + (size_t)kr * INC + PC_NAV + h * 64, bias, q, m, ls, o); } }
        for (int n = 0; n < TC; ++n) { const int kr = MLAT + b * TC + n; attn_key<false>(P + (size_t)kr * INC + PC_NAK + h * 64, P + (size_t)kr * INC + PC_NAV + h * 64, 0.f, q, m, ls, o); }
        attn_store(Y + (size_t)row * DM + GWD + h * 64, ls, o); }
}

namespace attn_body {
typedef unsigned short bf16;
using bf16x8=__attribute__((ext_vector_type(8)))short;
using s16x4=__attribute__((ext_vector_type(4)))short;
using f32x16=__attribute__((ext_vector_type(16)))float;
using u32x4=__attribute__((ext_vector_type(4)))unsigned;
constexpr int D=64; constexpr int QP=GWD, KP=64, OP=::DM;
constexpr int NW=8,QBLK=32,QB=QBLK*NW,KVBLK=64;
__device__ __forceinline__ int crow(int r,int hi){return (r&3)+8*(r>>2)+4*hi;}
#define SBAR() __builtin_amdgcn_sched_barrier(0)
constexpr int NSLOT=3, SLOTB=8192;
constexpr int LDS_K=0, LDS_V=NSLOT*SLOTB, LDS_WS=2*NSLOT*SLOTB, LDS_OST=LDS_WS+NW*64*4, LDS_BYTES=LDS_OST+NW*4096;
constexpr float C2=0.125f*1.4426950408889634f;
#ifdef HOST_EMU
__device__ __forceinline__ void glds16(const void*gsrc,unsigned lds_dst){ emu_glds(gsrc, emu_lds()+lds_dst, 16, 0, 0); }
#define ASM_(...) ((void)0)
#define PINV(x) ((void)0)
#define LDSADDR(p) ((unsigned)((const unsigned char*)(p)-emu_lds()))
__device__ __forceinline__ float max3f(float a,float b,float c){return fmaxf(fmaxf(a,b),c);}
__device__ __forceinline__ float max2f(float a,float b){return fmaxf(a,b);}
__device__ __forceinline__ float fadd_s(float a,float b){return a+b;}
__device__ __forceinline__ float fsub_s(float a,float b){return a-b;}
__device__ __forceinline__ unsigned cvtpk_s(float lo,float hi){return pk2(lo,hi);}
__device__ __forceinline__ unsigned __float_as_uint(float f){return __builtin_bit_cast(unsigned,f);}
__device__ __forceinline__ float __uint_as_float(unsigned u){return __builtin_bit_cast(float,u);}
typedef unsigned emu_u2 __attribute__((ext_vector_type(2)));
__device__ __forceinline__ emu_u2 emu_permlane32_swap(unsigned vdst,unsigned src,bool,bool){ int lane=emu_f().tid&63; struct{unsigned a,b;}d{vdst,src}; EmuXchg x=emu_deposit(&d,sizeof(d)); unsigned oa,ob; emu_u2 r;
  if(lane<32){ memcpy(&oa,x.at(lane+32),4); r[0]=vdst; r[1]=oa; } else { memcpy(&ob,x.at(lane-32)+4,4); r[0]=ob; r[1]=src; } return r; }
#define __builtin_amdgcn_permlane32_swap emu_permlane32_swap
__device__ __forceinline__ bool __any(bool p){ int v=p; EmuXchg x=emu_deposit(&v,sizeof(v)); int r=0; for(int l=0;l<64;++l){int q; memcpy(&q,x.at(l),4); r|=q;} return r!=0; }
#define WAIT_BAR(N) __syncthreads()
#else
#define ASM_(...) asm volatile(__VA_ARGS__)
#define PINV(x) asm volatile("":"+v"(x))
#define LDSADDR(p) ((unsigned)(uintptr_t)(p))
__device__ __forceinline__ void glds16(const void*gsrc,unsigned lds_dst){unsigned keep;
  asm volatile("s_mov_b32 %0, m0\n\ts_mov_b32 m0, %2\n\ts_nop 0\n\tglobal_load_lds_dwordx4 %1, off\n\ts_mov_b32 m0, %0":"=&s"(keep):"v"(gsrc),"s"(lds_dst):"memory");}
__device__ __forceinline__ float max3f(float a,float b,float c){float r;asm("v_max3_f32 %0, %1, %2, %3":"=v"(r):"v"(a),"v"(b),"v"(c));return r;}
__device__ __forceinline__ float max2f(float a,float b){float r;asm("v_max_f32_e32 %0, %1, %2":"=v"(r):"v"(a),"v"(b));return r;}
__device__ __forceinline__ float fadd_s(float a,float b){float r;asm("v_add_f32_e32 %0, %1, %2":"=v"(r):"v"(a),"v"(b));return r;}
__device__ __forceinline__ float fsub_s(float a,float b){float r;asm("v_sub_f32_e32 %0, %1, %2":"=v"(r):"v"(a),"v"(b));return r;}
typedef float f32x2_t __attribute__((ext_vector_type(2))); typedef __bf16 bf16x2_t __attribute__((ext_vector_type(2)));
__device__ __forceinline__ unsigned cvtpk_s(float lo,float hi){f32x2_t v={lo,hi};bf16x2_t b=__builtin_convertvector(v,bf16x2_t);return __builtin_bit_cast(unsigned,b);}
#define WAIT_BAR(N) asm volatile("s_waitcnt vmcnt(" #N ") lgkmcnt(0)\n\ts_barrier":::"memory")
#endif

__device__ __forceinline__ void qkt(f32x16&p0,f32x16&p1,LAS const char*Kslot,const bf16x8*qr,const f32x16&negm,int r32,int hi){
  LAS const char*kb=Kslot+hi*1024+r32*16;
  #pragma unroll
  for(int d0=0;d0<4;++d0){
    const bf16x8 b0=*(const LAS bf16x8*)(kb+d0*2048);
    const bf16x8 b1=*(const LAS bf16x8*)(kb+d0*2048+512);
    if(d0==0){p0=__builtin_amdgcn_mfma_f32_32x32x16_bf16(b0,qr[0],negm,0,0,0);p1=__builtin_amdgcn_mfma_f32_32x32x16_bf16(b1,qr[0],negm,0,0,0);}
    else{p0=__builtin_amdgcn_mfma_f32_32x32x16_bf16(b0,qr[d0],p0,0,0,0);p1=__builtin_amdgcn_mfma_f32_32x32x16_bf16(b1,qr[d0],p1,0,0,0);}}
}
typedef LAS const char* lds_cptr;
typedef short v4i16_t __attribute__((ext_vector_type(4)));
__device__ __forceinline__ void kload8(bf16x8*kf,lds_cptr kp){
  kf[0]=*(const LAS bf16x8*)(kp);      kf[1]=*(const LAS bf16x8*)(kp+512);
  kf[2]=*(const LAS bf16x8*)(kp+2048); kf[3]=*(const LAS bf16x8*)(kp+2560);
  kf[4]=*(const LAS bf16x8*)(kp+4096); kf[5]=*(const LAS bf16x8*)(kp+4608);
  kf[6]=*(const LAS bf16x8*)(kp+6144); kf[7]=*(const LAS bf16x8*)(kp+6656);
}
__device__ __forceinline__ void kload2(bf16x8*kf,lds_cptr kp,int j){ kf[2*j]=*(const LAS bf16x8*)(kp+j*2048); kf[2*j+1]=*(const LAS bf16x8*)(kp+j*2048+512); }
#ifdef HOST_EMU
__device__ __forceinline__ s16x4 vtr(lds_cptr p){ return __builtin_bit_cast(s16x4, emu_ds_read_tr16_b64((const void*)p)); }
#else
__device__ __forceinline__ s16x4 vtr(lds_cptr p){ return __builtin_bit_cast(s16x4,__builtin_amdgcn_ds_read_tr16_b64_v4i16((LAS v4i16_t*)p)); }
#endif
__device__ __forceinline__ float rowmax(const f32x16&p0,const f32x16&p1){
  float a=max3f(p0[0],p0[1],p1[0]),b=max3f(p0[2],p0[3],p1[1]);a=max3f(a,p1[2],p1[3]);
  #pragma unroll
  for(int r=4;r<16;r+=4){a=max3f(a,p0[r],p0[r+1]);b=max3f(b,p0[r+2],p0[r+3]);a=max3f(a,p1[r],p1[r+1]);b=max3f(b,p1[r+2],p1[r+3]);}
  const float m=max2f(a,b);
  auto rr=__builtin_amdgcn_permlane32_swap(__float_as_uint(m),__float_as_uint(m),false,false);
  return max2f(__uint_as_float(rr[0]),__uint_as_float(rr[1]));
}
__device__ __forceinline__ void pv(f32x16*o,int vb,bf16x8 pa0,bf16x8 pa1,bf16x8 pa2,bf16x8 pa3){
  #pragma unroll
  for(int d0=0;d0<2;++d0){s16x4 lo[4],hi[4];
    #pragma unroll
    for(int ks=0;ks<4;++ks){
#ifdef HOST_EMU
      lo[ks]=__builtin_bit_cast(s16x4, emu_ds_read_tr16_b64(emu_lds()+vb+d0*4096+ks*1024)); hi[ks]=__builtin_bit_cast(s16x4, emu_ds_read_tr16_b64(emu_lds()+vb+d0*4096+ks*1024+512));}
#else
      asm volatile("ds_read_b64_tr_b16 %0,%1 offset:%c2":"=&v"(lo[ks]):"v"(vb),"i"(d0*4096+ks*1024):"memory");
      asm volatile("ds_read_b64_tr_b16 %0,%1 offset:%c2":"=&v"(hi[ks]):"v"(vb),"i"(d0*4096+ks*1024+512):"memory");}
    asm volatile("s_waitcnt lgkmcnt(0)":::"memory");
#endif
    SBAR();
    #define PK(k) (bf16x8){lo[k][0],lo[k][1],lo[k][2],lo[k][3],hi[k][0],hi[k][1],hi[k][2],hi[k][3]}
    o[d0]=__builtin_amdgcn_mfma_f32_32x32x16_bf16(pa0,PK(0),o[d0],0,0,0);
    o[d0]=__builtin_amdgcn_mfma_f32_32x32x16_bf16(pa1,PK(1),o[d0],0,0,0);
    o[d0]=__builtin_amdgcn_mfma_f32_32x32x16_bf16(pa2,PK(2),o[d0],0,0,0);
    o[d0]=__builtin_amdgcn_mfma_f32_32x32x16_bf16(pa3,PK(3),o[d0],0,0,0);
    #undef PK
  }
}

#ifndef ATTN_STORE16
#define ATTN_STORE16(p,v) (*(u32x4*)(p)=(v))
#endif
struct NoHook { static constexpr bool USE_NEGM = true, QSCALE = false, QPREP = false; static constexpr int QPITCH = QP, KPITCH = KP, VPITCH = KP; __device__ __forceinline__ long koff(int t) const { return (long)t * KVBLK * KP; } __device__ __forceinline__ long voff(int t) const { return (long)t * KVBLK * KP; } __device__ __forceinline__ void mask(f32x16&, f32x16&, int) const {} };
struct GqaHook { static constexpr bool USE_NEGM = true, QSCALE = false, QPREP = true; static constexpr int QPITCH = INC, KPITCH = KP, VPITCH = INC;
  long ctx_off, lat_off; const float* gq; const float* rope; int t0;
  __device__ __forceinline__ long koff(int t) const { return (long)t * KVBLK * KP; }
  __device__ __forceinline__ long voff(int t) const { constexpr int NC4 = TC / 64; return t < NC4 ? ctx_off + (long)t * 64 * INC : lat_off + (long)(t - NC4) * 64 * INC; }
  __device__ __forceinline__ void mask(f32x16&, f32x16&, int) const {}
  __device__ __forceinline__ void qprep(bf16x8 (&qr)[4], int r32, int hi, int wid) const {
    float y[4][8]; float ss = 0.f;
    #pragma unroll
    for (int d0 = 0; d0 < 4; ++d0) {
      #pragma unroll
      for (int j = 0; j < 8; ++j) { y[d0][j] = bf2f((unsigned short)qr[d0][j]); ss += y[d0][j] * y[d0][j]; } }
    { auto rr = __builtin_amdgcn_permlane32_swap(__float_as_uint(ss), __float_as_uint(ss), false, false); ss = __uint_as_float(rr[0]) + __uint_as_float(rr[1]); }
    const float rstd = 1.f / sqrtf(ss * (1.f / 64.f) + EPS);
    #pragma unroll
    for (int d0 = 0; d0 < 4; ++d0) {
      #pragma unroll
      for (int j = 0; j < 8; ++j) y[d0][j] = y[d0][j] * rstd * gq[16 * d0 + 8 * hi + j]; }
    if (t0 >= 0) { const int t = t0 + wid * QBLK + r32;
      #pragma unroll
      for (int hf = 0; hf < 2; ++hf) { const int pos = hf == 0 ? t / GW : t % GW; const float* tb = rope + pos * 32 + 8 * hi;
        #pragma unroll
        for (int j = 0; j < 8; ++j) { const float cs = tb[j], sn = tb[16 + j], a = y[2 * hf][j], b = y[2 * hf + 1][j]; y[2 * hf][j] = a * cs - b * sn; y[2 * hf + 1][j] = b * cs + a * sn; } } }
    #pragma unroll
    for (int d0 = 0; d0 < 4; ++d0) {
      #pragma unroll
      for (int j = 0; j < 8; ++j) qr[d0][j] = (short)f2bf(y[d0][j] * ATT_C2); } } };

template<int THRL, class Hook = NoHook> __device__ __forceinline__ void attn_unit(const bf16*Qw0,const bf16*__restrict__ Kh,const bf16*__restrict__ Vh,bf16*Ow0,const int NT,LAS char*shm,const Hook H = Hook()){
  const int tid=threadIdx.x,lane=tid&63,r32=lane&31,hi=lane>>5; const int wid=__builtin_amdgcn_readfirstlane(tid>>6);
  constexpr int QP_=Hook::QPITCH, KP_=Hook::KPITCH, VP_=Hook::VPITCH;
  const bf16*Qw=Qw0+(long)(wid*QBLK)*QP_;
  const unsigned lds0=LDSADDR(shm);
  LAS float*wsf=(LAS float*)(shm+LDS_WS)+wid*64;
  const bf16*ksrc=Kh+(long)lane*KP_+wid*8;
  const bf16*vsrc=Vh+(long)(16*(wid&3)+(lane>>2))*VP_+(wid>>2)*32+(lane&3)*8;
  const unsigned kdst=lds0+LDS_K+wid*1024, vdst=lds0+LDS_V+wid*1024;
  #define DMA_K(t,slot) glds16(ksrc+H.koff(t),(unsigned)__builtin_amdgcn_readfirstlane(kdst+(slot)))
  #define DMA_V(t,slot) glds16(vsrc+H.voff(t),(unsigned)__builtin_amdgcn_readfirstlane(vdst+(slot)))
  const int vb0=(int)(lds0+LDS_V)+((lane>>4)&1)*32+(lane&3)*8+(4*hi+((lane&15)>>2))*64;
  LAS const char*Kbase=shm+LDS_K; bf16x8 kf[8];
  const lds_cptr shm3=(lds_cptr)shm; const lds_cptr kp0=shm3+LDS_K+hi*1024+r32*16; const lds_cptr vp0=shm3+LDS_V+((lane>>4)&1)*32+(lane&3)*8+(4*hi+((lane&15)>>2))*64;
  DMA_K(0,0);DMA_V(0,0);DMA_K(1,SLOTB);
  bf16x8 qr[4];
  #pragma unroll
  for(int d0=0;d0<4;++d0){qr[d0]=*reinterpret_cast<const bf16x8*>(&Qw[(long)r32*QP_+d0*16+hi*8]);
    if constexpr (Hook::QSCALE) { _Pragma("unroll") for(int j=0;j<8;++j) qr[d0][j]=(short)f2bf(bf2f((unsigned short)qr[d0][j])*ATT_C2); } }
  if constexpr (Hook::QPREP) H.qprep(qr, r32, hi, wid);
  float mhat=0.f,l_reg=0.f;f32x16 o[2];o[0]=f32x16{};o[1]=f32x16{};f32x16 negm=f32x16{}; if constexpr (Hook::USE_NEGM) { PINV(negm); } const f32x16 z16_=f32x16{};
  #define CMASK(P0,P1,t) do{ H.mask(P0,P1,(t)); }while(0)
  bool resc=false;
  #define START(P0,P1) do{ const float rm=rowmax(P0,P1); resc=false; \
    { const float dl=rm; mhat=fadd_s(mhat,dl); \
      _Pragma("unroll") for(int r=0;r<16;++r){P0[r]=fsub_s(P0[r],dl);P1[r]=fsub_s(P1[r],dl);} \
      if constexpr (Hook::USE_NEGM) { _Pragma("unroll") for(int r=0;r<16;++r)negm[r]=-mhat; PINV(negm); } } \
    _Pragma("unroll") for(int r=0;r<16;++r)P0[r]=__builtin_amdgcn_exp2f(P0[r]); }while(0)
  #define RESC() do{ if(resc){ ASM_("s_waitcnt lgkmcnt(0)":::"memory"); \
      _Pragma("unroll") for(int d_=0;d_<2;++d_) _Pragma("unroll") for(int r=0;r<16;++r)o[d_][r]*=wsf[crow(r,hi)]; } }while(0)
  f32x16 pA0,pA1,pB0,pB1;
  int sl_prev=0,sl_cur=0,sl_next=SLOTB;
  #define ROT() do{sl_prev=sl_cur;sl_cur=sl_next;sl_next=(sl_next==(NSLOT-1)*SLOTB)?0:sl_next+SLOTB;}while(0)
  DMA_K(2,2*SLOTB);
  WAIT_BAR(3);
  qkt(pA0,pA1,Kbase,qr,negm,r32,hi);
#ifndef HOST_EMU
  asm volatile("s_nop 15\n\ts_nop 7":"+v"(pA0),"+v"(pA1));
#endif

  START(pA0,pA1);
  _Pragma("unroll") for(int r=0;r<16;++r)pA1[r]=__builtin_amdgcn_exp2f(pA1[r]);
  WAIT_BAR(0);
  DMA_K(3,0);DMA_V(1,SLOTB);
  ROT();
  kload8(kf,kp0+sl_cur);
  WAIT_BAR(2);
  s16x4 vlo[8],vhi[8]; u32x4 pw0,pw1,pw2,pw3;
  #define PKW(P,B) cvtpk_s(P[B],P[B+1])
  #define PAF(k) __builtin_bit_cast(bf16x8,pw##k)
  #define VFR(i) (bf16x8){vlo[i][0],vlo[i][1],vlo[i][2],vlo[i][3],vhi[i][0],vhi[i][1],vhi[i][2],vhi[i][3]}
  #define PIN(x) PINV(x)
  #define MX3(a,b,c) __builtin_fmaxf(__builtin_fmaxf((a),(b)),(c))
  #define GAPA(MF,A0,A1,A2,A3,W0,W1,PW) do{ MF; sacc+=A0; sacc+=A1; sacc+=A2; sacc+=A3; PIN(sacc); W0; W1; PIN(PW); SBAR(); }while(0)
  #define EX(v) __builtin_amdgcn_exp2f(v)
  #define GAPB(MF,X,B) do{ MF; X[B]=EX(X[B]); X[B+1]=EX(X[B+1]); X[B+2]=EX(X[B+2]); X[B+3]=EX(X[B+3]); PIN(X); SBAR(); }while(0)
  #define VRD(i) do{ vlo[i]=vtr(vp_+(((i)>>2)*4096+((i)&3)*1024)); vhi[i]=vtr(vp_+(((i)>>2)*4096+((i)&3)*1024+512)); }while(0)
  #define KRD(G,j) do{ if(G){ kload2(kf,kp0+sl_next,j); SBAR(); } }while(0)
  #define STEP(C0,C1,P0,P1,t,GK,GV,GL) do{ SBAR(); \
    const lds_cptr vp_=vp0+sl_prev; \
    VRD(0); SBAR(); float sacc=(P0[0]+P0[1]); \
    GAPA(C0=__builtin_amdgcn_mfma_f32_32x32x16_bf16(kf[0],qr[0],(Hook::USE_NEGM?negm:z16_),0,0,0), P0[2],P0[3],P0[4],P0[5],     pw0[0]=PKW(P0,0), pw0[1]=PKW(P0,2), pw0); \
    VRD(4); SBAR(); GAPA(C1=__builtin_amdgcn_mfma_f32_32x32x16_bf16(kf[1],qr[0],(Hook::USE_NEGM?negm:z16_),0,0,0), P0[6],P0[7],P0[8],P0[9],     pw0[2]=PKW(P0,4), pw0[3]=PKW(P0,6), pw0); \
    VRD(1); SBAR(); GAPA(C0=__builtin_amdgcn_mfma_f32_32x32x16_bf16(kf[2],qr[1],C0,0,0,0),   P0[10],P0[11],P0[12],P0[13], pw1[0]=PKW(P0,8), pw1[1]=PKW(P0,10), pw1); \
    VRD(5); SBAR(); GAPA(C1=__builtin_amdgcn_mfma_f32_32x32x16_bf16(kf[3],qr[1],C1,0,0,0),   P0[14],P0[15],P1[0],P1[1],   pw1[2]=PKW(P0,12),pw1[3]=PKW(P0,14), pw1); \
    VRD(2); SBAR(); GAPA(C0=__builtin_amdgcn_mfma_f32_32x32x16_bf16(kf[4],qr[2],C0,0,0,0),   P1[2],P1[3],P1[4],P1[5],     pw2[0]=PKW(P1,0), pw2[1]=PKW(P1,2), pw2); \
    VRD(6); SBAR(); GAPA(C1=__builtin_amdgcn_mfma_f32_32x32x16_bf16(kf[5],qr[2],C1,0,0,0),   P1[6],P1[7],P1[8],P1[9],     pw2[2]=PKW(P1,4), pw2[3]=PKW(P1,6), pw2); \
    VRD(3); SBAR(); GAPA(C0=__builtin_amdgcn_mfma_f32_32x32x16_bf16(kf[6],qr[3],C0,0,0,0),   P1[10],P1[11],P1[12],P1[13], pw3[0]=PKW(P1,8), pw3[1]=PKW(P1,10), pw3); \
    VRD(7); SBAR(); GAPA(C1=__builtin_amdgcn_mfma_f32_32x32x16_bf16(kf[7],qr[3],C1,0,0,0),   P1[14],P1[15],0.f,0.f,       pw3[2]=PKW(P1,12),pw3[3]=PKW(P1,14), pw3); \
    l_reg+=sacc; \
    if(GK){DMA_K((t)+3,sl_cur);} if(GV){DMA_V((t)+1,sl_next);} \
    if constexpr (!Hook::USE_NEGM) { _Pragma("unroll") for(int r=0;r<16;++r){C0[r]-=mhat;C1[r]-=mhat;} } \
    CMASK(C0,C1,t); \
    { float a=MX3(C0[0],C0[1],C1[0]),b=MX3(C0[2],C0[3],C1[1]); a=MX3(a,C1[2],C1[3]); \
      _Pragma("unroll") for(int r=4;r<16;r+=4){a=MX3(a,C0[r],C0[r+1]);b=MX3(b,C0[r+2],C0[r+3]);a=MX3(a,C1[r],C1[r+1]);b=MX3(b,C1[r+2],C1[r+3]);} \
      float rm=__builtin_fmaxf(a,b); { auto rr=__builtin_amdgcn_permlane32_swap(__float_as_uint(rm),__float_as_uint(rm),false,false); rm=__builtin_fmaxf(__uint_as_float(rr[0]),__uint_as_float(rr[1])); } \
      resc=false; \
      if(__builtin_expect(__any(rm>(float)THRL),0)){ const float dl=__builtin_fmaxf(rm,0.f); mhat+=dl; \
        _Pragma("unroll") for(int r=0;r<16;++r){C0[r]-=dl;C1[r]-=dl;} \
        if constexpr (Hook::USE_NEGM) { _Pragma("unroll") for(int r=0;r<16;++r)negm[r]=-mhat; PINV(negm); } \
        const float f=__builtin_amdgcn_exp2f(-dl); l_reg*=f; if(hi==0)wsf[r32]=f; resc=true; } } \
    SBAR(); \
    GAPB(o[0]=__builtin_amdgcn_mfma_f32_32x32x16_bf16(PAF(0),VFR(0),o[0],0,0,0), C0,0); \
    GAPB(o[1]=__builtin_amdgcn_mfma_f32_32x32x16_bf16(PAF(0),VFR(4),o[1],0,0,0), C0,4); \
    KRD(GL,0); GAPB(o[0]=__builtin_amdgcn_mfma_f32_32x32x16_bf16(PAF(1),VFR(1),o[0],0,0,0), C0,8); \
    KRD(GL,1); GAPB(o[1]=__builtin_amdgcn_mfma_f32_32x32x16_bf16(PAF(1),VFR(5),o[1],0,0,0), C0,12); \
    KRD(GL,2); GAPB(o[0]=__builtin_amdgcn_mfma_f32_32x32x16_bf16(PAF(2),VFR(2),o[0],0,0,0), C1,0); \
    KRD(GL,3); GAPB(o[1]=__builtin_amdgcn_mfma_f32_32x32x16_bf16(PAF(2),VFR(6),o[1],0,0,0), C1,4); \
    GAPB(o[0]=__builtin_amdgcn_mfma_f32_32x32x16_bf16(PAF(3),VFR(3),o[0],0,0,0), C1,8); \
    GAPB(o[1]=__builtin_amdgcn_mfma_f32_32x32x16_bf16(PAF(3),VFR(7),o[1],0,0,0), C1,12); \
    }while(0)
  int t=1;
  #undef CMASK
  #define CMASK(P0,P1,t) do{ H.mask(P0,P1,(t)); }while(0)
  for(;t+5<NT;t+=2){
    STEP(pB0,pB1,pA0,pA1,t,true,true,true);     WAIT_BAR(2); RESC(); ROT();
    STEP(pA0,pA1,pB0,pB1,t+1,true,true,true);   WAIT_BAR(2); RESC(); ROT();
  }
  #undef CMASK
  #define CMASK(P0,P1,t) do{ H.mask(P0,P1,(t)); }while(0)
  #define ENDW(tt) do{ if((tt)+3<NT){WAIT_BAR(2);} else if((tt)+2<NT){WAIT_BAR(1);} else {WAIT_BAR(0);} }while(0)
  for(;t+1<NT;t+=2){
    STEP(pB0,pB1,pA0,pA1,t,(t+3<NT),(t+1<NT),(t+1<NT));       ENDW(t);   RESC(); ROT();
    STEP(pA0,pA1,pB0,pB1,t+1,(t+4<NT),(t+2<NT),(t+2<NT));     ENDW(t+1); RESC(); ROT();
  }
  STEP(pB0,pB1,pA0,pA1,NT-1,false,false,false); RESC();
  { float sacc=pB0[0]+pB0[1]; _Pragma("unroll") for(int r=2;r<16;++r)sacc+=pB0[r]; _Pragma("unroll") for(int r=0;r<16;++r)sacc+=pB1[r]; l_reg+=sacc;
    pw0=(u32x4){PKW(pB0,0),PKW(pB0,2),PKW(pB0,4),PKW(pB0,6)};pw1=(u32x4){PKW(pB0,8),PKW(pB0,10),PKW(pB0,12),PKW(pB0,14)};pw2=(u32x4){PKW(pB1,0),PKW(pB1,2),PKW(pB1,4),PKW(pB1,6)};pw3=(u32x4){PKW(pB1,8),PKW(pB1,10),PKW(pB1,12),PKW(pB1,14)};
    SBAR(); pv(o,vb0+sl_cur,PAF(0),PAF(1),PAF(2),PAF(3)); }
  #undef PKW
  #undef PAF
  #undef VFR
  #undef PIN
  #undef MX3
  #undef GAPA
  #undef GAPB
  #undef EX
  #undef VRD
  #undef KRD
  #undef STEP
  #undef ENDW
  {auto rr=__builtin_amdgcn_permlane32_swap(__float_as_uint(l_reg),__float_as_uint(l_reg),false,false);l_reg=__uint_as_float(rr[0])+__uint_as_float(rr[1]);}
  if(hi==0)wsf[32+r32]=l_reg;ASM_("s_waitcnt lgkmcnt(0)":::"memory");WAVE_SYNC();
  float rli[16];
  #pragma unroll
  for(int r=0;r<16;++r)rli[r]=__builtin_amdgcn_rcpf(wsf[32+crow(r,hi)]);
  bf16*Ow=Ow0+(long)(wid*QBLK)*OP;
  { LAS bf16*stg=(LAS bf16*)(shm+LDS_OST)+wid*2048;
    #pragma unroll
    for(int r=0;r<16;++r){const int orow=crow(r,hi);
      #pragma unroll
      for(int d0=0;d0<2;++d0)stg[orow*64+d0*32+r32]=(bf16)f2bf(o[d0][r]*rli[r]);}
    ASM_("s_waitcnt lgkmcnt(0)":::"memory");WAVE_SYNC();
    #pragma unroll
    for(int i=0;i<4;++i){const int row=i*8+(lane>>3),ch=lane&7; const u32x4 v=*(const LAS u32x4*)(stg+row*64+ch*8); ATTN_STORE16(Ow+(long)row*OP+ch*8,v);} }
#ifdef HOST_EMU
  __syncthreads();
#else
  asm volatile("s_waitcnt lgkmcnt(0)\n\ts_barrier":::"memory");
#endif
  #undef DMA_K
  #undef DMA_V
  #undef CMASK
  #undef START
  #undef RESC
  #undef ROT
}
constexpr int ATTN_LDS_BYTES=LDS_BYTES;

struct NaHook { static constexpr bool USE_NEGM = false;
  static constexpr bool QSCALE = true, QPREP = false; static constexpr int QPITCH = INC, KPITCH = INC, VPITCH = INC;
  long ctx_off, lat_off;
  int krlo, nwin, rsq, qrow, pk; const LAS float* tbl;
  __device__ __forceinline__ long voff(int t) const { return koff(t); }
  __device__ __forceinline__ long koff(int t) const { constexpr int NC4 = TC / 64; if (t < NC4) return ctx_off + (long)t * 64 * INC; const int w = t - NC4; return lat_off + (long)(krlo + (w < nwin ? w : 0)) * 64 * INC; }
  __device__ __forceinline__ void mask(f32x16& p0, f32x16& p1, int t) const { constexpr int NC4 = TC / 64;
    const int w = t - NC4, kr = krlo + w; const bool win = t >= NC4, part = win && w < nwin && kr >= rsq && kr < rsq + 8;
    const LAS float* trow = tbl + (part ? kr - qrow + 7 : 15) * 128 + (pk >> 16);
    const LAS float* prow = tbl + (win ? 16 * 128 + (part ? 64 + (int)(short)(pk & 0xffff) : 0) : 15 * 128);
    #pragma unroll
    for (int r = 0; r < 16; ++r) { const int kk = (r & 3) + 8 * (r >> 2); p0[r] = p0[r] + trow[kk] + prow[kk]; p1[r] = p1[r] + trow[kk + 32] + prow[kk + 32]; } } };
constexpr int LDS_RPB = LDS_BYTES;
constexpr int NA_TS = 128, NA_PAD = 48;
constexpr int NA_LDS_BYTES = LDS_RPB + 17 * NA_TS * 4;
__device__ __forceinline__ void na_unit(const bf16* __restrict__ P, const bf16* __restrict__ NAKV, const float* __restrict__ rpb_h, int b, int h, int r0, bool is_ctx, bf16* Ow0, LAS char* shm) {
  const int tid=threadIdx.x,lane=tid&63,r32=lane&31,hi=lane>>5; const int wid=__builtin_amdgcn_readfirstlane(tid>>6);
  const unsigned lds0=LDSADDR(shm);
  LAS float*wsf=(LAS float*)(shm+LDS_WS)+wid*64; LAS float* tbl=(LAS float*)(shm+LDS_RPB);
  const int qrow = r0 + (wid>>1), qc = (wid&1)*32 + r32;
  const size_t qtok0 = is_ctx ? (size_t)(MLAT + b*TC) : (size_t)(b*T + r0*GW);
  const bf16* Qw = P + (qtok0 + wid*32) * INC + PC_NAQ + h*64;
  int rs0 = r0 - 4; rs0 = rs0 < 0 ? 0 : (rs0 > NROWS-8 ? NROWS-8 : rs0); int rs3 = r0 + 3 - 4; rs3 = rs3 < 0 ? 0 : (rs3 > NROWS-8 ? NROWS-8 : rs3);
  const int krlo = rs0, nwin = is_ctx ? 0 : (rs3 + 8 - rs0), ntile = nwin + TC/64;
  int rsq = qrow - 4; rsq = rsq < 0 ? 0 : (rsq > NROWS-8 ? NROWS-8 : rsq);
  int csq = qc - 8; csq = csq < 0 ? 0 : (csq > GW-16 ? GW-16 : csq);
  const unsigned kdst=lds0+LDS_K+wid*1024, vdst=lds0+LDS_V+wid*1024;
  const bf16* Kc = (const bf16*)(NAKV) + (size_t)(b*NH + h)*(TC+T)*64; const bf16* Vc = Kc + (size_t)M*GWD;
  #define NA_TILE_ROW0(i) ((i) < nwin ? (size_t)(TC + (krlo+(i))*GW) : (size_t)(((i)-nwin)*64))
  #define NA_DMA(i,slot) do{ const size_t p0_=NA_TILE_ROW0(i)*64; \
      glds16(Kc + p0_ + (size_t)lane*64 + wid*8, (unsigned)__builtin_amdgcn_readfirstlane(kdst+(slot))); \
      glds16(Vc + p0_ + (size_t)(16*(wid&3)+(lane>>2))*64 + (wid>>2)*32 + (lane&3)*8, (unsigned)__builtin_amdgcn_readfirstlane(vdst+(slot))); }while(0)
  NA_DMA(0,0);
  for (int i = tid; i < 15*NA_TS; i += 512) { const int j = (i % NA_TS) - NA_PAD; tbl[i] = (is_ctx || j < 0 || j > 30) ? 0.f : rpb_h[(i / NA_TS) * 31 + j] * 1.4426950408889634f; }
  const LAS float* tb = tbl + NA_PAD + (4*hi - qc + 15); const int d0 = 4*hi - csq;
  bf16x8 qr[4];
  #pragma unroll
  for(int d0=0;d0<4;++d0){ float t[8]; ld8bf(&Qw[(size_t)r32*INC+d0*16+hi*8], t); u32x4 w; w.x=pk2(t[0]*ATT_C2,t[1]*ATT_C2); w.y=pk2(t[2]*ATT_C2,t[3]*ATT_C2); w.z=pk2(t[4]*ATT_C2,t[5]*ATT_C2); w.w=pk2(t[6]*ATT_C2,t[7]*ATT_C2); qr[d0]=__builtin_bit_cast(bf16x8,w); }
  float m_run=-1e30f, l_run=0.f; f32x16 o[2]; o[0]=f32x16{}; o[1]=f32x16{}; const f32x16 zero16=f32x16{};
  const int vb0=(int)(lds0+LDS_V)+((lane>>4)&1)*32+(lane&3)*8+(4*hi+((lane&15)>>2))*64;
  NA_DMA(1, SLOTB);
  int slot = 0, slot2 = 2*SLOTB;
  for (int i = 0; i < ntile; ++i) {
    if (i+1 < ntile) { WAIT_BAR(2); } else { WAIT_BAR(0); }
    if (i+2 < ntile) NA_DMA(i+2, slot2);
    const bool win = i < nwin; const int kr = krlo + i;
    if (!win || (kr >= rsq && kr < rsq + 8)) {
      f32x16 p0,p1; qkt(p0,p1,(LAS const char*)(shm+LDS_K+slot),qr,zero16,r32,hi);
      if (win) { const LAS float* trow = tb + (kr - qrow + 7)*NA_TS;
        #pragma unroll
        for(int r=0;r<16;++r){ const int kk=(r&3)+8*(r>>2); p0[r] = ((unsigned)(d0+kk) < 16u) ? p0[r]+trow[kk] : -1e30f; }
        #pragma unroll
        for(int r=0;r<16;++r){ const int kk=(r&3)+8*(r>>2)+32; p1[r] = ((unsigned)(d0+kk) < 16u) ? p1[r]+trow[kk] : -1e30f; } }
      const float rm = rowmax(p0,p1); const bool grow = __any(rm > m_run); const float mn = fmaxf(m_run, rm); const float alpha = exp2f(m_run - mn); m_run = mn;
      float sacc = 0.f;
      #pragma unroll
      for(int r=0;r<16;++r){ p0[r]=exp2f(p0[r]-mn); p1[r]=exp2f(p1[r]-mn); sacc += p0[r]+p1[r]; }
      l_run = l_run*alpha + sacc;
      if (grow) {
        if(hi==0) wsf[r32]=alpha;
        ASM_("s_waitcnt lgkmcnt(0)":::"memory"); WAVE_SYNC();
        #pragma unroll
        for(int d_=0;d_<2;++d_)
          #pragma unroll
          for(int r=0;r<16;++r) o[d_][r]*=wsf[crow(r,hi)];
        WAVE_SYNC(); }
      u32x4 pw0,pw1,pw2,pw3;
      pw0=(u32x4){cvtpk_s(p0[0],p0[1]),cvtpk_s(p0[2],p0[3]),cvtpk_s(p0[4],p0[5]),cvtpk_s(p0[6],p0[7])}; pw1=(u32x4){cvtpk_s(p0[8],p0[9]),cvtpk_s(p0[10],p0[11]),cvtpk_s(p0[12],p0[13]),cvtpk_s(p0[14],p0[15])};
      pw2=(u32x4){cvtpk_s(p1[0],p1[1]),cvtpk_s(p1[2],p1[3]),cvtpk_s(p1[4],p1[5]),cvtpk_s(p1[6],p1[7])}; pw3=(u32x4){cvtpk_s(p1[8],p1[9]),cvtpk_s(p1[10],p1[11]),cvtpk_s(p1[12],p1[13]),cvtpk_s(p1[14],p1[15])};
      SBAR(); pv(o,vb0+slot,__builtin_bit_cast(bf16x8,pw0),__builtin_bit_cast(bf16x8,pw1),__builtin_bit_cast(bf16x8,pw2),__builtin_bit_cast(bf16x8,pw3));
    }
    slot = (slot == 2*SLOTB) ? 0 : slot + SLOTB; slot2 = (slot2 == 2*SLOTB) ? 0 : slot2 + SLOTB;
  }
  #undef NA_DMA
  #undef NA_TILE_ROW0
  {auto rr=__builtin_amdgcn_permlane32_swap(__float_as_uint(l_run),__float_as_uint(l_run),false,false);l_run=__uint_as_float(rr[0])+__uint_as_float(rr[1]);}
  if(hi==0)wsf[32+r32]=l_run;ASM_("s_waitcnt lgkmcnt(0)":::"memory");WAVE_SYNC();
  float rli[16];
  #pragma unroll
  for(int r=0;r<16;++r)rli[r]=1.f/wsf[32+crow(r,hi)];
  bf16*Ow=Ow0+(long)(wid*32)*OP;
  { LAS bf16*stg=(LAS bf16*)(shm+LDS_OST)+wid*2048;
    #pragma unroll
    for(int r=0;r<16;++r){const int orow=crow(r,hi);
      #pragma unroll
      for(int d0=0;d0<2;++d0)stg[orow*64+d0*32+r32]=(bf16)f2bf(o[d0][r]*rli[r]);}
    ASM_("s_waitcnt lgkmcnt(0)":::"memory");WAVE_SYNC();
    #pragma unroll
    for(int i=0;i<4;++i){const int row=i*8+(lane>>3),ch=lane&7; const u32x4 v=*(const LAS u32x4*)(stg+row*64+ch*8); *(u32x4*)(Ow+(long)row*OP+ch*8)=v;} }
#ifdef HOST_EMU
  __syncthreads();
#else
  asm volatile("s_waitcnt lgkmcnt(0)\n\ts_barrier":::"memory");
#endif
}
#undef SBAR
#undef WAIT_BAR
}

namespace s5m {
#ifdef HOST_EMU
using attn_body::emu_permlane32_swap;
#endif
using attn_body::bf16x8; using attn_body::f32x16; using attn_body::s16x4; using attn_body::vtr; using attn_body::cvtpk_s; using attn_body::crow; using attn_body::lds_cptr;
constexpr int NFR = 12, NCN = 10, OFF_FR = 0, OFF_CN = 2 * NFR * 64 * 16, OFF_IMG = OFF_CN + 2 * 2 * NCN * 64 * 8, IMG_W = 8192, LDS_TOTAL = OFF_IMG + 8 * IMG_W;
static_assert(LDS_TOTAL <= 131072, "S5 LDS");
struct cx { float r, i; };
__device__ __forceinline__ cx cmul(cx a, cx b) { return cx{a.r * b.r - a.i * b.i, a.r * b.i + a.i * b.r}; }
__device__ __forceinline__ void disc(const Ctx& c, int l, int dir, int g, int p, cx& a, cx& f) {
    const size_t gi = ((size_t)(l * 2 + dir) * S5G + g);
    const float lr = c.in(I_S5LRE)[gi * 64 + p], li = c.in(I_S5LIM)[gi * 64 + p], dt = expf(c.in(I_S5STEP)[gi]);
    const float th = li * dt, em1 = expm1f(lr * dt), cs = cosf(th), sn = sinf(th), sh = sinf(0.5f * th);
    const float arm1 = em1 * cs - 2.f * sh * sh; a.r = 1.f + arm1; a.i = (em1 + 1.f) * sn;
    const float den = lr * lr + li * li; f.r = (arm1 * lr + a.i * li) / den; f.i = (a.i * lr - arm1 * li) / den;
}
__device__ __forceinline__ void build_item(const Ctx& c, int l, int g, int item) {
    unsigned char* L = c.ws + WS_S5T + (size_t)(l * S5G + g) * S5T_BYTES; static_assert(S5T_BYTES == (size_t)OFF_IMG, "table size");
    if (item < 256) { const int tid_ = item; const int dir = tid_ >> 7, sp = (tid_ >> 6) & 1, ln = tid_ & 63, hi = ln >> 5, p = 32 * sp + (ln & 31);
        cx a, f; disc(c, l, dir, g, p, a, f); const float n2 = 1.f / (a.r * a.r + a.i * a.i); const cx ai{a.r * n2, -a.i * n2};
        const cx a2 = cmul(a, a), a4 = cmul(a2, a2), a8 = cmul(a4, a4), a16 = cmul(a8, a8), a32 = cmul(a16, a16);
        const cx i2 = cmul(ai, ai), i4 = cmul(i2, i2), i8 = cmul(i4, i4), i16 = cmul(i8, i8), i32 = cmul(i16, i16);
        const cx a63 = cmul(cmul(cmul(a32, a16), cmul(a8, a4)), cmul(a2, a)), i63 = cmul(cmul(cmul(i32, i16), cmul(i8, i4)), cmul(i2, ai));
        const cx one{1.f, 0.f}; const cx a4h = hi ? a4 : one, i4h = hi ? i4 : one;
        cx k[NCN];
        if (dir == 0) { k[0] = i4h; k[1] = cmul(i32, i4h); k[2] = ai; k[3] = i8; k[4] = a4h; k[5] = cmul(a32, a4h); k[6] = a; k[7] = a8; }
        else { k[0] = cmul(i63, a4h); k[1] = cmul(i63, cmul(a32, a4h)); k[2] = a; k[3] = a8; k[4] = cmul(a63, i4h); k[5] = cmul(a63, cmul(i32, i4h)); k[6] = ai; k[7] = i8; }
        k[8] = a; k[9] = a63;
        float* cn = (float*)(L + OFF_CN) + ((size_t)(dir * 2 + sp) * NCN * 64 + ln) * 2;
#pragma unroll
        for (int q = 0; q < NCN; ++q) { cn[q * 128] = k[q].r; cn[q * 128 + 1] = k[q].i; } }
    else { const int e = item - 256; const int ln = e & 63, fr = (e >> 6) % NFR, dir = e / (64 * NFR), col = ln & 31, hi = ln >> 5; float v[8];
        const size_t gi = ((size_t)(l * 2 + dir) * S5G + g);
        if (fr < 4) { const int sp = fr >> 1, im = fr & 1, p = 32 * sp + col; cx a, f; disc(c, l, dir, g, p, a, f);
            const float* br = c.in(I_S5BRE) + (gi * 64 + p) * 16 + 8 * hi; const float* bi = c.in(I_S5BIM) + (gi * 64 + p) * 16 + 8 * hi;
#pragma unroll
            for (int j = 0; j < 8; ++j) v[j] = im ? (f.r * bi[j] + f.i * br[j]) : (f.r * br[j] - f.i * bi[j]); }
        else { const int idx = fr - 4, n = idx >> 1, sk = idx & 1, sp = n >> 1, im = n & 1, p0 = 32 * sp + 16 * sk + 8 * hi;
            const float* cp = (im ? c.in(I_S5CIM) : c.in(I_S5CRE)) + (gi * 16 + (col & 15)) * 64 + p0;
#pragma unroll
            for (int j = 0; j < 8; ++j) v[j] = col < 16 ? (im ? -cp[j] : cp[j]) : 0.f; }
        u32x4 w; w.x = pk2(v[0], v[1]); w.y = pk2(v[2], v[3]); w.z = pk2(v[4], v[5]); w.w = pk2(v[6], v[7]);
        *(u32x4*)(L + OFF_FR + ((size_t)(dir * NFR + fr) * 64 + ln) * 16) = w; }
}
__device__ __forceinline__ void build_all(const Ctx& c) { constexpr int PER = 256 + 2 * NFR * 64; for (int i = c.gt; i < NL * S5G * PER; i += c.NGT) build_item(c, i / (PER * S5G), (i / PER) % S5G, i % PER); }
__device__ __forceinline__ void setup(const Ctx& c, int l, int g) { const u32x4* src = (const u32x4*)(c.ws + WS_S5T + (size_t)(l * S5G + g) * S5T_BYTES);
    for (int i = c.tid; i < OFF_IMG / 16; i += NT) *(LAS u32x4*)(c.lds + i * 16) = src[i]; }
__device__ __forceinline__ bf16x8 frag(const Ctx& c, int dir, int fr) { return *(const LAS bf16x8*)(c.lds + OFF_FR + ((size_t)(dir * NFR + fr) * 64 + c.lane) * 16); }
__device__ __forceinline__ cx cnst(const Ctx& c, int dir, int sp, int q) { const LAS float* p = (const LAS float*)(c.lds + OFF_CN) + ((size_t)((dir * 2 + sp) * NCN + q) * 64 + c.lane) * 2; return cx{p[0], p[1]}; }
constexpr int NCTX5 = TC / 64;
__device__ __forceinline__ int rowbase(int b, int nc) { return nc < NCTX5 ? MLAT + b * TC + nc * 64 : b * T + (nc - NCTX5) * 64; }
__device__ __forceinline__ int pchunk(int dir, int nc) { return dir == 0 ? nc : (nc < NCTX5 ? NCTX5 - 1 - nc : NCTX5 + (NCH5 - NCTX5 - 1) - (nc - NCTX5)); }
__device__ __forceinline__ void proj_scale(const Ctx& c, int dir, int sp, const bf16x8 (&ua)[2], f32x16 (&xr)[2], f32x16 (&xi)[2]) {
    const bf16x8 Bre = frag(c, dir, 2 * sp), Bim = frag(c, dir, 2 * sp + 1); const f32x16 z16 = f32x16{};
#pragma unroll
    for (int m = 0; m < 2; ++m) { xr[m] = __builtin_amdgcn_mfma_f32_32x32x16_bf16(ua[m], Bre, z16, 0, 0, 0); xi[m] = __builtin_amdgcn_mfma_f32_32x32x16_bf16(ua[m], Bim, z16, 0, 0, 0); }
    const cx s1 = cnst(c, dir, sp, 2), s8 = cnst(c, dir, sp, 3);
#pragma unroll
    for (int m = 0; m < 2; ++m) { cx pq = cnst(c, dir, sp, m);
#pragma unroll
        for (int q = 0; q < 4; ++q) { cx p = pq;
#pragma unroll
            for (int i = 0; i < 4; ++i) { const int r = 4 * q + i; const float vr = xr[m][r], vi = xi[m][r]; xr[m][r] = p.r * vr - p.i * vi; xi[m][r] = p.r * vi + p.i * vr; p = cmul(p, s1); }
            pq = cmul(pq, s8); } }
}
__device__ __forceinline__ float half_swap_add(float v) { const unsigned u = __builtin_bit_cast(unsigned, v); auto rr = __builtin_amdgcn_permlane32_swap(u, u, false, false); const unsigned r0 = rr[0], r1 = rr[1]; return __builtin_bit_cast(float, r0) + __builtin_bit_cast(float, r1); }
__device__ __forceinline__ void load_u(const Ctx& c, int g, int rb, bf16x8 (&ua)[2]) {
    const bf16* P = (const bf16*)(c.ws + WS_BIG + BIG_P); const int r32 = c.lane & 31, hi = c.lane >> 5;
#pragma unroll
    for (int m = 0; m < 2; ++m) ua[m] = *(const bf16x8*)(P + (size_t)(rb + 32 * m + r32) * INC + PC_S5 + g * 16 + 8 * hi);
}
#ifndef S5DBG_DIRMASK
#define S5DBG_DIRMASK 3
#define S5DBG_SKIP 1
#define S5DBG_GELU 1
#endif
template <bool PASS_B, int dir> __device__ __forceinline__ void dir_body(const Ctx& c, int g, int b, int nc, float* E, const bf16x8 (&ua)[2], f32x16 (&yacc)[2]) {
    const int r32 = c.lane & 31, hi = c.lane >> 5; const int pc = pchunk(dir, nc); if (PASS_B && !((S5DBG_DIRMASK >> dir) & 1)) return;
                float* e = E + ((((size_t)(b * S5G + g) * 2 + dir) * NCH5 + pc) * 64) * 2;
                bf16x8 Lt0, Lt1, Lon;
                if (PASS_B) {
#pragma unroll
                    for (int j = 0; j < 8; ++j) { const int k0 = 8 * (j >> 2) + 4 * hi + (j & 3), k1 = 16 + k0; const short one = (short)0x3F80;
                        Lt0[j] = ((dir == 0) ? (k0 <= r32) : (k0 >= r32)) ? one : (short)0; Lt1[j] = ((dir == 0) ? (k1 <= r32) : (k1 >= r32)) ? one : (short)0; Lon[j] = one; } }
#pragma unroll 1
                for (int sp = 0; sp < 2; ++sp) {
                    f32x16 xr[2], xi[2]; proj_scale(c, dir, sp, ua, xr, xi);
                    if (!PASS_B) { float sr = 0.f, si = 0.f;
#pragma unroll
                        for (int m = 0; m < 2; ++m)
#pragma unroll
                            for (int r = 0; r < 16; ++r) { sr += xr[m][r]; si += xi[m][r]; }
#ifdef S5DBG_PRINT
                        if (g == 0 && b == 0 && nc == 0 && (c.lane & 31) == 0 && dir == 0 && sp == 0) printf("pre-swap lane %d: %g %g\n", c.lane, sr, si);
#endif
                        sr = half_swap_add(sr); si = half_swap_add(si); const cx a63 = cnst(c, dir, sp, 9);
#ifdef S5DBG_PRINT
                        if (g == 0 && b == 0 && nc == 0 && c.lane < 2) printf("passA dir %d sp %d lane %d: sum %g %g a63 %g %g x0 %g %g x1 %g %g\n", dir, sp, c.lane, sr, si, a63.r, a63.i, xr[0][0], xi[0][0], xr[0][1], xi[0][1]);
#endif
                        if (hi == 0) { e[(32 * sp + r32) * 2] = a63.r * sr - a63.i * si; e[(32 * sp + r32) * 2 + 1] = a63.r * si + a63.i * sr; }
                    } else {
                        bf16x8 xb[2][2][2];
#pragma unroll
                        for (int m = 0; m < 2; ++m)
#pragma unroll
                            for (int sk = 0; sk < 2; ++sk) { u32x4 wr, wi;
#pragma unroll
                                for (int q = 0; q < 4; ++q) { wr[q] = cvtpk_s(xr[m][8 * sk + 2 * q], xr[m][8 * sk + 2 * q + 1]); wi[q] = cvtpk_s(xi[m][8 * sk + 2 * q], xi[m][8 * sk + 2 * q + 1]); }
                                xb[m][0][sk] = __builtin_bit_cast(bf16x8, wr); xb[m][1][sk] = __builtin_bit_cast(bf16x8, wi); }
                        constexpr int mf = dir == 0 ? 0 : 1, ml = 1 - mf;
                        f32x16 cs[2][2]; const f32x16 z16 = f32x16{};
#pragma unroll
                        for (int nn = 0; nn < 2; ++nn) {
                            cs[mf][nn] = __builtin_amdgcn_mfma_f32_32x32x16_bf16(Lt0, xb[mf][nn][0], z16, 0, 0, 0); cs[mf][nn] = __builtin_amdgcn_mfma_f32_32x32x16_bf16(Lt1, xb[mf][nn][1], cs[mf][nn], 0, 0, 0);
                            cs[ml][nn] = __builtin_amdgcn_mfma_f32_32x32x16_bf16(Lon, xb[mf][nn][0], z16, 0, 0, 0); cs[ml][nn] = __builtin_amdgcn_mfma_f32_32x32x16_bf16(Lon, xb[mf][nn][1], cs[ml][nn], 0, 0, 0);
                            cs[ml][nn] = __builtin_amdgcn_mfma_f32_32x32x16_bf16(Lt0, xb[ml][nn][0], cs[ml][nn], 0, 0, 0); cs[ml][nn] = __builtin_amdgcn_mfma_f32_32x32x16_bf16(Lt1, xb[ml][nn][1], cs[ml][nn], 0, 0, 0); }
                        const cx hin{e[(32 * sp + r32) * 2], e[(32 * sp + r32) * 2 + 1]}; const cx gi_ = cmul(cnst(c, dir, sp, 8), hin);
                        const cx s1 = cnst(c, dir, sp, 6), s8 = cnst(c, dir, sp, 7);
                        LAS unsigned char* img = c.lds + OFF_IMG + c.wave * IMG_W;
#pragma unroll
                        for (int m = 0; m < 2; ++m) { cx pq = cnst(c, dir, sp, 4 + m);
#pragma unroll
                            for (int q = 0; q < 4; ++q) { cx p = pq; float or_[4], oi_[4];
#pragma unroll
                                for (int i = 0; i < 4; ++i) { const int r = 4 * q + i; const float vr = cs[m][0][r] + gi_.r, vi = cs[m][1][r] + gi_.i; or_[i] = p.r * vr - p.i * vi; oi_[i] = p.r * vi + p.i * vr; p = cmul(p, s1); }
                                pq = cmul(pq, s8);
                                u32x2 wr, wi; wr.x = cvtpk_s(or_[0], or_[1]); wr.y = cvtpk_s(or_[2], or_[3]); wi.x = cvtpk_s(oi_[0], oi_[1]); wi.y = cvtpk_s(oi_[2], oi_[3]);
                                *(LAS u32x2*)(img + (m * 2 + 0) * 2048 + r32 * 64 + 8 * (2 * q + hi)) = wr; *(LAS u32x2*)(img + (m * 2 + 1) * 2048 + r32 * 64 + 8 * (2 * q + hi)) = wi; } }
                        WAVE_SYNC();
                        const int i16 = c.lane & 15, qq = i16 >> 2, pp = i16 & 3, blk = (c.lane >> 4) & 1;
#pragma unroll
                        for (int m = 0; m < 2; ++m)
#pragma unroll
                            for (int nn = 0; nn < 2; ++nn)
#pragma unroll
                                for (int sk = 0; sk < 2; ++sk) { const lds_cptr tb = (lds_cptr)(img + (m * 2 + nn) * 2048);
                                    const s16x4 lo = vtr(tb + (16 * sk + 8 * hi + qq) * 64 + 8 * (4 * blk + pp)), hi4 = vtr(tb + (16 * sk + 8 * hi + 4 + qq) * 64 + 8 * (4 * blk + pp));
                                    const bf16x8 xa = (bf16x8){lo[0], lo[1], lo[2], lo[3], hi4[0], hi4[1], hi4[2], hi4[3]};
                                    yacc[m] = __builtin_amdgcn_mfma_f32_32x32x16_bf16(xa, frag(c, dir, 4 + 2 * (2 * sp + nn) + sk), yacc[m], 0, 0, 0); }
                        WAVE_SYNC();
                    }
                }
}
template <bool PASS_B> __device__ __forceinline__ void run(const Ctx& c, int l, int mrows, int nblk = 0) {
    float* E = (float*)(c.ws + WS_S5E); bf16* Y = (bf16*)(c.ws + WS_Y);
    const int r32 = c.lane & 31, hi = c.lane >> 5;
    const int GG = nblk ? nblk : c.G; if (c.bx >= GG) return;
    const int gstep = GG < S5G ? GG : S5G, nbg = GG < S5G ? 1 : GG / S5G, jb = c.bx / S5G;
    if (GG >= S5G && jb >= nbg) return;
    for (int g = c.bx % S5G; g < S5G; g += gstep) {
        __syncthreads(); setup(c, l, g); __syncthreads();
        const bool skip_ctx = PASS_B && mrows <= MLAT;
        const int ncl = skip_ctx ? NCH5 - NCTX5 : NCH5, nc0 = skip_ctx ? NCTX5 : 0;
        const int nw = 8 * nbg, w0 = jb * 8 + c.wave, nitems = NB * ncl;
        for (int it = w0; it < nitems; it += nw) { const int nc = nc0 + it % ncl, b = it / ncl; const int rb = rowbase(b, nc);
            bf16x8 ua[2]; load_u(c, g, rb, ua);
            f32x16 yacc[2]; yacc[0] = f32x16{}; yacc[1] = f32x16{};
            dir_body<PASS_B, 0>(c, g, b, nc, E, ua, yacc); dir_body<PASS_B, 1>(c, g, b, nc, E, ua, yacc);
            if (PASS_B) {
                const float dv = c.in(I_S5D)[(size_t)l * GWD + g * 16 + (r32 & 15)]; bf16x8 Bd;
#pragma unroll
                for (int j = 0; j < 8; ++j) Bd[j] = (r32 < 16 && 8 * hi + j == r32) ? (short)f2bf(dv) : (short)0;
#pragma unroll
                for (int m = 0; m < 2; ++m) { if (S5DBG_SKIP) yacc[m] = __builtin_amdgcn_mfma_f32_32x32x16_bf16(ua[m], Bd, yacc[m], 0, 0, 0);
                    if (r32 < 16) {
#pragma unroll
                        for (int r = 0; r < 16; ++r) Y[(size_t)(rb + 32 * m + crow(r, hi)) * DM + g * 16 + r32] = (bf16)f2bf(S5DBG_GELU ? geluf_(yacc[m][r]) : yacc[m][r]); } }
            }
        }
    }
    __syncthreads();
}
}

namespace lrum {
#ifdef HOST_EMU
__device__ __forceinline__ float fast_sqrtf(float x) { return sqrtf(x); }
#else
__device__ __forceinline__ float fast_sqrtf(float x) { return __builtin_amdgcn_sqrtf(x); }
#endif
using attn_body::bf16x8; using attn_body::f32x16; using attn_body::cvtpk_s;
#ifdef HOST_EMU
using attn_body::emu_permlane32_swap;
#endif
constexpr int XROW = GWD * 2 + 16;
static_assert(32 * XROW <= 131072 && GWD == 4 * 64 && LL == 32, "LRU MFMA geometry: 8 waves = 4 channel blocks x 2 halves");
__device__ __forceinline__ float partner(float v, int hi) { const unsigned u = __builtin_bit_cast(unsigned, v); auto rr = __builtin_amdgcn_permlane32_swap(u, u, false, false); const unsigned r0 = rr[0], r1 = rr[1]; return __builtin_bit_cast(float, hi ? r0 : r1); }
__device__ __forceinline__ void decay(float la, float& a, float& sq) { a = __builtin_amdgcn_exp2f(1.4426950408889634f * la); const float x2 = 2.f * la;
    const float big = 1.f - a * a, small = -x2 * (1.f + x2 * (0.5f + x2 * (0.16666667f + x2 * 0.041666668f))); sq = fast_sqrtf(x2 > -0.1f ? small : big); }
template <bool PASS_B> __device__ __forceinline__ void run(const Ctx& c, int l, bool need_ctx, int blk0 = 0) {
    const bf16* P = (const bf16*)(c.ws + WS_BIG + BIG_P); float* E = (float*)(c.ws + WS_LRUE); bf16* Y = (bf16*)(c.ws + WS_Y);
    LAS unsigned char* XC = c.lds;
    const int r32 = c.lane & 31, hi = c.lane >> 5, blk = c.wave >> 1, half = c.wave & 1, e = blk * 64 + half * 32 + r32;
    bf16x8 Wa[2][4], Wx[2][4]; float ba[2], bx[2], sp[2];
    { const bf16x8* lw = (const bf16x8*)(c.ws + WS_LRUW);
#pragma unroll
      for (int dir = 0; dir < 2; ++dir) {
#pragma unroll
        for (int ks = 0; ks < 4; ++ks) { Wa[dir][ks] = lw[((((size_t)((l * 2 + dir) * 2 + 0) * NH + blk) * 2 + half) * 4 + ks) * 64 + c.lane]; Wx[dir][ks] = lw[((((size_t)((l * 2 + dir) * 2 + 1) * NH + blk) * 2 + half) * 4 + ks) * 64 + c.lane]; }
        ba[dir] = c.in(I_LBA)[(size_t)(l * 2 + dir) * GWD + e]; bx[dir] = c.in(I_LBX)[(size_t)(l * 2 + dir) * GWD + e]; sp[dir] = softplusf_(-c.in(I_LLAM)[(size_t)(l * 2 + dir) * GWD + e]); } }
    bf16x8 I0, I1;
#pragma unroll
    for (int j = 0; j < 8; ++j) { I0[j] = (8 * hi + j == r32) ? (short)0x3F80 : (short)0; I1[j] = (16 + 8 * hi + j == r32) ? (short)0x3F80 : (short)0; }
    const bool skip_ctx = PASS_B && !need_ctx;
    const int ntl = skip_ctx ? NTL - NCT : NTL, tl0 = skip_ctx ? NCT : 0; const int nitems = NB * ntl;
    if (c.bx < blk0) return;
    for (int it = c.G - 1 - c.bx; it < nitems; it += c.G - blk0) { const int tile = tl0 + it % ntl, b = it / ntl; const bool is_ctx = tile < NCT;
        const int row0 = lru_tile_row0(b, tile); const int t0 = (is_ctx ? tile : tile - NCT) * LL, tlen = is_ctx ? TC : T; const int seq0 = row0 - t0;
        __syncthreads();
        for (int i = c.tid; i < LL * GWD / 8; i += NT) { const int t = i / (GWD / 8), ch = (i % (GWD / 8)) * 8; float acc8[8];
            { const f32x4 b0 = *(const f32x4*)(c.in(I_LCB) + (size_t)l * GWD + ch), b1 = *(const f32x4*)(c.in(I_LCB) + (size_t)l * GWD + ch + 4);
#pragma unroll
              for (int j = 0; j < 4; ++j) { acc8[j] = b0[j]; acc8[4 + j] = b1[j]; } }
#pragma unroll
            for (int k = 0; k < 4; ++k) { const int tt = t0 + t + k - 2; if (tt >= 0 && tt < tlen) { float xv8[8]; ld8bf(P + (size_t)(seq0 + tt) * INC + PC_LX + ch, xv8);
                const f32x4 w0 = *(const f32x4*)(c.in(I_LCW) + ((size_t)l * 4 + k) * GWD + ch), w1 = *(const f32x4*)(c.in(I_LCW) + ((size_t)l * 4 + k) * GWD + ch + 4);
#pragma unroll
                for (int j = 0; j < 4; ++j) { acc8[j] += w0[j] * xv8[j]; acc8[4 + j] += w1[j] * xv8[4 + j]; } } }
            u32x4 o; o.x = pk2(acc8[0], acc8[1]); o.y = pk2(acc8[2], acc8[3]); o.z = pk2(acc8[4], acc8[5]); o.w = pk2(acc8[6], acc8[7]); *(LAS u32x4*)(XC + t * XROW + ch * 2) = o; }
        __syncthreads();
        bf16x8 A[4];
#pragma unroll
        for (int ks = 0; ks < 4; ++ks) A[ks] = *(const LAS bf16x8*)(XC + r32 * XROW + (blk * 64 + 16 * ks + 8 * hi) * 2);
        const bf16x8 Ax0 = *(const LAS bf16x8*)(XC + r32 * XROW + (blk * 64 + half * 32 + 8 * hi) * 2), Ax1 = *(const LAS bf16x8*)(XC + r32 * XROW + (blk * 64 + half * 32 + 16 + 8 * hi) * 2);
        const f32x16 z16 = f32x16{};
        f32x16 xv = __builtin_amdgcn_mfma_f32_32x32x16_bf16(Ax0, I0, z16, 0, 0, 0); xv = __builtin_amdgcn_mfma_f32_32x32x16_bf16(Ax1, I1, xv, 0, 0, 0);
        f32x16 av[2], bv[2];
#pragma unroll
        for (int dir = 0; dir < 2; ++dir) { f32x16 r = z16, g = z16;
#pragma unroll
            for (int ks = 0; ks < 4; ++ks) { r = __builtin_amdgcn_mfma_f32_32x32x16_bf16(A[ks], Wa[dir][ks], r, 0, 0, 0); g = __builtin_amdgcn_mfma_f32_32x32x16_bf16(A[ks], Wx[dir][ks], g, 0, 0, 0); }
#pragma unroll
            for (int k = 0; k < 16; ++k) { const float rr = sigmoidf_(r[k] + ba[dir]), ii = sigmoidf_(g[k] + bx[dir]); float a, sq; decay(-8.f * rr * sp[dir], a, sq); av[dir][k] = a; bv[dir][k] = sq * (ii * xv[k]); } }
        float hf[16], hb[16];
        { float RA[4], RB[4], PA[4], PB[4], st[4];
#pragma unroll
          for (int q = 0; q < 4; ++q) { float Aq = 1.f, Bq = 0.f;
#pragma unroll
              for (int i = 0; i < 4; ++i) { Bq = av[0][4 * q + i] * Bq + bv[0][4 * q + i]; Aq *= av[0][4 * q + i]; }
              RA[q] = Aq; RB[q] = Bq; PA[q] = partner(Aq, hi); PB[q] = partner(Bq, hi); }
          float* eo = E + (((size_t)(b * 2 + 0) * NTL + tile) * GWD + e) * 2;
          float sst = PASS_B ? eo[1] : 0.f, tot = 1.f;
#pragma unroll
          for (int q = 0; q < 4; ++q) { const float fA = hi ? PA[q] : RA[q], fB = hi ? PB[q] : RB[q], sA = hi ? RA[q] : PA[q], sB = hi ? RB[q] : PB[q];
              const float mid = fA * sst + fB; st[q] = hi ? mid : sst; sst = sA * mid + sB; tot *= fA * sA; }
          if (!PASS_B) { if (hi == 0) { eo[0] = tot; eo[1] = sst; } }
          else {
#pragma unroll
              for (int q = 0; q < 4; ++q) { float h = st[q];
#pragma unroll
                  for (int i = 0; i < 4; ++i) { h = av[0][4 * q + i] * h + bv[0][4 * q + i]; hf[4 * q + i] = h; } } } }
        { float RA[4], RB[4], PA[4], PB[4], st[4];
#pragma unroll
          for (int q = 0; q < 4; ++q) { float Aq = 1.f, Bq = 0.f;
#pragma unroll
              for (int i = 3; i >= 0; --i) { Bq = av[1][4 * q + i] * Bq + bv[1][4 * q + i]; Aq *= av[1][4 * q + i]; }
              RA[q] = Aq; RB[q] = Bq; PA[q] = partner(Aq, hi); PB[q] = partner(Bq, hi); }
          float* eo = E + (((size_t)(b * 2 + 1) * NTL + tile) * GWD + e) * 2;
          float sst = PASS_B ? eo[1] : 0.f, tot = 1.f;
#pragma unroll
          for (int q = 3; q >= 0; --q) { const float fA = hi ? RA[q] : PA[q], fB = hi ? RB[q] : PB[q], sA = hi ? PA[q] : RA[q], sB = hi ? PB[q] : RB[q];
              const float mid = fA * sst + fB; st[q] = hi ? sst : mid; sst = sA * mid + sB; tot *= fA * sA; }
          if (!PASS_B) { if (hi == 0) { eo[0] = tot; eo[1] = sst; } }
          else {
#pragma unroll
              for (int q = 0; q < 4; ++q) { float h = st[q];
#pragma unroll
                  for (int i = 3; i >= 0; --i) { h = av[1][4 * q + i] * h + bv[1][4 * q + i]; hb[4 * q + i] = h; } } } }
        if (PASS_B && (!is_ctx || need_ctx)) {
#pragma unroll
            for (int k = 0; k < 16; ++k) { const int row = row0 + 8 * (k >> 2) + 4 * hi + (k & 3); const float gt = bf2f(P[(size_t)row * INC + PC_LG + e]);
                Y[(size_t)row * DM + 3 * GWD + e] = (bf16)f2bf((hf[k] + hb[k]) * geluf_(gt)); } }
    }
    __syncthreads();
}
}

#ifndef USE_FLASH_GQA
#define USE_FLASH_GQA 1
#endif
__device__ __forceinline__ void gqa_flash_unit(const Ctx& c, int l, int u) {
    const bf16* P = (const bf16*)(c.ws + WS_BIG + BIG_P); const bf16* KN = (const bf16*)(c.ws + WS_BIG + BIG_KN); bf16* Y = (bf16*)(c.ws + WS_Y);
    constexpr int NQB = T / 256, NLU = NB * NH * NQB, NCQ = TC / 256; int b, h, qrow0, ntk;
    if (u < NLU) { b = u / (NH * NQB); h = (u / NQB) % NH; qrow0 = b * T + (u % NQB) * 256; ntk = (TC + T) / 64; }
    else { const int v = u - NLU; b = v / (NH * NCQ); h = (v / NCQ) % NH; qrow0 = MLAT + b * TC + (v % NCQ) * 256; ntk = TC / 64; }
    const size_t kb = (size_t)(b * NKV + h / GQG) * (TC + T) * 64;
    attn_body::GqaHook H; H.ctx_off = (long)(MLAT + b * TC) * INC; H.lat_off = (long)b * T * INC; H.gq = c.in(I_GQN) + l * 64; H.rope = (const float*)(c.ws + WS_ROPE); H.t0 = u < NLU ? (u % NQB) * 256 : -1;
    attn_body::attn_unit<8, attn_body::GqaHook>(P + (size_t)qrow0 * INC + PC_GQ + h * 64, KN + kb, P + PC_GV + (h / GQG) * 64, Y + (size_t)qrow0 * DM + 2 * GWD + h * 64, ntk, (LAS char*)c.lds, H);
}
__device__ __forceinline__ void ph_gqa_flash(const Ctx& c, int l, bool need_ctx) {
    constexpr int NQB = T / 256, NLU = NB * NH * NQB, NCQ = TC / 256, NCU = NB * NH * NCQ; static_assert(T % 256 == 0 && TC % 256 == 0 && ((TC + T) / 64) % 2 == 0 && TC / 64 >= 4 && (TC / 64) % 2 == 0, "attention unit geometry");
    const int nctx = need_ctx ? NCU : 0;
    const int vcu = (c.G % 8 == 0) ? (c.bx % 8) * (c.G / 8) + c.bx / 8 : c.bx;
    __syncthreads();
    for (int u = vcu; u < NLU; u += c.G) gqa_flash_unit(c, l, u);
    for (int cv = (vcu + c.G - c.G / 2) % c.G; cv < nctx; cv += c.G) gqa_flash_unit(c, l, NLU + cv);
}

#ifndef USE_NA_FLASHBODY
#define USE_NA_FLASHBODY 1
#endif
__device__ __forceinline__ void ph_na_flash(const Ctx& c, int l, bool need_ctx) {
    static_assert(GW == 64 && NROWS % 4 == 0 && NROWS >= 8 && TC == 256, "NA unit geometry");
    const bf16* P = (const bf16*)(c.ws + WS_BIG + BIG_P); bf16* Y = (bf16*)(c.ws + WS_Y);
    const float* rpb = c.in(I_RPB) + (size_t)l * NH * 15 * 31;
    constexpr int NRQ = NROWS / 4, NLU = NB * NH * NRQ, NCU = NB * NH;
    const int nunits = NLU + (need_ctx ? NCU : 0);
    const int vcu = (c.G % 8 == 0) ? (c.bx % 8) * (c.G / 8) + c.bx / 8 : c.bx;
    LAS float* tbl = (LAS float*)(c.lds + attn_body::LDS_RPB); const int r32 = c.lane & 31, hi = c.lane >> 5;
    __syncthreads();
    for (int u = vcu; u < nunits; u += c.G) { const bool is_ctx = u >= NLU; int b, h, r0;
        if (!is_ctx) { b = u / (NH * NRQ); h = (u / NRQ) % NH; r0 = (u % NRQ) * 4; } else { const int v = u - NLU; b = v / NH; h = v % NH; r0 = 0; }
        attn_body::NaHook H;
        int rs0 = r0 - 4; rs0 = rs0 < 0 ? 0 : (rs0 > NROWS - 8 ? NROWS - 8 : rs0); int rs3 = r0 + 3 - 4; rs3 = rs3 < 0 ? 0 : (rs3 > NROWS - 8 ? NROWS - 8 : rs3);
        H.krlo = __builtin_amdgcn_readfirstlane(rs0); H.nwin = __builtin_amdgcn_readfirstlane(is_ctx ? 0 : rs3 + 8 - rs0); H.qrow = __builtin_amdgcn_readfirstlane(r0 + (c.wave >> 1)); const int qc = (c.wave & 1) * 32 + r32;
        int rsq = H.qrow - 4; rsq = rsq < 0 ? 0 : (rsq > NROWS - 8 ? NROWS - 8 : rsq); H.rsq = __builtin_amdgcn_readfirstlane(rsq); int csq = qc - 8; csq = csq < 0 ? 0 : (csq > GW - 16 ? GW - 16 : csq);
        H.pk = ((4 * hi - csq) & 0xffff) | ((attn_body::NA_PAD + 4 * hi - qc + 15) << 16); H.tbl = tbl;
        { const float* rh = rpb + (size_t)h * 15 * 31;
            for (int i = is_ctx ? 15 * attn_body::NA_TS + c.tid : c.tid; i < 17 * attn_body::NA_TS; i += NT) { const int jj = i % attn_body::NA_TS, j = jj - attn_body::NA_PAD, rr = i / attn_body::NA_TS;
                tbl[i] = rr == 16 ? ((jj >= 64 && jj < 80) ? 0.f : -INFINITY) : ((rr > 14 || j < 0 || j > 30) ? 0.f : rh[rr * 31 + j] * 1.4426950408889634f); } }
        const int nt0 = TC / 64 + H.nwin, ntk = nt0 + (nt0 & 1);
        const size_t row0 = is_ctx ? (size_t)(MLAT + b * TC) : (size_t)(b * T + r0 * GW); H.ctx_off = (long)(MLAT + b * TC) * INC; H.lat_off = (long)b * T * INC;
        attn_body::attn_unit<8, attn_body::NaHook>(P + row0 * INC + PC_NAQ + h * 64, P + PC_NAK + h * 64, P + PC_NAV + h * 64, Y + row0 * DM + GWD + h * 64, ntk, (LAS char*)c.lds, H); }
}

#ifndef USE_MFMA_NA
#define USE_MFMA_NA 1
#endif
__device__ __forceinline__ void ph_na_mfma(const Ctx& c, int l, bool need_ctx) {
    static_assert(GW == 64 && NROWS % 4 == 0 && NROWS >= 8 && TC % 256 == 0, "NA unit geometry");
    const bf16* P = (const bf16*)(c.ws + WS_BIG + BIG_P); bf16* Y = (bf16*)(c.ws + WS_Y); const float* rpb = c.in(I_RPB) + (size_t)l * NH * 15 * 31;
    constexpr int NRQ = NROWS / 4, NLU = NB * NH * NRQ, NCQ = TC / 256, NCU = NB * NH * NCQ;
    const int nunits = NLU + (need_ctx ? NCU : 0);
    const int vcu = (c.G % 8 == 0) ? (c.bx % 8) * (c.G / 8) + c.bx / 8 : c.bx;
    __syncthreads();
    for (int u = vcu; u < nunits; u += c.G) {
        if (u < NLU) { const int b = u / (NH * NRQ), h = (u / NRQ) % NH, r0 = (u % NRQ) * 4;
            attn_body::na_unit(P, (const bf16*)(c.ws + WS_XN), rpb + (size_t)h * 15 * 31, b, h, r0, false, Y + (size_t)(b * T + r0 * GW) * DM + GWD + h * 64, (LAS char*)c.lds); }
        else { const int v = u - NLU; const int b = v / (NH * NCQ), h = (v / NCQ) % NH;
            attn_body::na_unit(P, (const bf16*)(c.ws + WS_XN), rpb, b, h, 0, true, Y + (size_t)(MLAT + b * TC + (v % NCQ) * 256) * DM + GWD + h * 64, (LAS char*)c.lds); }
    }
}

#ifndef PROBE_MASK
#define PROBE_MASK 0
#endif
#define RUNP(bit, call) do { call; if (PROBE_MASK & (1 << (bit))) { __syncthreads(); call; } } while (0)
#ifndef USE_MFMA_LRU
#define USE_MFMA_LRU 1
#endif
#if USE_MFMA_LRU
#define LRU_RUN(B) lrum::run<B>(c, l, need_ctx)
#define LRU_RUN_FROM(B, b0) lrum::run<B>(c, l, need_ctx, (b0))
#else
#define LRU_RUN(B) ph_lru<B>(c, l, need_ctx)
#endif
#ifndef S5B_SHARE_16THS
#define S5B_SHARE_16THS 0
#endif
__device__ __forceinline__ int s5b_blocks(int G) { return (S5B_SHARE_16THS > 0 && G >= 64 && G % S5G == 0) ? (G / S5G) * S5B_SHARE_16THS : 0; }
constexpr int PH_INIT = 0, PH_MODS = 1, PH_L0 = 2, NPL = 13, PH_FINAL = PH_L0 + NL * NPL, N_PHASES = PH_FINAL + 1;
template <int ph> __device__ __forceinline__ void run_phase(const Ctx& c) {
    if (ph == PH_INIT) { RUNP(0, ph_ada_partial(c)); RUNP(1, ph_cvt_all(c)); ph_tables(c); s5m::build_all(c); return; }
    if (ph == PH_MODS) { ph_mods_reduce(c); return; }
    if (ph == PH_FINAL) { ph_norm_final(c); return; }
    constexpr int l = (ph - PH_L0) / NPL, s = (ph - PH_L0) % NPL; constexpr bool need_ctx = l < NL - 1; constexpr int mrows2 = need_ctx ? M : MLAT;
    bf16* PARTY = (bf16*)(c.ws + WS_Y); bf16* PARTB = (bf16*)(c.ws + WS_BIG);
    static_assert((size_t)(DFF / 256) * MCTX * DM * 4 <= Y_BYTES && (size_t)(DM / 256) * MCTX * DM * 4 <= BIG_BYTES && DFF % 256 == 0, "slab regions");
    bf16* XN = (bf16*)(c.ws + WS_XN); bf16* G = (bf16*)(c.ws + WS_BIG); bf16* Pb = (bf16*)(c.ws + WS_BIG + BIG_P); bf16* Y = (bf16*)(c.ws + WS_Y);
    switch (s) {
    case 0: ph_norm_mod(c, l, c.in(I_GFFN1) + (size_t)l * DM, 0, 1, M, l > 0 ? Pending{PARTY, DFF / 256, l - 1, 8, 0.5f} : Pending{nullptr, 0, 0, 0, 0.f}, l == 0 ? 1 : 0); break;
    case 1: { EpiSwiglu E{G}; RUNP(10, gemm_run_swiglu(c, XN, c.wl(l, W_1I), M, DM, E)); } break;
    case 2: gemm_resid_all<l == 0>(c, G, c.wl(l, W_1O), DM, DFF, l, 2, 0.5f, true, PARTY, c.in(I_X)); break;
    case 3: ph_norm_mod(c, l, c.in(I_GMIX) + (size_t)l * DM, 3, 4, M, Pending{PARTY, DFF / 256, l, 2, 0.5f}, l == 0 ? 2 : 0); break;
    case 4: { EpiP E{Pb}; RUNP(11, gemm_run(c, XN, c.wl(l, W_IN), M, INC, DM, E)); } break;
#ifndef USE_MFMA_S5
#define USE_MFMA_S5 1
#endif
    case 5:
#if USE_MFMA_S5 && !defined(S5DBG_OLD_A)
        RUNP(3, s5m::run<false>(c, l, M));
#else
        RUNP(3, ph_s5_a(c, l));
#endif
        RUNP(4, LRU_RUN(false)); RUNP(5, ph_gqa_prep(c, l)); break;
    case 6: ph_carries(c, l);
#if USE_MFMA_NA
#if USE_NA_FLASHBODY
        RUNP(6, ph_na_flash(c, l, need_ctx));
#else
        RUNP(6, ph_na_mfma(c, l, need_ctx));
#endif
#else
        ph_na_naive(c, l, need_ctx);
#endif
#if USE_FLASH_GQA
        RUNP(7, ph_gqa_flash(c, l, need_ctx));
#else
        ph_gqa_naive(c, need_ctx);
#endif
        break;
    case 7: { const int sb = s5b_blocks(c.G); RUNP(3, s5m::run<true>(c, l, mrows2, sb)); RUNP(4, LRU_RUN_FROM(true, sb)); } break;
    case 8: { EpiGlu E{Y}; pg8::Gemm g{Y, c.wl(l, W_GLU), mrows2, GWD, GWD, DM, GWD}; pg8::StaticOrder S; S.init(mrows2, GWD, c.G, c.bx); PgEpi<EpiGlu> PE{E};
              pg8::gemm_phase<PgEpi<EpiGlu>, pg8::StaticOrder, true, true>(c.lds, g, S, PE); } break;
    case 9: gemm_resid_all(c, Y, c.wl(l, W_OUT), DM, DM, l, 5, 1.0f, need_ctx, PARTB); break;
    case 10: ph_norm_mod(c, l, c.in(I_GFFN2) + (size_t)l * DM, 6, 7, mrows2, need_ctx ? Pending{PARTB, DM / 256, l, 5, 1.0f} : Pending{nullptr, 0, 0, 0, 0.f}); break;
    case 11: { EpiSwiglu E{G}; gemm_run_swiglu(c, XN, c.wl(l, W_2I), mrows2, DM, E); } break;
    case 12: gemm_resid_all<false, l == NL - 1>(c, G, c.wl(l, W_2O), DM, DFF, l, 8, 0.5f, need_ctx, PARTY); break;
    }
}

#ifndef HOST_EMU
#define XB_TMO      128
#define XB_XCNT(j)  (256  + 64 * (j))
#define XB_XSUB(j)  (1280 + 64 * (j))
#define XB_XGEN(j)  (2304 + 64 * (j))
#define XB_TOP      3328
#define XB_TOPGEN   3392
#define XCD_BAR_WORDS 3456
#define XB_SPIN_CAP (1u << 22)
__device__ __forceinline__ unsigned xb_ld(unsigned* p)              { return __hip_atomic_load(p, __ATOMIC_RELAXED, __HIP_MEMORY_SCOPE_AGENT); }
__device__ __forceinline__ unsigned xb_add(unsigned* p, unsigned v) { return __hip_atomic_fetch_add(p, v, __ATOMIC_RELAXED, __HIP_MEMORY_SCOPE_AGENT); }
__device__ __forceinline__ unsigned xb_xcc_id() { return (unsigned)__builtin_amdgcn_s_getreg((3 << 11) | 20) & 0xFu; }
#define XB_SPIN(cond, bar) do { unsigned _sp = 0; while (cond) { __builtin_amdgcn_s_sleep(1); \
    if ((++_sp & 255u) == 0u) { if (xb_ld(&(bar)[XB_TMO])) break; if (_sp > XB_SPIN_CAP) { atomicAdd(&(bar)[XB_TMO], 1u); break; } } } } while (0)
struct XcdBarrier { unsigned* bar; unsigned x; volatile LAS unsigned* st; };
__device__ __forceinline__ XcdBarrier xcd_barrier_post(unsigned* bar, volatile LAS unsigned* st) {
    XcdBarrier b; b.bar = bar; b.x = xb_xcc_id(); b.st = st;
    if (threadIdx.x == 0) (void)xb_add(&bar[XB_XCNT(b.x)], 1u);
    return b;
}
__device__ __forceinline__ void xcd_barrier_complete(unsigned* bar, unsigned x, unsigned& nloc, unsigned& nx) {
    const unsigned G = gridDim.x * gridDim.y * gridDim.z;
    unsigned sum, cnt, mine, sp = 0u;
    for (;;) {
        sum = 0u; cnt = 0u; mine = 0u;
#pragma unroll
        for (unsigned j = 0; j < 16; ++j) { const unsigned cj = xb_ld(&bar[XB_XCNT(j)]); sum += cj; cnt += (cj > 0u) ? 1u : 0u; mine = (j == x) ? cj : mine; }
        if (sum == G) break;
        __builtin_amdgcn_s_sleep(1);
        if ((++sp & 255u) == 0u) { if (xb_ld(&bar[XB_TMO])) break; if (sp > XB_SPIN_CAP) { atomicAdd(&bar[XB_TMO], 1u); break; } }
    }
    nloc = mine > 0u ? mine : 1u; nx = cnt > 0u ? cnt : 1u;
}
__device__ __forceinline__ void xcd_barrier(const XcdBarrier& b) {
    asm volatile("s_waitcnt vmcnt(0)" ::: "memory");
    __syncthreads();
    if (threadIdx.x == 0) {
        unsigned* bar = b.bar;
        __builtin_amdgcn_s_waitcnt(0);
        unsigned nloc = b.st[0], nx = b.st[1];
        if (nloc == 0u) { xcd_barrier_complete(bar, b.x, nloc, nx); b.st[0] = nloc; b.st[1] = nx; }
        const unsigned old = xb_add(&bar[XB_XSUB(b.x)], 1u);
        const unsigned gen = old / nloc;
        if (old + 1u == (gen + 1u) * nloc) {
            __builtin_amdgcn_fence(__ATOMIC_RELEASE, "agent");
            asm volatile("s_waitcnt vmcnt(0)" ::: "memory");
            const unsigned og = xb_add(&bar[XB_TOP], 1u);
            const unsigned tg = og / nx;
            if (og + 1u == (tg + 1u) * nx) xb_add(&bar[XB_TOPGEN], 1u);
            else XB_SPIN(xb_ld(&bar[XB_TOPGEN]) == tg, bar);
            __builtin_amdgcn_fence(__ATOMIC_ACQUIRE, "agent");
            xb_add(&bar[XB_XGEN(b.x)], 1u);
            asm volatile("s_waitcnt vmcnt(0)" ::: "memory");
        } else {
            XB_SPIN(xb_ld(&bar[XB_XGEN(b.x)]) == gen, bar);
            __builtin_amdgcn_fence(__ATOMIC_ACQUIRE, "agent");
            asm volatile("s_waitcnt vmcnt(0)" ::: "memory");
        }
    }
    __syncthreads();
}
#endif

#ifdef HOST_EMU
template <int PH> __device__ __forceinline__ void phases_from(const Ctx& c, int lo, int hi) {
    if constexpr (PH < N_PHASES) { if (lo <= PH && PH < hi) run_phase<PH>(c); phases_from<PH + 1>(c, lo, hi); }
}
#else
template <int PH> __device__ __forceinline__ void phases_from(const Ctx& c, int lo, int hi, const XcdBarrier& bar) {
    if constexpr (PH < N_PHASES) { if (lo <= PH && PH < hi) { run_phase<PH>(c); if (PH + 1 < hi) xcd_barrier(bar); } phases_from<PH + 1>(c, lo, hi, bar); }
}
#endif
#ifdef HOST_EMU
static void mega_body(const Params& prm) {
    unsigned char* lds_raw = emu_lds();
#else
__global__ void __launch_bounds__(NT, 2) mega_kernel(Params prm) {
    extern __shared__ __attribute__((aligned(16))) unsigned char lds_raw[];
#endif
    Ctx c; c.p = &prm; c.ws = prm.ws; c.lds = (LAS unsigned char*)lds_raw;
    c.tid = threadIdx.x; c.lane = c.tid & 63; c.wave = __builtin_amdgcn_readfirstlane(c.tid >> 6);
    c.G = gridDim.x; c.bx = blockIdx.x; c.gw = c.bx * NWAVES + c.wave; c.NGW = c.G * NWAVES; c.gt = c.bx * NT + c.tid; c.NGT = c.G * NT;
#ifndef HOST_EMU
    volatile LAS unsigned* misc = (volatile LAS unsigned*)(c.lds + LDS_MISC);
    if (c.tid < 16) misc[c.tid] = 0u;
    __syncthreads();
    XcdBarrier bar; bar.bar = (unsigned*)(c.ws + WS_CTL) + 4096; bar.x = 0; bar.st = nullptr;
    const bool multi = prm.ph_hi - prm.ph_lo > 1;
    if (multi) bar = xcd_barrier_post((unsigned*)(c.ws + WS_CTL) + 4096, misc + 8);
#endif
    phases_from<0>(c, prm.ph_lo, prm.ph_hi
#ifndef HOST_EMU
        , bar
#endif
        );
}

#ifndef HOST_EMU
#ifndef MK_PER_PHASE
#define MK_PER_PHASE 0
#endif
extern "C" void kernel_launch(void* const* d_in, const int* in_sizes, int n_in, void* d_out, int out_size, void* d_ws, size_t ws_size, hipStream_t stream) {
    static int grid = 0;
    if (grid == 0) {
        if (n_in != N_IN || out_size != MLAT * DM || ws_size < WS_END) { fprintf(stderr, "kernel_launch: unexpected shapes (n_in %d out %d ws %zu need %zu)\n", n_in, out_size, ws_size, (size_t)WS_END); grid = -1; return; }
        int dev = 0, cus = 0, per_cu = 0;
        if (hipGetDevice(&dev) != hipSuccess || hipDeviceGetAttribute(&cus, hipDeviceAttributeMultiprocessorCount, dev) != hipSuccess) { grid = -1; return; }
        if (hipFuncSetAttribute((const void*)mega_kernel, hipFuncAttributeMaxDynamicSharedMemorySize, LDS_BYTES) != hipSuccess) { fprintf(stderr, "kernel_launch: hipFuncSetAttribute failed\n"); grid = -1; return; }
        if (hipOccupancyMaxActiveBlocksPerMultiprocessor(&per_cu, (const void*)mega_kernel, NT, LDS_BYTES) != hipSuccess || per_cu < 1) fprintf(stderr, "kernel_launch: occupancy query says %d\n", per_cu);
        (void)hipGetLastError();
        grid = cus;
    }
    if (grid < 0) return;
    (void)hipMemsetAsync((char*)d_ws + WS_CTL, 0, CTL_ZERO_BYTES, stream);
    Params p{};
    for (int i = 0; i < N_IN; ++i) p.in[i] = (const float*)d_in[i];
    p.out = (float*)d_out; p.ws = (unsigned char*)d_ws;
#if MK_PER_PHASE
    for (int ph = 0; ph < N_PHASES; ++ph) { p.ph_lo = ph; p.ph_hi = ph + 1; hipLaunchKernelGGL(mega_kernel, dim3(grid), dim3(NT), LDS_BYTES, stream, p); }
#else
    p.ph_lo = 0; p.ph_hi = N_PHASES; hipLaunchKernelGGL(mega_kernel, dim3(grid), dim3(NT), LDS_BYTES, stream, p);
#endif
}
#endif
```

```cpp
#ifndef HOST_EMU
#include <hip/hip_runtime.h>
#include <cstdio>
#include <cstdint>
#define LAS __attribute__((address_space(3)))
#define GAS __attribute__((address_space(1)))
#else
#define LAS
#define GAS
#endif
#ifdef HOST_EMU
static inline void emu_atomic_add_f32(float* p, float v) { unsigned* u = (unsigned*)p; unsigned o = __atomic_load_n(u, __ATOMIC_RELAXED), n; do { float f; memcpy(&f, &o, 4); f += v; memcpy(&n, &f, 4); } while (!__atomic_compare_exchange_n(u, &o, n, false, __ATOMIC_RELAXED, __ATOMIC_RELAXED)); }
#define ATOMIC_ADD_F32(p, v) emu_atomic_add_f32((p), (v))
#define WAVE_SYNC() emu_yield(EMU_WAVE)
#else
#define ATOMIC_ADD_F32(p, v) ((void)atomicAdd((p), (v)))
#define WAVE_SYNC() __builtin_amdgcn_wave_barrier()
#endif

#ifndef CFG_DM
#define CFG_DM 1024
#define CFG_T 8192
#define CFG_TC 256
#define CFG_GW 64
#endif
constexpr int DM = CFG_DM, NB = 2, T = CFG_T, TC = CFG_TC, GW = CFG_GW, NROWS = T / GW, NL = 2;
constexpr int GWD = DM / 4, NH = GWD / 64, NKV = (NH / 2 > 0) ? NH / 2 : 1, GQG = NH / NKV, S5G = GWD / 16;
constexpr int DFF = ((8 * DM / 3 + 127) / 128) * 128;
constexpr int INC = 7 * GWD + 2 * NKV * 64;
constexpr int MLAT = NB * T, MCTX = NB * TC, M = MLAT + MCTX;
constexpr int PC_S5 = 0, PC_NAQ = GWD, PC_NAK = 2 * GWD, PC_NAV = 3 * GWD, PC_GQ = 4 * GWD, PC_GK = 5 * GWD, PC_GV = 5 * GWD + NKV * 64, PC_LX = 5 * GWD + 2 * NKV * 64, PC_LG = PC_LX + GWD;
constexpr int NMOD = 9;
constexpr float EPS = 1e-6f;
constexpr int NT = 512, NWAVES = 8;
constexpr int LS5 = 64;
constexpr int NCH5 = (TC + T) / LS5;
constexpr int LL = 32;
constexpr int NCT = TC / LL, NLT = T / LL, NTL = NCT + NLT;
constexpr int ADA_KC = DM / 64;
static_assert(T % LS5 == 0 && TC % LS5 == 0 && T % LL == 0 && TC % LL == 0 && GWD % 64 == 0 && DM % 256 == 0, "shape");

enum { I_X = 0, I_C, I_CTX, I_CCTX, I_WADA, I_BADA, I_GFFN1, I_W1I, I_W1O, I_GMIX, I_WIN, I_WOUT, I_S5LRE, I_S5LIM, I_S5STEP, I_S5BRE, I_S5BIM, I_S5CRE, I_S5CIM,
       I_S5D, I_S5GLU, I_RPB, I_GQN, I_GKN, I_LCW, I_LCB, I_LWA, I_LBA, I_LWX, I_LBX, I_LLAM, I_GFFN2, I_W2I, I_W2O, I_GFINAL, N_IN };

typedef unsigned short bf16;
typedef float f32x4 __attribute__((ext_vector_type(4)));
typedef unsigned u32x4 __attribute__((ext_vector_type(4)));
typedef unsigned u32x2 __attribute__((ext_vector_type(2)));

constexpr size_t MiB = 1u << 20;
constexpr size_t al(size_t x) { return (x + 255) & ~(size_t)255; }
constexpr size_t WS_CTL = 0, CTL_ZERO_BYTES = 1 * MiB;
constexpr size_t WS_MODS = WS_CTL + CTL_ZERO_BYTES;
constexpr size_t WS_MODP = WS_MODS + al((size_t)NL * 3 * NMOD * DM * 4);
constexpr size_t WS_S5E = WS_MODP + al((size_t)ADA_KC * NL * 3 * NMOD * DM * 4);
constexpr size_t WS_LRUE = WS_S5E + al((size_t)NB * S5G * 2 * NCH5 * 64 * 2 * 4);
constexpr int ROPE_NPOS = (NROWS > GW ? NROWS : GW);
constexpr size_t WS_ROPE = WS_LRUE + al((size_t)NB * 2 * NTL * GWD * 2 * 4);
constexpr size_t WS_LRUW = WS_ROPE + al((size_t)ROPE_NPOS * 32 * 4);
constexpr size_t S5T_BYTES = 2 * 12 * 64 * 16 + 2 * 2 * 10 * 64 * 8;
constexpr size_t WS_S5T = WS_LRUW + al((size_t)NL * 2 * 2 * NH * 2 * 4 * 64 * 16);
constexpr size_t WS_HCTX = WS_S5T + al((size_t)NL * S5G * S5T_BYTES);
constexpr size_t W_1I = 0, W_1O = W_1I + (size_t)2 * DFF * DM * 2, W_IN = W_1O + (size_t)DM * DFF * 2, W_OUT = W_IN + (size_t)INC * DM * 2,
                 W_2I = W_OUT + (size_t)DM * DM * 2, W_2O = W_2I + (size_t)2 * DFF * DM * 2, W_GLU = W_2O + (size_t)DM * DFF * 2, W_LAYER = al(W_GLU + (size_t)GWD * GWD * 2);
constexpr size_t WS_W = WS_HCTX + al((size_t)MCTX * DM * 4);
constexpr size_t WS_XN = WS_W + NL * W_LAYER;
constexpr size_t WS_Y = WS_XN + al((size_t)M * DM * 2);
constexpr size_t Y_BYTES = ((size_t)M * DM * 2 > (size_t)(DFF / 256) * MCTX * DM * 4) ? (size_t)M * DM * 2 : (size_t)(DFF / 256) * MCTX * DM * 4;
constexpr size_t WS_BIG = WS_Y + al(Y_BYTES);
constexpr size_t BIG_P = 0, BIG_QN = al((size_t)M * INC * 2), BIG_KN = BIG_QN + al((size_t)M * GWD * 2), BIG_VN = BIG_KN + al((size_t)M * NKV * 64 * 2), BIG_END = BIG_VN + al((size_t)M * NKV * 64 * 2);
constexpr size_t BIG_BYTES = ((size_t)M * DFF * 2 > BIG_END) ? al((size_t)M * DFF * 2) : BIG_END;
constexpr size_t WS_END = WS_BIG + BIG_BYTES;
static_assert((size_t)2 * M * GWD * 4 <= (size_t)M * DM * 2, "YS5 overlay fits XN");
static_assert(CFG_DM != 1024 || WS_END <= 290 * MiB, "workspace budget");

constexpr int LDS_BYTES = 147456;
constexpr int LDS_MISC = 131072;

__device__ __forceinline__ unsigned f2bf(float f) { unsigned u = __builtin_bit_cast(unsigned, f); return (u + 0x7fffu + ((u >> 16) & 1u)) >> 16; }
__device__ __forceinline__ float bf2f(unsigned h) { return __builtin_bit_cast(float, h << 16); }
__device__ __forceinline__ unsigned pk2(float lo, float hi) { return f2bf(lo) | (f2bf(hi) << 16); }
__device__ __forceinline__ float bflo(unsigned w) { return __builtin_bit_cast(float, w << 16); }
__device__ __forceinline__ float bfhi(unsigned w) { return __builtin_bit_cast(float, w & 0xffff0000u); }
__device__ __forceinline__ float wave_sum(float v) {
#pragma unroll
    for (int o = 1; o < 64; o <<= 1) v += __shfl_xor(v, o);
    return v;
}
__device__ __forceinline__ float sigmoidf_(float x) { return __builtin_amdgcn_rcpf(1.f + __builtin_amdgcn_exp2f(-1.4426950408889634f * x)); }
__device__ __forceinline__ float siluf_(float x) { return x * sigmoidf_(x); }
__device__ __forceinline__ float geluf_(float x) { const float u = 0.7978845608028654f * (x + 0.044715f * x * x * x); return x * sigmoidf_(2.f * u); }
__device__ __forceinline__ float softplusf_(float x) { return x > 20.f ? x : log1pf(expf(x)); }
__device__ __forceinline__ void ld8bf(const bf16* p, float (&v)[8]) { const u32x4 w = *(const u32x4*)p; v[0] = bflo(w.x); v[1] = bfhi(w.x); v[2] = bflo(w.y); v[3] = bfhi(w.y); v[4] = bflo(w.z); v[5] = bfhi(w.z); v[6] = bflo(w.w); v[7] = bfhi(w.w); }
__device__ __forceinline__ void st8bf(bf16* p, const float (&v)[8]) { u32x4 w; w.x = pk2(v[0], v[1]); w.y = pk2(v[2], v[3]); w.z = pk2(v[4], v[5]); w.w = pk2(v[6], v[7]); *(u32x4*)p = w; }

struct Params { const float* in[N_IN]; float* out; unsigned char* ws; int ph_lo, ph_hi, pad0, pad1; };

struct Ctx {
    const Params* p; unsigned char* ws; LAS unsigned char* lds; int tid, lane, wave, G, bx, gw, NGW, gt, NGT;
    __device__ __forceinline__ const float* in(int i) const { return p->in[i]; }
    __device__ __forceinline__ float* hrow(int row) const { return row < MLAT ? p->out + (size_t)row * DM : (float*)(ws + WS_HCTX) + (size_t)(row - MLAT) * DM; }
    __device__ __forceinline__ bf16* hb(int row) const { return (bf16*)p->out + (size_t)row * DM; }
    __device__ __forceinline__ bf16* hfin(int row) const { return (bf16*)(ws + WS_XN) + (size_t)row * DM; }
    __device__ __forceinline__ const float* mods(int l, int which, int k) const { return (const float*)(ws + WS_MODS) + ((size_t)(l * 3 + which) * NMOD + k) * DM; }
    __device__ __forceinline__ bf16* wl(int l, size_t off) const { return (bf16*)(ws + WS_W + (size_t)l * W_LAYER + off); }
};
__device__ __forceinline__ int row_mi(int row) { return row < MLAT ? row / T : 2; }

__device__ __forceinline__ void ph_ada_partial(const Ctx& c) {
    constexpr int NJB = NMOD * DM / 256; const int nitems = NL * NJB * ADA_KC;
    const float* cc = c.in(I_C); const float* cctx = c.in(I_CCTX);
    for (int it = c.gw; it < nitems; it += c.NGW) {
        const int kc = it % ADA_KC, jb = (it / ADA_KC) % NJB, l = it / (ADA_KC * NJB);
        const float* w = c.in(I_WADA) + (size_t)l * DM * NMOD * DM + (size_t)(kc * 64) * NMOD * DM + jb * 256 + c.lane * 4;
        f32x4 a0 = {0, 0, 0, 0}, a1 = a0, a2 = a0;
#pragma unroll 8
        for (int k = 0; k < 64; ++k) { const f32x4 wv = *(const f32x4*)(w + (size_t)k * NMOD * DM); const int kk = kc * 64 + k;
            const float s0 = siluf_(cc[kk]), s1 = siluf_(cc[DM + kk]), s2 = siluf_(cctx[kk]); a0 += wv * s0; a1 += wv * s1; a2 += wv * s2; }
        float* mp = (float*)(c.ws + WS_MODP) + ((size_t)(kc * NL + l) * 3) * NMOD * DM + jb * 256 + c.lane * 4;
        *(f32x4*)(mp) = a0; *(f32x4*)(mp + NMOD * DM) = a1; *(f32x4*)(mp + 2 * NMOD * DM) = a2;
    }
}
__device__ __forceinline__ void ph_mods_reduce(const Ctx& c) {
    const int n = NL * 3 * NMOD * DM;
    for (int i = c.gt; i < n; i += c.NGT) { const int j = i % (NMOD * DM), l = i / (3 * NMOD * DM);
        float s = c.in(I_BADA)[(size_t)l * NMOD * DM + j];
#pragma unroll
        for (int kc = 0; kc < ADA_KC; ++kc) { const int lw = i / (NMOD * DM); s += ((const float*)(c.ws + WS_MODP))[((size_t)kc * NL * 3 + lw) * NMOD * DM + j]; }
        ((float*)(c.ws + WS_MODS))[i] = s; }
}
__device__ __forceinline__ int cvt_row(int n, int kind) { if (kind == 0) return n; const int j = n < DFF ? n : n - DFF; return (j / 128) * 256 + (n < DFF ? 0 : 128) + (j % 128); }
__device__ __forceinline__ void cvt_item(const Ctx& c, const float* W, int K, int N, bf16* WT, int kind, int item) {
    LAS float* scr = (LAS float*)(c.lds + c.wave * 16384); const int lane = c.lane;
    const int nblk = N / 32, kb = item / nblk, nb = item % nblk, k0 = 64 * kb, n0 = 32 * nb;
#pragma unroll 8
    for (int i = 0; i < 32; ++i) { const int kk = 2 * i + (lane >> 5); scr[kk * 33 + (lane & 31)] = W[(size_t)(k0 + kk) * N + n0 + (lane & 31)]; }
    WAVE_SYNC();
    const int ch = lane & 7;
#pragma unroll
    for (int j = 0; j < 4; ++j) { const int n = (lane >> 3) + 8 * j; const LAS float* sp = scr + (8 * ch) * 33 + n;
        u32x4 o; o.x = pk2(sp[0 * 33], sp[1 * 33]); o.y = pk2(sp[2 * 33], sp[3 * 33]); o.z = pk2(sp[4 * 33], sp[5 * 33]); o.w = pk2(sp[6 * 33], sp[7 * 33]);
        *(u32x4*)(WT + (size_t)cvt_row(n0 + n, kind) * K + k0 + 8 * ch) = o; }
    WAVE_SYNC();
}
__device__ __forceinline__ void ph_cvt_all(const Ctx& c) {
    static_assert(DM % 64 == 0 && DFF % 64 == 0 && GWD % 64 == 0, "transpose items");
    constexpr int I_1I = (DM / 64) * (2 * DFF / 32), I_1O = (DFF / 64) * (DM / 32), I_IN = (DM / 64) * (INC / 32), I_OUT = (DM / 64) * (DM / 32), I_GL = (GWD / 64) * (GWD / 32);
    constexpr int PER_L = 2 * I_1I + 2 * I_1O + I_IN + I_OUT + I_GL;
    for (int it = c.gw; it < NL * PER_L; it += c.NGW) { const int l = it / PER_L; int r = it % PER_L;
        if (r < I_1I) { cvt_item(c, c.in(I_W1I) + (size_t)l * DM * 2 * DFF, DM, 2 * DFF, c.wl(l, W_1I), 1, r); continue; } r -= I_1I;
        if (r < I_1I) { cvt_item(c, c.in(I_W2I) + (size_t)l * DM * 2 * DFF, DM, 2 * DFF, c.wl(l, W_2I), 1, r); continue; } r -= I_1I;
        if (r < I_1O) { cvt_item(c, c.in(I_W1O) + (size_t)l * DFF * DM, DFF, DM, c.wl(l, W_1O), 0, r); continue; } r -= I_1O;
        if (r < I_1O) { cvt_item(c, c.in(I_W2O) + (size_t)l * DFF * DM, DFF, DM, c.wl(l, W_2O), 0, r); continue; } r -= I_1O;
        if (r < I_IN) { cvt_item(c, c.in(I_WIN) + (size_t)l * DM * INC, DM, INC, c.wl(l, W_IN), 0, r); continue; } r -= I_IN;
        if (r < I_OUT) { cvt_item(c, c.in(I_WOUT) + (size_t)l * DM * DM, DM, DM, c.wl(l, W_OUT), 0, r); continue; } r -= I_OUT;
        cvt_item(c, c.in(I_S5GLU) + (size_t)l * GWD * GWD, GWD, GWD, c.wl(l, W_GLU), 0, r);
    }
}
__device__ __forceinline__ void ph_tables(const Ctx& c) {
    float* rope = (float*)(c.ws + WS_ROPE);
    for (int i = c.gt; i < ROPE_NPOS * 16; i += c.NGT) { const int pos = i / 16, k = i % 16; const float ang = (float)pos * powf(10000.f, -(float)k / 16.f); rope[pos * 32 + k] = cosf(ang); rope[pos * 32 + 16 + k] = sinf(ang); }
    u32x4* lw = (u32x4*)(c.ws + WS_LRUW); const int n = NL * 2 * 2 * NH * 2 * 4 * 64;
    for (int i = c.gt; i < n; i += c.NGT) { const int lane = i & 63, ks = (i >> 6) & 3, half = (i >> 8) & 1, blk = (i >> 9) % NH, gate = (i / (512 * NH)) & 1, ld = i / (1024 * NH);
        const int r32 = lane & 31, hi = lane >> 5; const float* w = c.in(gate ? I_LWX : I_LWA) + (((size_t)ld * NH + blk) * 64) * 64 + half * 32 + r32; u32x4 o;
#pragma unroll
        for (int q = 0; q < 4; ++q) { const int d = 16 * ks + 8 * hi + 2 * q; o[q] = pk2(w[(size_t)d * 64], w[(size_t)(d + 1) * 64]); }
        lw[i] = o; }
}
__device__ __forceinline__ void ph_h_init(const Ctx& c) {
    const size_t n4 = (size_t)M * DM / 4;
    for (size_t i = c.gt; i < n4; i += c.NGT) { const size_t e = i * 4; const int row = (int)(e / DM), col = (int)(e % DM);
        const f32x4 v = row < MLAT ? *(const f32x4*)(c.in(I_X) + e) : *(const f32x4*)(c.in(I_CTX) + (e - (size_t)MLAT * DM));
        *(f32x4*)(c.hrow(row) + col) = v; }
}

struct Pending { const bf16* part; int nks, pl, pgate; float pscale; };
__device__ __forceinline__ void ph_norm_mod(const Ctx& c, int l, const float* g, int k_shift, int k_scale, int mrows, const Pending pend = Pending{nullptr, 0, 0, 0, 0.f}, int src_mode = 0) {
    constexpr int NV = DM / 256, U = 2; bf16* XN = (bf16*)(c.ws + WS_XN);
    for (int row0 = c.gw; row0 < mrows; row0 += U * c.NGW) {
        int row[U]; bool ok[U]; float* h[U]; f32x4 v[U][NV]; float s[U];
#pragma unroll
        for (int u = 0; u < U; ++u) { const int r = row0 + u * c.NGW; ok[u] = r < mrows; row[u] = ok[u] ? r : row0; h[u] = c.hrow(row[u]);
            const float* hs = (src_mode == 1 || (src_mode == 2 && row[u] >= MLAT)) ? (row[u] < MLAT ? c.in(I_X) + (size_t)row[u] * DM : c.in(I_CTX) + (size_t)(row[u] - MLAT) * DM) : h[u];
#pragma unroll
            for (int j = 0; j < NV; ++j) { if (row[u] < MLAT && src_mode != 1) { const u32x2 w = *(const u32x2*)(c.hb(row[u]) + j * 256 + c.lane * 4); v[u][j] = (f32x4){bf2f(w.x & 0xffffu), bf2f(w.x >> 16), bf2f(w.y & 0xffffu), bf2f(w.y >> 16)}; }
                else v[u][j] = *(const f32x4*)(hs + j * 256 + c.lane * 4); } }
#pragma unroll
        for (int u = 0; u < U; ++u) if (ok[u] && pend.part && row[u] >= MLAT) { const float* pg = c.mods(pend.pl, 2, pend.pgate);
#pragma unroll
            for (int j = 0; j < NV; ++j) { const int col = j * 256 + c.lane * 4; f32x4 a = {0.f, 0.f, 0.f, 0.f};
                for (int ks = 0; ks < pend.nks; ++ks) { const u32x2 w = *(const u32x2*)(pend.part + ((size_t)ks * MCTX + (row[u] - MLAT)) * DM + col); a += (f32x4){bf2f(w.x & 0xffffu), bf2f(w.x >> 16), bf2f(w.y & 0xffffu), bf2f(w.y >> 16)}; }
                v[u][j] += a * *(const f32x4*)(pg + col) * pend.pscale; if (ok[u]) *(f32x4*)(h[u] + col) = v[u][j]; } }
#pragma unroll
        for (int u = 0; u < U; ++u) { s[u] = 0.f;
#pragma unroll
            for (int j = 0; j < NV; ++j) s[u] += v[u][j].x * v[u][j].x + v[u][j].y * v[u][j].y + v[u][j].z * v[u][j].z + v[u][j].w * v[u][j].w; }
#pragma unroll
        for (int o = 1; o < 64; o <<= 1) {
#pragma unroll
            for (int u = 0; u < U; ++u) s[u] += __shfl_xor(s[u], o); }
#pragma unroll
        for (int u = 0; u < U; ++u) { const float rstd = 1.f / sqrtf(s[u] * (1.f / DM) + EPS);
            const int mi = row_mi(row[u]); const float* sh = c.mods(l, mi, k_shift); const float* sc = c.mods(l, mi, k_scale);
#pragma unroll
            for (int j = 0; j < NV; ++j) { const int col = j * 256 + c.lane * 4; const f32x4 gv = *(const f32x4*)(g + col), shv = *(const f32x4*)(sh + col), scv = *(const f32x4*)(sc + col);
                const f32x4 y = v[u][j] * rstd * gv * (scv + 1.f) + shv; u32x2 w; w.x = pk2(y.x, y.y); w.y = pk2(y.z, y.w); if (ok[u]) *(u32x2*)(XN + (size_t)row[u] * DM + col) = w; } }
    }
}
__device__ __forceinline__ void ph_norm_final(const Ctx& c) {
    constexpr int NV = DM / 256; const float* g = c.in(I_GFINAL);
    for (int row = c.gw; row < MLAT; row += c.NGW) {
        float* h = c.p->out + (size_t)row * DM; const bf16* hl = c.hfin(row); f32x4 v[NV]; float s = 0.f;
#pragma unroll
        for (int j = 0; j < NV; ++j) { const u32x2 w = *(const u32x2*)(hl + j * 256 + c.lane * 4); v[j] = (f32x4){bf2f(w.x & 0xffffu), bf2f(w.x >> 16), bf2f(w.y & 0xffffu), bf2f(w.y >> 16)}; s += v[j].x * v[j].x + v[j].y * v[j].y + v[j].z * v[j].z + v[j].w * v[j].w; }
        const float rstd = 1.f / sqrtf(wave_sum(s) * (1.f / DM) + EPS);
#pragma unroll
        for (int j = 0; j < NV; ++j) { const int col = j * 256 + c.lane * 4; const f32x4 y = v[j] * rstd * *(const f32x4*)(g + col);
#ifdef HOST_EMU
            *(f32x4*)(h + col) = y;
#else
            __builtin_nontemporal_store(y, (f32x4*)(h + col));
#endif
        }
    }
}

struct EpiSwiglu { bf16* G;
    __device__ __forceinline__ void operator()(int row, int j0, const float (&a)[8], const float (&b)[8]) const { float o[8];
#pragma unroll
        for (int i = 0; i < 8; ++i) o[i] = siluf_(a[i]) * b[i];
        st8bf(G + (size_t)row * DFF + j0, o); } };
template <bool FROMX, bool LAST = false> struct EpiResidT { const Ctx* c; int l, k_gate; float scale;
    __device__ __forceinline__ void operator()(int row, int c0, const float (&v)[8]) const { const float* g = c->mods(l, row_mi(row), k_gate) + c0; float h[8];
        if (FROMX) { const float* x = c->in(I_X) + (size_t)row * DM + c0;
#pragma unroll
            for (int i = 0; i < 8; ++i) h[i] = x[i]; } else ld8bf(c->hb(row) + c0, h);
#pragma unroll
        for (int i = 0; i < 8; ++i) h[i] += v[i] * g[i] * scale;
        st8bf((LAST ? c->hfin(row) : c->hb(row)) + c0, h); } };
struct EpiP { bf16* P;
    __device__ __forceinline__ void operator()(int row, int c0, const float (&v)[8]) const { st8bf(P + (size_t)row * INC + c0, v); } };

template <class Epi> __device__ __forceinline__ void gemm_naive_ld(const Ctx& c, const bf16* A, const bf16* Bt, int mrows, int N, int K, int ld, const Epi& E);
template <class Epi> __device__ __forceinline__ void gemm_naive(const Ctx& c, const bf16* A, const bf16* Bt, int mrows, int N, int K, const Epi& E) { gemm_naive_ld(c, A, Bt, mrows, N, K, K, E); }
template <class Epi> __device__ __forceinline__ void gemm_naive_ld(const Ctx& c, const bf16* A, const bf16* Bt, int mrows, int N, int K, int ld, const Epi& E) {
    const int ncg = N / 8; const long nitems = (long)mrows * ncg;
    for (long it = c.gt; it < nitems; it += c.NGT) { const int row = (int)(it / ncg), c0 = (int)(it % ncg) * 8; float acc[8];
#pragma unroll
        for (int i = 0; i < 8; ++i) acc[i] = 0.f;
        const bf16* a = A + (size_t)row * ld;
        for (int k = 0; k < K; k += 8) { float av[8]; ld8bf(a + k, av);
#pragma unroll
            for (int i = 0; i < 8; ++i) { float bv[8]; ld8bf(Bt + (size_t)(c0 + i) * ld + k, bv);
#pragma unroll
                for (int j = 0; j < 8; ++j) acc[i] += av[j] * bv[j]; } }
        E(row, c0, acc); }
}
__device__ __forceinline__ void gemm_naive_swiglu(const Ctx& c, const bf16* A, const bf16* Bt, int mrows, int K, const EpiSwiglu& E) {
    const int ncg = DFF / 8; const long nitems = (long)mrows * ncg;
    for (long it = c.gt; it < nitems; it += c.NGT) { const int row = (int)(it / ncg), j0 = (int)(it % ncg) * 8; float aa[8], ab[8];
#pragma unroll
        for (int i = 0; i < 8; ++i) { aa[i] = 0.f; ab[i] = 0.f; }
        const bf16* a = A + (size_t)row * K; const int ra = (j0 / 128) * 256 + (j0 % 128);
        for (int k = 0; k < K; k += 8) { float av[8]; ld8bf(a + k, av);
#pragma unroll
            for (int i = 0; i < 8; ++i) { float bv[8]; ld8bf(Bt + (size_t)(ra + i) * K + k, bv);
#pragma unroll
                for (int j = 0; j < 8; ++j) aa[i] += av[j] * bv[j];
                ld8bf(Bt + (size_t)(ra + 128 + i) * K + k, bv);
#pragma unroll
                for (int j = 0; j < 8; ++j) ab[i] += av[j] * bv[j]; } }
        E(row, j0, aa, ab); }
}

namespace pg8 {
#define PG8_LAS LAS
typedef unsigned short bf16_t;
typedef short bf16x8 __attribute__((ext_vector_type(8)));
typedef float f32x4 __attribute__((ext_vector_type(4)));
typedef unsigned u32x4 __attribute__((ext_vector_type(4)));
constexpr int BM = 256, BK = 64, HALF = 128, HTB = HALF * BK * 2  , STAGE_BYTES = 8 * HTB, NXCD = 8, WGM = 8;

__host__ __device__ __forceinline__ int lds_byte(int r, int c) { const int st = (r >> 4) * 2 + (c >> 5), rr = r & 15, cc = c & 31, ob = rr * 64 + cc * 2; return st * 1024 + (ob ^ (((ob >> 9) & 1) << 5)); }
__host__ __device__ __forceinline__ void stage_rc(int b, int& R, int& C) { const int st = b / 1024, sb = b % 1024, swz = sb ^ (((sb >> 9) & 1) << 5); R = (st >> 1) * 16 + swz / 64; C = (st & 1) * 32 + (swz % 64) / 2; }
__host__ __device__ __forceinline__ int perm32(int rho) { const int n = rho >> 4, i = rho & 15; return 8 * (i >> 2) + 4 * n + (i & 3); }

struct Unit { int pm, pn; };
struct Gemm { const bf16_t* A; const bf16_t* Bt; int M, N, K, lda, ldb; };

struct StaticOrder {
    int nM, nN, nwg, G, c;
    __host__ __device__ void init(int M, int N, int G_, int c_) { nM = M / BM; nN = N / BM; nwg = nM * nN; G = G_; c = c_; }
    __host__ __device__ bool next(int i, Unit& u) const {
        const long L = (long)i * G + c; if (L >= nwg) return false;
        int wgid = (int)L; { const int q = nwg / NXCD, r = nwg % NXCD, xcd = wgid % NXCD, off = wgid / NXCD; wgid = (xcd < r ? xcd * (q + 1) : r * (q + 1) + (xcd - r) * q) + off; }
        const int nig = WGM * nN, gid = wgid / nig, fm = gid * WGM, gsz = (nM - fm) < WGM ? (nM - fm) : WGM;
        u.pm = fm + ((wgid % nig) % gsz); u.pn = (wgid % nig) / gsz; return true;
    }
    __device__ __forceinline__ void a_ready(const Unit&) const {}
    __device__ __forceinline__ void done(const Unit&) const {}
};
template <class Epi, class Sched, bool ALIGN_EPI = false, bool SP2 = false>
__device__ __forceinline__ void gemm_phase(PG8_LAS unsigned char* lds, const Gemm g, const Sched& S, const Epi& E) {
    const int tid = threadIdx.x, wid = __builtin_amdgcn_readfirstlane(tid >> 6), lane = tid & 63, wr = wid >> 2, wc = wid & 3, fr = lane & 15, fq = lane >> 4;
    const int K = g.K, nt = K / BK;
    unsigned voffA[2], voffB[2];
#pragma unroll
    for (int i = 0; i < 2; ++i) { int R, C; stage_rc(tid * 16 + i * 8192, R, C); const int Rb = Epi::PERM ? ((R & ~31) + perm32(R & 31)) : R;
        voffA[i] = (unsigned)(R * g.lda + C) * 2u; voffB[i] = (unsigned)(Rb * g.ldb + C) * 2u; }
    const size_t kstep = (size_t)(BK * 2);
    const size_t hstepA = (size_t)HALF * g.lda * 2, hstepB = (size_t)HALF * g.ldb * 2;
    const size_t tstepA = 2 * hstepA, tstepB = 2 * hstepB;
    const unsigned ldsw = (unsigned)wid * 1024u;
    const int aoff = lds_byte(wr * 64 + fr, fq * 8), boff = lds_byte(wc * 32 + fr, fq * 8);
#define PG8_SA(b, h) (((b) * 2 + (h)) * HTB)
#define PG8_SB(b, h) ((4 + (b) * 2 + (h)) * HTB)
#define PG8_STAGE(bufoff, gbase, voff) do { _Pragma("unroll") for (int _i = 0; _i < 2; ++_i) \
        __builtin_amdgcn_global_load_lds((const unsigned*)((const char*)(gbase) + (voff)[_i]), (PG8_LAS unsigned*)(lds + (bufoff) + ldsw + _i * 8192), 16, 0, 0); } while (0)
#define PG8_LDA(dst, b, h) do { _Pragma("unroll") for (int m = 0; m < 4; ++m) _Pragma("unroll") for (int k = 0; k < 2; ++k) dst[m][k] = *(const PG8_LAS bf16x8*)(lds + PG8_SA(b, h) + aoff + m * 2048 + k * 1024); } while (0)
#define PG8_LDB(dst, b, h) do { _Pragma("unroll") for (int n = 0; n < 2; ++n) _Pragma("unroll") for (int k = 0; k < 2; ++k) dst[n][k] = *(const PG8_LAS bf16x8*)(lds + PG8_SB(b, h) + boff + n * 2048 + k * 1024); } while (0)
#define PG8_MMA(ai, bj, At, Bt) do { __builtin_amdgcn_s_setprio(1); _Pragma("unroll") for (int m = 0; m < 4; ++m) _Pragma("unroll") for (int n = 0; n < 2; ++n) _Pragma("unroll") for (int k = 0; k < 2; ++k) \
        acc[ai][bj][m][n] = __builtin_amdgcn_mfma_f32_16x16x32_bf16(Bt[n][k], At[m][k], acc[ai][bj][m][n], 0, 0, 0); __builtin_amdgcn_s_setprio(0); } while (0)
#ifdef HOST_EMU
#define PG8_WAIT_V(n) ((void)0)
#define PG8_WAIT_L(n) ((void)0)
#else
#define PG8_WAIT_V(n) asm volatile("s_waitcnt vmcnt(" #n ")" ::: "memory")
#define PG8_WAIT_L(n) asm volatile("s_waitcnt lgkmcnt(" #n ")" ::: "memory")
#endif
#define PG8_BAR __builtin_amdgcn_s_barrier()
#define PG8_SCHED __builtin_amdgcn_sched_barrier(0)
    Unit cur, nxt; int ui = 0;
    if (!S.next(0, cur)) return;
    f32x4 acc[2][2][4][2];
#pragma unroll
    for (int a = 0; a < 2; ++a)
#pragma unroll
        for (int b = 0; b < 2; ++b)
#pragma unroll
            for (int m = 0; m < 4; ++m)
#pragma unroll
                for (int n = 0; n < 2; ++n) acc[a][b][m][n] = (f32x4){0.f, 0.f, 0.f, 0.f};
    bf16x8 At[4][2], B0[2][2], B1[2][2];
    const char* cA = (const char*)g.A + (size_t)cur.pm * tstepA; const char* cB = (const char*)g.Bt + (size_t)cur.pn * tstepB;
    S.a_ready(cur);
    if constexpr (SP2) {
        PG8_STAGE(PG8_SB(0, 0), cB, voffB); PG8_STAGE(PG8_SB(0, 1), cB + hstepB, voffB); PG8_STAGE(PG8_SA(0, 0), cA, voffA); PG8_STAGE(PG8_SA(0, 1), cA + hstepA, voffA);
        if (wr == 1) PG8_BAR;
        PG8_WAIT_V(2); PG8_BAR;
        PG8_STAGE(PG8_SB(1, 0), cB + kstep, voffB); PG8_STAGE(PG8_SA(1, 0), cA + kstep, voffA); PG8_STAGE(PG8_SB(1, 1), cB + hstepB + kstep, voffB);
        PG8_WAIT_V(6); PG8_BAR;
    } else {
        PG8_STAGE(PG8_SB(0, 0), cB, voffB); PG8_STAGE(PG8_SA(0, 0), cA, voffA); PG8_STAGE(PG8_SB(0, 1), cB + hstepB, voffB); PG8_STAGE(PG8_SA(0, 1), cA + hstepA, voffA);
        if (wr == 1) PG8_BAR;
        PG8_WAIT_V(4); PG8_BAR;
        PG8_STAGE(PG8_SB(1, 0), cB + kstep, voffB); PG8_STAGE(PG8_SA(1, 0), cA + kstep, voffA); PG8_STAGE(PG8_SB(1, 1), cB + hstepB + kstep, voffB);
        PG8_WAIT_V(6); PG8_BAR;
    }
    for (;;) {
        const bool has_next = S.next(ui + 1, nxt);
        const char* nA = has_next ? (const char*)g.A + (size_t)nxt.pm * tstepA : cA; const char* nB = has_next ? (const char*)g.Bt + (size_t)nxt.pn * tstepB : cB;
#pragma unroll 1
        for (int t = 0; t < nt; t += 2) {
            const bool last = (t == nt - 2);
            const char* a1 = cA + (size_t)(t + 1) * kstep;
            const char* a2 = last ? nA : cA + (size_t)(t + 2) * kstep; const char* b2 = last ? nB : cB + (size_t)(t + 2) * kstep;
            const char* a3 = a2 + kstep; const char* b3 = b2 + kstep;
            if (last && has_next) S.a_ready(nxt);
            if constexpr (SP2) {
            PG8_LDB(B0, 0, 0); PG8_LDB(B1, 0, 1); PG8_SCHED; PG8_LDA(At, 0, 0); PG8_STAGE(PG8_SA(1, 1), a1 + hstepA, voffA);
            PG8_WAIT_V(8); PG8_WAIT_L(0); PG8_BAR; PG8_MMA(0, 0, At, B0); PG8_MMA(0, 1, At, B1); PG8_BAR; PG8_SCHED;
            PG8_LDA(At, 0, 1); PG8_STAGE(PG8_SB(0, 0), b2, voffB); PG8_STAGE(PG8_SB(0, 1), b2 + hstepB, voffB); PG8_STAGE(PG8_SA(0, 0), a2, voffA);
            PG8_WAIT_V(8); PG8_WAIT_L(0); PG8_BAR; PG8_MMA(1, 0, At, B0); PG8_MMA(1, 1, At, B1); PG8_BAR; PG8_SCHED;
            PG8_LDB(B0, 1, 0); PG8_LDB(B1, 1, 1); PG8_SCHED; PG8_LDA(At, 1, 0); PG8_STAGE(PG8_SA(0, 1), a2 + hstepA, voffA);
            PG8_WAIT_V(8); PG8_WAIT_L(0); PG8_BAR; PG8_MMA(0, 0, At, B0); PG8_MMA(0, 1, At, B1); PG8_BAR; PG8_SCHED;
            PG8_LDA(At, 1, 1); PG8_STAGE(PG8_SB(1, 0), b3, voffB); PG8_STAGE(PG8_SB(1, 1), b3 + hstepB, voffB); PG8_STAGE(PG8_SA(1, 0), a3, voffA);
            PG8_WAIT_V(8); PG8_WAIT_L(0); PG8_BAR; PG8_MMA(1, 0, At, B0); PG8_MMA(1, 1, At, B1); PG8_BAR; PG8_SCHED;
            } else {
            PG8_LDB(B0, 0, 0); PG8_SCHED; PG8_LDA(At, 0, 0); PG8_STAGE(PG8_SA(1, 1), a1 + hstepA, voffA);
            PG8_WAIT_L(8); PG8_BAR; PG8_WAIT_L(0); PG8_MMA(0, 0, At, B0); PG8_BAR; PG8_SCHED;
            PG8_LDB(B1, 0, 1); PG8_STAGE(PG8_SB(0, 0), b2, voffB);
            PG8_BAR; PG8_WAIT_L(0); PG8_MMA(0, 1, At, B1); PG8_BAR;
            PG8_LDA(At, 0, 1); PG8_STAGE(PG8_SA(0, 0), a2, voffA);
            PG8_BAR; PG8_WAIT_L(0); PG8_MMA(1, 0, At, B0); PG8_BAR; PG8_SCHED;
            PG8_STAGE(PG8_SB(0, 1), b2 + hstepB, voffB);
            PG8_WAIT_V(6); PG8_BAR; PG8_MMA(1, 1, At, B1); PG8_BAR;
            PG8_LDB(B0, 1, 0); PG8_SCHED; PG8_LDA(At, 1, 0); PG8_STAGE(PG8_SA(0, 1), a2 + hstepA, voffA);
            PG8_WAIT_L(8); PG8_BAR; PG8_WAIT_L(0); PG8_MMA(0, 0, At, B0); PG8_BAR; PG8_SCHED;
            PG8_LDB(B1, 1, 1); PG8_STAGE(PG8_SB(1, 0), b3, voffB);
            PG8_BAR; PG8_WAIT_L(0); PG8_MMA(0, 1, At, B1); PG8_BAR;
            PG8_LDA(At, 1, 1); PG8_STAGE(PG8_SA(1, 0), a3, voffA);
            PG8_BAR; PG8_WAIT_L(0); PG8_MMA(1, 0, At, B0); PG8_BAR; PG8_SCHED;
            PG8_STAGE(PG8_SB(1, 1), b3 + hstepB, voffB);
            PG8_WAIT_V(6); PG8_BAR; PG8_MMA(1, 1, At, B1); PG8_BAR;
            }
        }
        if constexpr (ALIGN_EPI) { if (wr == 0) PG8_BAR; }
        if constexpr (!Epi::AFTER_DRAIN) { E(acc, cur, wr, wc, fr, fq); S.done(cur); }
        if (!has_next) break;
#pragma unroll
        for (int a = 0; a < 2; ++a)
#pragma unroll
            for (int b = 0; b < 2; ++b)
#pragma unroll
                for (int m = 0; m < 4; ++m)
#pragma unroll
                    for (int n = 0; n < 2; ++n) acc[a][b][m][n] = (f32x4){0.f, 0.f, 0.f, 0.f};
        cur = nxt; cA = nA; cB = nB; ++ui;
        if constexpr (ALIGN_EPI) { if (wr == 1) PG8_BAR; }
    }
    PG8_WAIT_V(0);
    if constexpr (!ALIGN_EPI) { if (wr == 0) PG8_BAR; }
    PG8_BAR;
    if constexpr (Epi::AFTER_DRAIN) { E.fused(acc, cur, wr, wc, fr, fq, lds, wid, lane); S.done(cur); }
#undef PG8_SA
#undef PG8_SB
#undef PG8_STAGE
#undef PG8_LDA
#undef PG8_LDB
#undef PG8_MMA
#undef PG8_WAIT_V
#undef PG8_WAIT_L
#undef PG8_BAR
#undef PG8_SCHED
}
}

template <class E8> struct PgEpi { static constexpr bool PERM = true, AFTER_DRAIN = false; E8 e;
    __device__ __forceinline__ void operator()(const pg8::f32x4 (&acc)[2][2][4][2], const pg8::Unit& u, int wr, int wc, int fr, int fq) const {
#pragma unroll
        for (int ai = 0; ai < 2; ++ai)
#pragma unroll
            for (int m = 0; m < 4; ++m) { const int row = u.pm * 256 + ai * 128 + wr * 64 + m * 16 + fr;
#pragma unroll
                for (int bj = 0; bj < 2; ++bj) { const int c0 = u.pn * 256 + bj * 128 + wc * 32 + 8 * fq;
                    const float v[8] = {acc[ai][bj][m][0][0], acc[ai][bj][m][0][1], acc[ai][bj][m][0][2], acc[ai][bj][m][0][3], acc[ai][bj][m][1][0], acc[ai][bj][m][1][1], acc[ai][bj][m][1][2], acc[ai][bj][m][1][3]};
                    e(row, c0, v); } } } };
struct PgEpiSwiglu { static constexpr bool PERM = true, AFTER_DRAIN = false; EpiSwiglu e;
    __device__ __forceinline__ void operator()(const pg8::f32x4 (&acc)[2][2][4][2], const pg8::Unit& u, int wr, int wc, int fr, int fq) const {
#pragma unroll
        for (int ai = 0; ai < 2; ++ai)
#pragma unroll
            for (int m = 0; m < 4; ++m) { const int row = u.pm * 256 + ai * 128 + wr * 64 + m * 16 + fr; const int j0 = u.pn * 128 + wc * 32 + 8 * fq;
                const float a[8] = {acc[ai][0][m][0][0], acc[ai][0][m][0][1], acc[ai][0][m][0][2], acc[ai][0][m][0][3], acc[ai][0][m][1][0], acc[ai][0][m][1][1], acc[ai][0][m][1][2], acc[ai][0][m][1][3]};
                const float b[8] = {acc[ai][1][m][0][0], acc[ai][1][m][0][1], acc[ai][1][m][0][2], acc[ai][1][m][0][3], acc[ai][1][m][1][0], acc[ai][1][m][1][1], acc[ai][1][m][1][2], acc[ai][1][m][1][3]};
                e(row, j0, a, b); } } };
template <bool FROMX, bool LAST> struct PgEpi<EpiResidT<FROMX, LAST>> { static constexpr bool PERM = true, AFTER_DRAIN = false; EpiResidT<FROMX, LAST> e;
    __device__ __forceinline__ void operator()(const pg8::f32x4 (&acc)[2][2][4][2], const pg8::Unit& u, int wr, int wc, int fr, int fq) const {
        const int row00 = u.pm * 256 + wr * 64 + fr, c00 = u.pn * 256 + wc * 32 + 8 * fq; const int mi = row_mi(u.pm * 256);
#pragma unroll
        for (int bj = 0; bj < 2; ++bj) { const int c0 = c00 + bj * 128; const float* g = e.c->mods(e.l, mi, e.k_gate) + c0;
            const f32x4 g0 = *(const f32x4*)g * e.scale, g1 = *(const f32x4*)(g + 4) * e.scale;
#pragma unroll
            for (int ai = 0; ai < 2; ++ai) { f32x4 h0[4], h1[4];
#pragma unroll
                for (int m = 0; m < 4; ++m) { const int row = row00 + ai * 128 + m * 16;
                    if (FROMX) { const float* hb = e.c->in(I_X) + (size_t)row * DM + c0; h0[m] = *(const f32x4*)hb; h1[m] = *(const f32x4*)(hb + 4); }
                    else { const u32x4 w = *(const u32x4*)(e.c->hb(row) + c0); h0[m] = (f32x4){bf2f(w.x & 0xffffu), bf2f(w.x >> 16), bf2f(w.y & 0xffffu), bf2f(w.y >> 16)}; h1[m] = (f32x4){bf2f(w.z & 0xffffu), bf2f(w.z >> 16), bf2f(w.w & 0xffffu), bf2f(w.w >> 16)}; } }
#pragma unroll
                for (int m = 0; m < 4; ++m) { const int row = row00 + ai * 128 + m * 16; const f32x4 a = h0[m] + acc[ai][bj][m][0] * g0, b = h1[m] + acc[ai][bj][m][1] * g1;
                    u32x4 w; w.x = pk2(a.x, a.y); w.y = pk2(a.z, a.w); w.z = pk2(b.x, b.y); w.w = pk2(b.z, b.w); *(u32x4*)((LAST ? e.c->hfin(row) : e.c->hb(row)) + c0) = w; } } } } };
#ifndef USE_PG8
#define USE_PG8 1
#endif
template <class E8> __device__ __forceinline__ void gemm_run(const Ctx& c, const bf16* A, const bf16* Bt, int mrows, int N, int K, const E8& e) {
#if USE_PG8
    pg8::Gemm g{A, Bt, mrows, N, K, K, K}; pg8::StaticOrder S; S.init(mrows, N, c.G, c.bx); PgEpi<E8> E{e};
    pg8::gemm_phase<PgEpi<E8>, pg8::StaticOrder, true, true>(c.lds, g, S, E);
#else
    gemm_naive(c, A, Bt, mrows, N, K, e);
#endif
}
__device__ __forceinline__ void gemm_run_swiglu(const Ctx& c, const bf16* A, const bf16* Bt, int mrows, int K, const EpiSwiglu& e) {
#if USE_PG8
    pg8::Gemm g{A, Bt, mrows, 2 * DFF, K, K, K}; pg8::StaticOrder S; S.init(mrows, 2 * DFF, c.G, c.bx); PgEpiSwiglu E{e};
    pg8::gemm_phase<PgEpiSwiglu, pg8::StaticOrder, false, true>(c.lds, g, S, E);
#else
    gemm_naive_swiglu(c, A, Bt, mrows, K, e);
#endif
}

struct EpiPartial { bf16* part;
    __device__ __forceinline__ void operator()(int row, int c0, const float (&v)[8]) const { st8bf(part + (size_t)row * DM + c0, v); } };
struct OneUnit { pg8::Unit u; bool has;
    __device__ __forceinline__ bool next(int i, pg8::Unit& o) const { if (i == 0 && has) { o = u; return true; } return false; }
    __device__ __forceinline__ void a_ready(const pg8::Unit&) const {}
    __device__ __forceinline__ void done(const pg8::Unit&) const {} };
template <bool FROMX = false, bool LAST = false> __device__ __forceinline__ void gemm_resid_all(const Ctx& c, const bf16* A, const bf16* Bt, int N, int K, int l, int k_gate, float scale, bool with_ctx, bf16* part, const float* xin = nullptr) {
    { EpiResidT<FROMX, LAST> E{&c, l, k_gate, scale}; gemm_run(c, A, Bt, MLAT, N, K, E); }
#if USE_PG8
    if (with_ctx) { constexpr int KP = 256; const int nks = K / KP, ncol = N / 256, npieces = (MCTX / 256) * ncol * nks;
        for (int pi = c.G - 1 - c.bx; pi < npieces; pi += c.G) {
        OneUnit S; S.has = true; const int ks = pi % nks, pn = (pi / nks) % ncol, pm = pi / (nks * ncol); S.u.pm = pm; S.u.pn = pn;
        pg8::Gemm g{A + (size_t)MLAT * K + (size_t)ks * KP, Bt + (size_t)ks * KP, MCTX, N, KP, K, K}; PgEpi<EpiPartial> E{EpiPartial{part + (size_t)ks * MCTX * DM}};
        pg8::gemm_phase<PgEpi<EpiPartial>, OneUnit, true, true>(c.lds, g, S, E); } }
#else
    if (with_ctx) { for (int ks = 0; ks < K / 256; ++ks) { EpiPartial E{part + (size_t)ks * MCTX * DM}; gemm_naive_ld(c, A + (size_t)MLAT * K + ks * 256, Bt + ks * 256, MCTX, N, 256, K, E); } }
#endif
}

struct S5Lane { float ar, ai, fr, fi; float bre[16], bim[16], cre[16], cim[16]; };
__device__ __forceinline__ void s5_load(const Ctx& c, int l, int dir, int g, int p, S5Lane& S) {
    const size_t gi = ((size_t)(l * 2 + dir) * S5G + g);
    const float lr = c.in(I_S5LRE)[gi * 64 + p], li = c.in(I_S5LIM)[gi * 64 + p], dt = expf(c.in(I_S5STEP)[gi]);
    const float th = li * dt, em1 = expm1f(lr * dt), cs = cosf(th), sn = sinf(th), sh = sinf(0.5f * th);
    const float arm1 = em1 * cs - 2.f * sh * sh;
    S.ar = 1.f + arm1; S.ai = (em1 + 1.f) * sn;
    const float den = lr * lr + li * li; S.fr = (arm1 * lr + S.ai * li) / den; S.fi = (S.ai * lr - arm1 * li) / den;
    const float* br = c.in(I_S5BRE) + (gi * 64 + p) * 16; const float* bi = c.in(I_S5BIM) + (gi * 64 + p) * 16;
#pragma unroll
    for (int h = 0; h < 16; ++h) { S.bre[h] = br[h]; S.bim[h] = bi[h]; S.cre[h] = c.in(I_S5CRE)[(gi * 16 + h) * 64 + p]; S.cim[h] = c.in(I_S5CIM)[(gi * 16 + h) * 64 + p]; }
}
__device__ __forceinline__ int s5_row(int b, int dir, int i) {
    if (i < TC) return MLAT + b * TC + (dir ? TC - 1 - i : i);
    const int t = i - TC; return b * T + (dir ? T - 1 - t : t);
}
__device__ __forceinline__ void s5_step(const S5Lane& S, const bf16* urow, float& sr, float& si) {
    float u[16]; { float t0[8], t1[8]; ld8bf(urow, t0); ld8bf(urow + 8, t1);
#pragma unroll
        for (int i = 0; i < 8; ++i) { u[i] = t0[i]; u[8 + i] = t1[i]; } }
    float wr = 0.f, wi = 0.f;
#pragma unroll
    for (int h = 0; h < 16; ++h) { wr += S.bre[h] * u[h]; wi += S.bim[h] * u[h]; }
    const float xr = S.fr * wr - S.fi * wi, xi = S.fr * wi + S.fi * wr;
    const float nr = S.ar * sr - S.ai * si + xr, ni = S.ar * si + S.ai * sr + xi; sr = nr; si = ni;
}
__device__ __forceinline__ void ph_s5_a(const Ctx& c, int l) {
    const bf16* P = (const bf16*)(c.ws + WS_BIG + BIG_P); float* E = (float*)(c.ws + WS_S5E);
    const int nitems = NB * S5G * 2 * (NCH5 - 1);
    for (int it = c.gw; it < nitems; it += c.NGW) { const int ch = it % (NCH5 - 1), dir = (it / (NCH5 - 1)) % 2, g = (it / (2 * (NCH5 - 1))) % S5G, b = it / (2 * (NCH5 - 1) * S5G);
        S5Lane S; s5_load(c, l, dir, g, c.lane, S); float sr = 0.f, si = 0.f;
        for (int i = ch * LS5; i < (ch + 1) * LS5; ++i) s5_step(S, P + (size_t)s5_row(b, dir, i) * INC + PC_S5 + g * 16, sr, si);
        float* e = E + ((((size_t)(b * S5G + g) * 2 + dir) * NCH5 + ch) * 64 + c.lane) * 2; e[0] = sr; e[1] = si; }
}
__device__ __forceinline__ void ph_s5_b(const Ctx& c, int l) {
    const bf16* P = (const bf16*)(c.ws + WS_BIG + BIG_P); const float* E = (const float*)(c.ws + WS_S5E); float* YS = (float*)(c.ws + WS_XN);
    const int nitems = NB * S5G * 2 * NCH5;
    for (int it = c.gw; it < nitems; it += c.NGW) { const int ch = it % NCH5, dir = (it / NCH5) % 2, g = (it / (2 * NCH5)) % S5G, b = it / (2 * NCH5 * S5G);
        S5Lane S; s5_load(c, l, dir, g, c.lane, S);
        const float* e = E + ((((size_t)(b * S5G + g) * 2 + dir) * NCH5 + ch) * 64 + c.lane) * 2;
        float sr = e[0], si = e[1];
        for (int i = ch * LS5; i < (ch + 1) * LS5; ++i) { const int row = s5_row(b, dir, i);
            s5_step(S, P + (size_t)row * INC + PC_S5 + g * 16, sr, si);
            float v[16];
#pragma unroll
            for (int h = 0; h < 16; ++h) v[h] = S.cre[h] * sr - S.cim[h] * si;
            float w8[8];
            { const bool hi = (c.lane & 32) != 0;
#pragma unroll
              for (int k = 0; k < 8; ++k) { const float send = hi ? v[k] : v[8 + k]; const float keep = hi ? v[8 + k] : v[k]; w8[k] = keep + __shfl_xor(send, 32); } }
            float w4[4];
            { const bool hi = (c.lane & 16) != 0;
#pragma unroll
              for (int k = 0; k < 4; ++k) { const float send = hi ? w8[k] : w8[4 + k]; const float keep = hi ? w8[4 + k] : w8[k]; w4[k] = keep + __shfl_xor(send, 16); } }
            float w2[2];
            { const bool hi = (c.lane & 8) != 0;
#pragma unroll
              for (int k = 0; k < 2; ++k) { const float send = hi ? w4[k] : w4[2 + k]; const float keep = hi ? w4[2 + k] : w4[k]; w2[k] = keep + __shfl_xor(send, 8); } }
            float w1;
            { const bool hi = (c.lane & 4) != 0; const float send = hi ? w2[0] : w2[1]; const float keep = hi ? w2[1] : w2[0]; w1 = keep + __shfl_xor(send, 4); }
            w1 += __shfl_xor(w1, 2); w1 += __shfl_xor(w1, 1);
            if ((c.lane & 3) == 0) YS[((size_t)dir * M + row) * GWD + g * 16 + (c.lane >> 2)] = w1;
        } }
}
__device__ __forceinline__ void lru_carry_block(const Ctx& c, int it) {
    float* E = (float*)(c.ws + WS_LRUE); constexpr int NEB = GWD / 64, SEG = (NTL + 7) / 8; const int eb = it % NEB, dir = (it / NEB) % 2, b = it / (2 * NEB);
    float* e = E + ((size_t)(b * 2 + dir) * NTL) * GWD * 2 + (eb * 64 + c.lane) * 2; LAS float* sm = (LAS float*)c.lds;
    float pa[SEG], he[SEG]; float A = 1.f, B = 0.f;
#pragma unroll
    for (int j = 0; j < SEG; ++j) { const int i = c.wave * SEG + j; const int ic = i < NTL ? i : NTL - 1; const int tile = dir == 0 ? ic : (ic < NCT ? NCT - 1 - ic : NTL - 1 - (ic - NCT));
        pa[j] = e[(size_t)tile * GWD * 2]; he[j] = e[(size_t)tile * GWD * 2 + 1]; if (i >= NTL) { pa[j] = 1.f; he[j] = 0.f; } }
#pragma unroll
    for (int j = 0; j < SEG; ++j) { B = pa[j] * B + he[j]; A *= pa[j]; }
    sm[(c.wave * 64 + c.lane) * 2] = A; sm[(c.wave * 64 + c.lane) * 2 + 1] = B;
    __syncthreads();
    float h = 0.f;
    for (int w = 0; w < c.wave; ++w) h = sm[(w * 64 + c.lane) * 2] * h + sm[(w * 64 + c.lane) * 2 + 1];
#pragma unroll
    for (int j = 0; j < SEG; ++j) { const int i = c.wave * SEG + j; if (i < NTL) { const int tile = dir == 0 ? i : (i < NCT ? NCT - 1 - i : NTL - 1 - (i - NCT)); e[(size_t)tile * GWD * 2 + 1] = h; h = pa[j] * h + he[j]; } }
    __syncthreads();
}
__device__ __forceinline__ void s5_carry_block(const Ctx& c, int l, int it) {
    float* E = (float*)(c.ws + WS_S5E); const int dir = it % 2, g = (it / 2) % S5G, b = it / (2 * S5G); constexpr int SEG = (NCH5 + 7) / 8;
    const size_t gi = ((size_t)(l * 2 + dir) * S5G + g);
    const float lr = c.in(I_S5LRE)[gi * 64 + c.lane], li = c.in(I_S5LIM)[gi * 64 + c.lane], dt = expf(c.in(I_S5STEP)[gi]);
    const float th = li * dt, em1 = expm1f(lr * dt), sh = sinf(0.5f * th);
    float pr = 1.f + (em1 * cosf(th) - 2.f * sh * sh), pi = (em1 + 1.f) * sinf(th);
#pragma unroll
    for (int s = 1; s < LS5; s <<= 1) { const float nr = pr * pr - pi * pi, ni = 2.f * pr * pi; pr = nr; pi = ni; }
    float* e = E + ((((size_t)(b * S5G + g) * 2 + dir) * NCH5) * 64 + c.lane) * 2; LAS float* sm = (LAS float*)c.lds;
    float er[SEG], ei[SEG]; float Ar = 1.f, Ai = 0.f, Br = 0.f, Bi = 0.f;
#pragma unroll
    for (int j = 0; j < SEG; ++j) { const int ch = c.wave * SEG + j; const int cc = ch < NCH5 ? ch : NCH5 - 1; er[j] = e[(size_t)cc * 128]; ei[j] = e[(size_t)cc * 128 + 1]; }
#pragma unroll
    for (int j = 0; j < SEG; ++j) { const int ch = c.wave * SEG + j; if (ch < NCH5) { const float nr = pr * Br - pi * Bi + er[j], ni = pr * Bi + pi * Br + ei[j]; Br = nr; Bi = ni; const float ar = pr * Ar - pi * Ai, ai = pr * Ai + pi * Ar; Ar = ar; Ai = ai; } }
    { LAS float* q = sm + (c.wave * 64 + c.lane) * 4; q[0] = Ar; q[1] = Ai; q[2] = Br; q[3] = Bi; }
    __syncthreads();
    float sr = 0.f, si = 0.f;
    for (int w = 0; w < c.wave; ++w) { const LAS float* q = sm + (w * 64 + c.lane) * 4; const float nr = q[0] * sr - q[1] * si + q[2], ni = q[0] * si + q[1] * sr + q[3]; sr = nr; si = ni; }
#pragma unroll
    for (int j = 0; j < SEG; ++j) { const int ch = c.wave * SEG + j; if (ch < NCH5) { e[(size_t)ch * 128] = sr; e[(size_t)ch * 128 + 1] = si; const float nr = pr * sr - pi * si + er[j], ni = pr * si + pi * sr + ei[j]; sr = nr; si = ni; } }
    __syncthreads();
}
__device__ __forceinline__ void ph_carries(const Ctx& c, int l) {
    constexpr int N5 = NB * S5G * 2, NLR = NB * 2 * (GWD / 64);
    __syncthreads();
    for (int it = c.bx; it < N5 + NLR; it += c.G) { if (it < N5) s5_carry_block(c, l, it); else lru_carry_block(c, it - N5); }
}
__device__ __forceinline__ void ph_s5_z(const Ctx& c, int l, int mrows) {
    const bf16* P = (const bf16*)(c.ws + WS_BIG + BIG_P); const float* YS = (const float*)(c.ws + WS_XN); bf16* Y = (bf16*)(c.ws + WS_Y); const float* d = c.in(I_S5D) + (size_t)l * GWD;
    const int n8 = mrows * (GWD / 8);
    for (int i = c.gt; i < n8; i += c.NGT) { const int row = i / (GWD / 8), ch = (i % (GWD / 8)) * 8; float u[8], z[8]; ld8bf(P + (size_t)row * INC + PC_S5 + ch, u);
        const f32x4 f0 = *(const f32x4*)(YS + (size_t)row * GWD + ch), f1 = *(const f32x4*)(YS + (size_t)row * GWD + ch + 4), b0 = *(const f32x4*)(YS + ((size_t)M + row) * GWD + ch), b1 = *(const f32x4*)(YS + ((size_t)M + row) * GWD + ch + 4);
        const f32x4 d0 = *(const f32x4*)(d + ch), d1 = *(const f32x4*)(d + ch + 4);
#pragma unroll
        for (int j = 0; j < 4; ++j) { z[j] = geluf_(d0[j] * u[j] + f0[j] + b0[j]); z[4 + j] = geluf_(d1[j] * u[4 + j] + f1[j] + b1[j]); }
        st8bf(Y + (size_t)row * DM + ch, z); }
}
struct EpiGlu { bf16* Y;
    __device__ __forceinline__ void operator()(int row, int c0, const float (&v)[8]) const { float z[8], o[8]; ld8bf(Y + (size_t)row * DM + c0, z);
#pragma unroll
        for (int i = 0; i < 8; ++i) o[i] = z[i] * sigmoidf_(v[i]);
        st8bf(Y + (size_t)row * DM + c0, o); } };

__device__ __forceinline__ int lru_tile_row0(int b, int tile) { return tile < NCT ? MLAT + b * TC + tile * LL : b * T + (tile - NCT) * LL; }
template <bool PASS_B> __device__ __forceinline__ void ph_lru(const Ctx& c, int l, bool need_ctx) {
    const bf16* P = (const bf16*)(c.ws + WS_BIG + BIG_P); float* E = (float*)(c.ws + WS_LRUE); bf16* Y = (bf16*)(c.ws + WS_Y);
    LAS float* XC = (LAS float*)c.lds;
    LAS float* HT = XC + LL * GWD;
    const int e = c.tid % GWD, dir = (c.tid / GWD) & 1; const bool active = c.tid < 2 * GWD;
    const int blk = e / 64, el = e % 64;
    float wa[64], wx[64];
    { const float* pa = c.in(I_LWA) + (((size_t)(l * 2 + dir) * NH + blk) * 64) * 64 + el; const float* px = c.in(I_LWX) + (((size_t)(l * 2 + dir) * NH + blk) * 64) * 64 + el;
#pragma unroll
      for (int d = 0; d < 64; ++d) { wa[d] = pa[d * 64]; wx[d] = px[d * 64]; } }
    const float ba = c.in(I_LBA)[(size_t)(l * 2 + dir) * GWD + e], bx = c.in(I_LBX)[(size_t)(l * 2 + dir) * GWD + e];
    const float sp = softplusf_(-c.in(I_LLAM)[(size_t)(l * 2 + dir) * GWD + e]);
    const int nitems = NB * NTL;
    for (int it = c.bx; it < nitems; it += c.G) { const int tile = it % NTL, b = it / NTL; const bool is_ctx = tile < NCT;
        const int row0 = lru_tile_row0(b, tile); const int t0 = (is_ctx ? tile : tile - NCT) * LL, tlen = is_ctx ? TC : T; const int seq0 = row0 - t0;
        __syncthreads();
        for (int i = c.tid; i < LL * GWD; i += NT) { const int t = i / GWD, ch = i % GWD; float s = c.in(I_LCB)[(size_t)l * GWD + ch];
#pragma unroll
            for (int k = 0; k < 4; ++k) { const int tt = t0 + t + k - 2; if (tt >= 0 && tt < tlen) s += c.in(I_LCW)[((size_t)l * 4 + k) * GWD + ch] * bf2f(P[(size_t)(seq0 + tt) * INC + PC_LX + ch]); }
            XC[i] = s; }
        __syncthreads();
        if (active) {
            float h = 0.f, pa = 1.f;
            if (PASS_B) h = E[(((size_t)(b * 2 + dir) * NTL + tile) * GWD + e) * 2 + 1];
            for (int s = 0; s < LL; ++s) { const int t = dir ? LL - 1 - s : s; const LAS float* xr = XC + t * GWD + blk * 64;
                float r = ba, ig = bx;
#pragma unroll
                for (int d = 0; d < 64; ++d) { const float xv = xr[d]; r += xv * wa[d]; ig += xv * wx[d]; }
                r = sigmoidf_(r); ig = sigmoidf_(ig);
                const float la = -8.f * r * sp, a = expf(la), bb = sqrtf(-expm1f(2.f * la)) * (ig * xr[el]);
                h = a * h + bb; pa *= a;
                if (PASS_B) HT[(dir * LL + t) * GWD + e] = h; }
            if (!PASS_B) { float* eo = E + (((size_t)(b * 2 + dir) * NTL + tile) * GWD + e) * 2; eo[0] = pa; eo[1] = h; }
        }
        if (PASS_B) { __syncthreads();
            if (!is_ctx || need_ctx) for (int i = c.tid; i < LL * GWD; i += NT) { const int t = i / GWD, ch = i % GWD; const int row = row0 + t;
                const float gt = bf2f(P[(size_t)row * INC + PC_LG + ch]); Y[(size_t)row * DM + 3 * GWD + ch] = (bf16)f2bf((HT[t * GWD + ch] + HT[(LL + t) * GWD + ch]) * geluf_(gt)); } }
    }
}

constexpr float ATT_C2 = 0.125f * 1.4426950408889634f;
__device__ __forceinline__ size_t gqa_kv_index(int row, int kvh) {
    const int b = row < MLAT ? row / T : (row - MLAT) / TC; const int pos = row < MLAT ? TC + row % T : (row - MLAT) % TC;
    return ((size_t)(b * NKV + kvh) * (TC + T) + pos) * 64; }
__device__ __forceinline__ void ph_na_kvcopy(const Ctx& c) {
    static_assert((size_t)3 * M * GWD * 2 <= (size_t)M * DM * 2, "NA K/V/Q copies fit the XN region");
    const bf16* P = (const bf16*)(c.ws + WS_BIG + BIG_P); bf16* NK = (bf16*)(c.ws + WS_XN);
    const long nitems = (long)M * 2 * NH * 8;
    constexpr int UN = 4;
    for (long it0 = c.gt; it0 < nitems; it0 += (long)UN * c.NGT) { u32x4 v[UN]; long it[UN];
#pragma unroll
        for (int u = 0; u < UN; ++u) { it[u] = it0 + (long)u * c.NGT; const long ic = it[u] < nitems ? it[u] : nitems - 1; const int w = (int)(ic % (2 * NH * 8)), row = (int)(ic / (2 * NH * 8)); v[u] = *(const u32x4*)(P + (size_t)row * INC + PC_NAK + w * 8); }
#pragma unroll
        for (int u = 0; u < UN; ++u) if (it[u] < nitems) { const int w = (int)(it[u] % (2 * NH * 8)), row = (int)(it[u] / (2 * NH * 8)); const int kv = w / (NH * 8), hh = (w / 8) % NH, j = w & 7;
            const int b = row < MLAT ? row / T : (row - MLAT) / TC; const int pos = row < MLAT ? TC + row % T : (row - MLAT) % TC;
            *(u32x4*)(NK + (size_t)kv * M * GWD + ((size_t)(b * NH + hh) * (TC + T) + pos) * 64 + 8 * j) = v[u]; } }
    bf16* NQ = NK + (size_t)2 * M * GWD;
    for (long it = c.gt; it < (long)M * NH * 8; it += c.NGT) { const int w = (int)(it % (NH * 8)), row = (int)(it / (NH * 8)); float q[8]; ld8bf(P + (size_t)row * INC + PC_NAQ + w * 8, q);
#pragma unroll
        for (int i = 0; i < 8; ++i) q[i] *= ATT_C2;
        st8bf(NQ + (size_t)row * GWD + w * 8, q); }
}
__device__ __forceinline__ void ph_gqa_prep(const Ctx& c, int l) {
    const bf16* P = (const bf16*)(c.ws + WS_BIG + BIG_P); bf16* KN = (bf16*)(c.ws + WS_BIG + BIG_KN);
    const float* gk = c.in(I_GKN) + l * 64; const float* rope = (const float*)(c.ws + WS_ROPE);
    constexpr int NS = NKV; const long nitems = (long)M * NS * 8;
    const long nloop = (nitems + c.NGT - 1) / c.NGT;
    for (long k = 0; k < nloop; ++k) { const long it = k * c.NGT + c.gt; const bool act = it < nitems; const long itc = act ? it : nitems - 1;
        const int j = (int)(itc & 7), hh = (int)((itc >> 3) % NS), row = (int)((itc >> 3) / NS);
        float x[8]; ld8bf(P + (size_t)row * INC + PC_GK + hh * 64 + 8 * j, x);
        float ss = 0.f;
#pragma unroll
        for (int i = 0; i < 8; ++i) ss += x[i] * x[i];
        ss += __shfl_xor(ss, 1); ss += __shfl_xor(ss, 2); ss += __shfl_xor(ss, 4);
        const float rstd = 1.f / sqrtf(ss * (1.f / 64.f) + EPS); const float* gg = gk + 8 * j; float y[8], pr[8];
#pragma unroll
        for (int i = 0; i < 8; ++i) y[i] = x[i] * rstd * gg[i];
#pragma unroll
        for (int i = 0; i < 8; ++i) pr[i] = __shfl_xor(y[i], 2);
        if (row < MLAT) { const int t = row % T; const int pos = (j < 4) ? t / GW : t % GW; const float* tb = rope + pos * 32 + (8 * j & 15); const bool second = (j & 2) != 0;
#pragma unroll
            for (int i = 0; i < 8; ++i) { const float cs = tb[i], sn = tb[16 + i]; y[i] = second ? (y[i] * cs + pr[i] * sn) : (y[i] * cs - pr[i] * sn); } }
        if (act) st8bf(KN + gqa_kv_index(row, hh) + 8 * j, y);
    }
}

template <bool LOG2> __device__ __forceinline__ void attn_key(const bf16* k, const bf16* v, float bias, const float (&q)[64], float& m, float& lsum, float (&o)[64]) {
    float s = bias;
#pragma unroll
    for (int d8 = 0; d8 < 8; ++d8) { float kv[8]; ld8bf(k + d8 * 8, kv);
#pragma unroll
        for (int j = 0; j < 8; ++j) s += q[d8 * 8 + j] * kv[j]; }
    const float mn = fmaxf(m, s), corr = LOG2 ? exp2f(m - mn) : expf(m - mn), pp = LOG2 ? exp2f(s - mn) : expf(s - mn); m = mn; lsum = lsum * corr + pp;
#pragma unroll
    for (int d8 = 0; d8 < 8; ++d8) { float vv[8]; ld8bf(v + d8 * 8, vv);
#pragma unroll
        for (int j = 0; j < 8; ++j) o[d8 * 8 + j] = o[d8 * 8 + j] * corr + pp * vv[j]; }
}
__device__ __forceinline__ void attn_store(bf16* dst, float lsum, const float (&o)[64]) {
    const float inv = 1.f / lsum;
#pragma unroll
    for (int d8 = 0; d8 < 8; ++d8) { float t[8];
#pragma unroll
        for (int j = 0; j < 8; ++j) t[j] = o[d8 * 8 + j] * inv;
        st8bf(dst + d8 * 8, t); }
}
__device__ __forceinline__ void ph_gqa_naive(const Ctx& c, bool need_ctx) {
    const bf16* QN = (const bf16*)(c.ws + WS_BIG + BIG_QN); const bf16* KN = (const bf16*)(c.ws + WS_BIG + BIG_KN); const bf16* VN = (const bf16*)(c.ws + WS_BIG + BIG_VN); bf16* Y = (bf16*)(c.ws + WS_Y);
    const int nq = need_ctx ? M : MLAT; const long nitems = (long)nq * NH;
    for (long it = c.gt; it < nitems; it += c.NGT) { const int h = (int)(it / nq), row = (int)(it % nq); const int kvh = h / GQG;
        const int b = row < MLAT ? row / T : (row - MLAT) / TC;
        float q[64], o[64]; float m = -1e30f, ls = 0.f;
#pragma unroll
        for (int d8 = 0; d8 < 8; ++d8) { float t[8]; ld8bf(QN + (size_t)row * GWD + h * 64 + d8 * 8, t);
#pragma unroll
            for (int j = 0; j < 8; ++j) { q[d8 * 8 + j] = t[j]; o[d8 * 8 + j] = 0.f; } }
        const size_t kb = (size_t)(b * NKV + kvh) * (TC + T) * 64; const int nk = row < MLAT ? TC + T : TC;
        for (int n = 0; n < nk; ++n) attn_key<true>(KN + kb + (size_t)n * 64, VN + kb + (size_t)n * 64, 0.f, q, m, ls, o);
        attn_store(Y + (size_t)row * DM + 2 * GWD + h * 64, ls, o); }
}
__device__ __forceinline__ void ph_na_naive(const Ctx& c, int l, bool need_ctx) {
    const bf16* P = (const bf16*)(c.ws + WS_BIG + BIG_P); bf16* Y = (bf16*)(c.ws + WS_Y); const float* rpb = c.in(I_RPB) + (size_t)l * NH * 15 * 31;
    constexpr int KR = NROWS < 8 ? NROWS : 8;
    const int nq = need_ctx ? M : MLAT; const long nitems = (long)nq * NH;
    for (long it = c.gt; it < nitems; it += c.NGT) { const int h = (int)(it / nq), row = (int)(it % nq);
        const int b = row < MLAT ? row / T : (row - MLAT) / TC;
        float q[64], o[64]; float m = -1e30f, ls = 0.f;
#pragma unroll
        for (int d8 = 0; d8 < 8; ++d8) { float t[8]; ld8bf(P + (size_t)row * INC + PC_NAQ + h * 64 + d8 * 8, t);
#pragma unroll
            for (int j = 0; j < 8; ++j) { q[d8 * 8 + j] = t[j] * 0.125f; o[d8 * 8 + j] = 0.f; } }
        if (row < MLAT) { const int t = row % T, r = t / GW, cc = t % GW;
            int rs = r - 4; rs = rs < 0 ? 0 : (rs > NROWS - KR ? NROWS - KR : rs); int cs = cc - 8; cs = cs < 0 ? 0 : (cs > GW - 16 ? GW - 16 : cs);
            for (int i = 0; i < KR; ++i) for (int j = 0; j < 16; ++j) { const int kr = b * T + (rs + i) * GW + cs + j; const float bias = rpb[((size_t)h * 15 + (rs + i - r + 7)) * 31 + (cs + j - cc + 15)];
                attn_key<false>(P + (size_t)kr * INC + PC_NAK + h * 64, P + (size_t)kr * INC + PC_NAV + h * 64, bias, q, m, ls, o); } }
        for (int n = 0; n < TC; ++n) { const int kr = MLAT + b * TC + n; attn_key<false>(P + (size_t)kr * INC + PC_NAK + h * 64, P + (size_t)kr * INC + PC_NAV + h * 64, 0.f, q, m, ls, o); }
        attn_store(Y + (size_t)row * DM + GWD + h * 64, ls, o); }
}

namespace attn_body {
typedef unsigned short bf16;
using bf16x8=__attribute__((ext_vector_type(8)))short;
using s16x4=__attribute__((ext_vector_type(4)))short;
using f32x16=__attribute__((ext_vector_type(16)))float;
using u32x4=__attribute__((ext_vector_type(4)))unsigned;
constexpr int D=64; constexpr int QP=GWD, KP=64, OP=::DM;
constexpr int NW=8,QBLK=32,QB=QBLK*NW,KVBLK=64;
__device__ __forceinline__ int crow(int r,int hi){return (r&3)+8*(r>>2)+4*hi;}
#define SBAR() __builtin_amdgcn_sched_barrier(0)
constexpr int NSLOT=3, SLOTB=8192;
constexpr int LDS_K=0, LDS_V=NSLOT*SLOTB, LDS_WS=2*NSLOT*SLOTB, LDS_OST=LDS_WS+NW*64*4, LDS_BYTES=LDS_OST+NW*4096;
constexpr float C2=0.125f*1.4426950408889634f;
#ifdef HOST_EMU
__device__ __forceinline__ void glds16(const void*gsrc,unsigned lds_dst){ emu_glds(gsrc, emu_lds()+lds_dst, 16, 0, 0); }
#define ASM_(...) ((void)0)
#define PINV(x) ((void)0)
#define LDSADDR(p) ((unsigned)((const unsigned char*)(p)-emu_lds()))
__device__ __forceinline__ float max3f(float a,float b,float c){return fmaxf(fmaxf(a,b),c);}
__device__ __forceinline__ float max2f(float a,float b){return fmaxf(a,b);}
__device__ __forceinline__ float fadd_s(float a,float b){return a+b;}
__device__ __forceinline__ float fsub_s(float a,float b){return a-b;}
__device__ __forceinline__ unsigned cvtpk_s(float lo,float hi){return pk2(lo,hi);}
__device__ __forceinline__ unsigned __float_as_uint(float f){return __builtin_bit_cast(unsigned,f);}
__device__ __forceinline__ float __uint_as_float(unsigned u){return __builtin_bit_cast(float,u);}
typedef unsigned emu_u2 __attribute__((ext_vector_type(2)));
__device__ __forceinline__ emu_u2 emu_permlane32_swap(unsigned vdst,unsigned src,bool,bool){ int lane=emu_f().tid&63; struct{unsigned a,b;}d{vdst,src}; EmuXchg x=emu_deposit(&d,sizeof(d)); unsigned oa,ob; emu_u2 r;
  if(lane<32){ memcpy(&oa,x.at(lane+32),4); r[0]=vdst; r[1]=oa; } else { memcpy(&ob,x.at(lane-32)+4,4); r[0]=ob; r[1]=src; } return r; }
#define __builtin_amdgcn_permlane32_swap emu_permlane32_swap
__device__ __forceinline__ bool __any(bool p){ int v=p; EmuXchg x=emu_deposit(&v,sizeof(v)); int r=0; for(int l=0;l<64;++l){int q; memcpy(&q,x.at(l),4); r|=q;} return r!=0; }
#define WAIT_BAR(N) __syncthreads()
#else
#define ASM_(...) asm volatile(__VA_ARGS__)
#define PINV(x) asm volatile("":"+v"(x))
#define LDSADDR(p) ((unsigned)(uintptr_t)(p))
__device__ __forceinline__ void glds16(const void*gsrc,unsigned lds_dst){unsigned keep;
  asm volatile("s_mov_b32 %0, m0\n\ts_mov_b32 m0, %2\n\ts_nop 0\n\tglobal_load_lds_dwordx4 %1, off\n\ts_mov_b32 m0, %0":"=&s"(keep):"v"(gsrc),"s"(lds_dst):"memory");}
__device__ __forceinline__ float max3f(float a,float b,float c){float r;asm("v_max3_f32 %0, %1, %2, %3":"=v"(r):"v"(a),"v"(b),"v"(c));return r;}
__device__ __forceinline__ float max2f(float a,float b){float r;asm("v_max_f32_e32 %0, %1, %2":"=v"(r):"v"(a),"v"(b));return r;}
__device__ __forceinline__ float fadd_s(float a,float b){float r;asm("v_add_f32_e32 %0, %1, %2":"=v"(r):"v"(a),"v"(b));return r;}
__device__ __forceinline__ float fsub_s(float a,float b){float r;asm("v_sub_f32_e32 %0, %1, %2":"=v"(r):"v"(a),"v"(b));return r;}
typedef float f32x2_t __attribute__((ext_vector_type(2))); typedef __bf16 bf16x2_t __attribute__((ext_vector_type(2)));
__device__ __forceinline__ unsigned cvtpk_s(float lo,float hi){f32x2_t v={lo,hi};bf16x2_t b=__builtin_convertvector(v,bf16x2_t);return __builtin_bit_cast(unsigned,b);}
#define WAIT_BAR(N) asm volatile("s_waitcnt vmcnt(" #N ") lgkmcnt(0)\n\ts_barrier":::"memory")
#endif

__device__ __forceinline__ void qkt(f32x16&p0,f32x16&p1,LAS const char*Kslot,const bf16x8*qr,const f32x16&negm,int r32,int hi){
  LAS const char*kb=Kslot+hi*1024+r32*16;
  #pragma unroll
  for(int d0=0;d0<4;++d0){
    const bf16x8 b0=*(const LAS bf16x8*)(kb+d0*2048);
    const bf16x8 b1=*(const LAS bf16x8*)(kb+d0*2048+512);
    if(d0==0){p0=__builtin_amdgcn_mfma_f32_32x32x16_bf16(b0,qr[0],negm,0,0,0);p1=__builtin_amdgcn_mfma_f32_32x32x16_bf16(b1,qr[0],negm,0,0,0);}
    else{p0=__builtin_amdgcn_mfma_f32_32x32x16_bf16(b0,qr[d0],p0,0,0,0);p1=__builtin_amdgcn_mfma_f32_32x32x16_bf16(b1,qr[d0],p1,0,0,0);}}
}
typedef LAS const char* lds_cptr;
typedef short v4i16_t __attribute__((ext_vector_type(4)));
__device__ __forceinline__ void kload8(bf16x8*kf,lds_cptr kp){
  kf[0]=*(const LAS bf16x8*)(kp);      kf[1]=*(const LAS bf16x8*)(kp+512);
  kf[2]=*(const LAS bf16x8*)(kp+2048); kf[3]=*(const LAS bf16x8*)(kp+2560);
  kf[4]=*(const LAS bf16x8*)(kp+4096); kf[5]=*(const LAS bf16x8*)(kp+4608);
  kf[6]=*(const LAS bf16x8*)(kp+6144); kf[7]=*(const LAS bf16x8*)(kp+6656);
}
__device__ __forceinline__ void kload2(bf16x8*kf,lds_cptr kp,int j){ kf[2*j]=*(const LAS bf16x8*)(kp+j*2048); kf[2*j+1]=*(const LAS bf16x8*)(kp+j*2048+512); }
#ifdef HOST_EMU
__device__ __forceinline__ s16x4 vtr(lds_cptr p){ return __builtin_bit_cast(s16x4, emu_ds_read_tr16_b64((const void*)p)); }
#else
__device__ __forceinline__ s16x4 vtr(lds_cptr p){ return __builtin_bit_cast(s16x4,__builtin_amdgcn_ds_read_tr16_b64_v4i16((LAS v4i16_t*)p)); }
#endif
__device__ __forceinline__ float rowmax(const f32x16&p0,const f32x16&p1){
  float a=max3f(p0[0],p0[1],p1[0]),b=max3f(p0[2],p0[3],p1[1]);a=max3f(a,p1[2],p1[3]);
  #pragma unroll
  for(int r=4;r<16;r+=4){a=max3f(a,p0[r],p0[r+1]);b=max3f(b,p0[r+2],p0[r+3]);a=max3f(a,p1[r],p1[r+1]);b=max3f(b,p1[r+2],p1[r+3]);}
  const float m=max2f(a,b);
  auto rr=__builtin_amdgcn_permlane32_swap(__float_as_uint(m),__float_as_uint(m),false,false);
  return max2f(__uint_as_float(rr[0]),__uint_as_float(rr[1]));
}
__device__ __forceinline__ void pv(f32x16*o,int vb,bf16x8 pa0,bf16x8 pa1,bf16x8 pa2,bf16x8 pa3){
  #pragma unroll
  for(int d0=0;d0<2;++d0){s16x4 lo[4],hi[4];
    #pragma unroll
    for(int ks=0;ks<4;++ks){
#ifdef HOST_EMU
      lo[ks]=__builtin_bit_cast(s16x4, emu_ds_read_tr16_b64(emu_lds()+vb+d0*4096+ks*1024)); hi[ks]=__builtin_bit_cast(s16x4, emu_ds_read_tr16_b64(emu_lds()+vb+d0*4096+ks*1024+512));}
#else
      asm volatile("ds_read_b64_tr_b16 %0,%1 offset:%c2":"=&v"(lo[ks]):"v"(vb),"i"(d0*4096+ks*1024):"memory");
      asm volatile("ds_read_b64_tr_b16 %0,%1 offset:%c2":"=&v"(hi[ks]):"v"(vb),"i"(d0*4096+ks*1024+512):"memory");}
    asm volatile("s_waitcnt lgkmcnt(0)":::"memory");
#endif
    SBAR();
    #define PK(k) (bf16x8){lo[k][0],lo[k][1],lo[k][2],lo[k][3],hi[k][0],hi[k][1],hi[k][2],hi[k][3]}
    o[d0]=__builtin_amdgcn_mfma_f32_32x32x16_bf16(pa0,PK(0),o[d0],0,0,0);
    o[d0]=__builtin_amdgcn_mfma_f32_32x32x16_bf16(pa1,PK(1),o[d0],0,0,0);
    o[d0]=__builtin_amdgcn_mfma_f32_32x32x16_bf16(pa2,PK(2),o[d0],0,0,0);
    o[d0]=__builtin_amdgcn_mfma_f32_32x32x16_bf16(pa3,PK(3),o[d0],0,0,0);
    #undef PK
  }
}

#ifndef ATTN_STORE16
#define ATTN_STORE16(p,v) (*(u32x4*)(p)=(v))
#endif
struct NoHook { static constexpr bool USE_NEGM = true, QSCALE = false, QPREP = false; static constexpr int QPITCH = QP, KPITCH = KP, VPITCH = KP; __device__ __forceinline__ long koff(int t) const { return (long)t * KVBLK * KP; } __device__ __forceinline__ long voff(int t) const { return (long)t * KVBLK * KP; } __device__ __forceinline__ void mask(f32x16&, f32x16&, int) const {} };
struct GqaHook { static constexpr bool USE_NEGM = true, QSCALE = false, QPREP = true; static constexpr int QPITCH = INC, KPITCH = KP, VPITCH = INC;
  long ctx_off, lat_off; const float* gq; const float* rope; int t0;
  __device__ __forceinline__ long koff(int t) const { return (long)t * KVBLK * KP; }
  __device__ __forceinline__ long voff(int t) const { constexpr int NC4 = TC / 64; return t < NC4 ? ctx_off + (long)t * 64 * INC : lat_off + (long)(t - NC4) * 64 * INC; }
  __device__ __forceinline__ void mask(f32x16&, f32x16&, int) const {}
  __device__ __forceinline__ void qprep(bf16x8 (&qr)[4], int r32, int hi, int wid) const {
    float y[4][8]; float ss = 0.f;
    #pragma unroll
    for (int d0 = 0; d0 < 4; ++d0) {
      #pragma unroll
      for (int j = 0; j < 8; ++j) { y[d0][j] = bf2f((unsigned short)qr[d0][j]); ss += y[d0][j] * y[d0][j]; } }
    { auto rr = __builtin_amdgcn_permlane32_swap(__float_as_uint(ss), __float_as_uint(ss), false, false); ss = __uint_as_float(rr[0]) + __uint_as_float(rr[1]); }
    const float rstd = 1.f / sqrtf(ss * (1.f / 64.f) + EPS);
    #pragma unroll
    for (int d0 = 0; d0 < 4; ++d0) {
      #pragma unroll
      for (int j = 0; j < 8; ++j) y[d0][j] = y[d0][j] * rstd * gq[16 * d0 + 8 * hi + j]; }
    if (t0 >= 0) { const int t = t0 + wid * QBLK + r32;
      #pragma unroll
      for (int hf = 0; hf < 2; ++hf) { const int pos = hf == 0 ? t / GW : t % GW; const float* tb = rope + pos * 32 + 8 * hi;
        #pragma unroll
        for (int j = 0; j < 8; ++j) { const float cs = tb[j], sn = tb[16 + j], a = y[2 * hf][j], b = y[2 * hf + 1][j]; y[2 * hf][j] = a * cs - b * sn; y[2 * hf + 1][j] = b * cs + a * sn; } } }
    #pragma unroll
    for (int d0 = 0; d0 < 4; ++d0) {
      #pragma unroll
      for (int j = 0; j < 8; ++j) qr[d0][j] = (short)f2bf(y[d0][j] * ATT_C2); } } };

template<int THRL, class Hook = NoHook> __device__ __forceinline__ void attn_unit(const bf16*Qw0,const bf16*__restrict__ Kh,const bf16*__restrict__ Vh,bf16*Ow0,const int NT,LAS char*shm,const Hook H = Hook()){
  const int tid=threadIdx.x,lane=tid&63,r32=lane&31,hi=lane>>5; const int wid=__builtin_amdgcn_readfirstlane(tid>>6);
  constexpr int QP_=Hook::QPITCH, KP_=Hook::KPITCH, VP_=Hook::VPITCH;
  const bf16*Qw=Qw0+(long)(wid*QBLK)*QP_;
  const unsigned lds0=LDSADDR(shm);
  LAS float*wsf=(LAS float*)(shm+LDS_WS)+wid*64;
  const bf16*ksrc=Kh+(long)lane*KP_+wid*8;
  const bf16*vsrc=Vh+(long)(16*(wid&3)+(lane>>2))*VP_+(wid>>2)*32+(lane&3)*8;
  const unsigned kdst=lds0+LDS_K+wid*1024, vdst=lds0+LDS_V+wid*1024;
  #define DMA_K(t,slot) glds16(ksrc+H.koff(t),(unsigned)__builtin_amdgcn_readfirstlane(kdst+(slot)))
  #define DMA_V(t,slot) glds16(vsrc+H.voff(t),(unsigned)__builtin_amdgcn_readfirstlane(vdst+(slot)))
  const int vb0=(int)(lds0+LDS_V)+((lane>>4)&1)*32+(lane&3)*8+(4*hi+((lane&15)>>2))*64;
  LAS const char*Kbase=shm+LDS_K; bf16x8 kf[8];
  const lds_cptr shm3=(lds_cptr)shm; const lds_cptr kp0=shm3+LDS_K+hi*1024+r32*16; const lds_cptr vp0=shm3+LDS_V+((lane>>4)&1)*32+(lane&3)*8+(4*hi+((lane&15)>>2))*64;
  DMA_K(0,0);DMA_V(0,0);DMA_K(1,SLOTB);
  bf16x8 qr[4];
  #pragma unroll
  for(int d0=0;d0<4;++d0){qr[d0]=*reinterpret_cast<const bf16x8*>(&Qw[(long)r32*QP_+d0*16+hi*8]);
    if constexpr (Hook::QSCALE) { _Pragma("unroll") for(int j=0;j<8;++j) qr[d0][j]=(short)f2bf(bf2f((unsigned short)qr[d0][j])*ATT_C2); } }
  if constexpr (Hook::QPREP) H.qprep(qr, r32, hi, wid);
  float mhat=0.f,l_reg=0.f;f32x16 o[2];o[0]=f32x16{};o[1]=f32x16{};f32x16 negm=f32x16{}; if constexpr (Hook::USE_NEGM) { PINV(negm); } const f32x16 z16_=f32x16{};
  #define CMASK(P0,P1,t) do{ H.mask(P0,P1,(t)); }while(0)
  bool resc=false;
  #define START(P0,P1) do{ const float rm=rowmax(P0,P1); resc=false; \
    { const float dl=rm; mhat=fadd_s(mhat,dl); \
      _Pragma("unroll") for(int r=0;r<16;++r){P0[r]=fsub_s(P0[r],dl);P1[r]=fsub_s(P1[r],dl);} \
      if constexpr (Hook::USE_NEGM) { _Pragma("unroll") for(int r=0;r<16;++r)negm[r]=-mhat; PINV(negm); } } \
    _Pragma("unroll") for(int r=0;r<16;++r)P0[r]=__builtin_amdgcn_exp2f(P0[r]); }while(0)
  #define RESC() do{ if(resc){ ASM_("s_waitcnt lgkmcnt(0)":::"memory"); \
      _Pragma("unroll") for(int d_=0;d_<2;++d_) _Pragma("unroll") for(int r=0;r<16;++r)o[d_][r]*=wsf[crow(r,hi)]; } }while(0)
  f32x16 pA0,pA1,pB0,pB1;
  int sl_prev=0,sl_cur=0,sl_next=SLOTB;
  #define ROT() do{sl_prev=sl_cur;sl_cur=sl_next;sl_next=(sl_next==(NSLOT-1)*SLOTB)?0:sl_next+SLOTB;}while(0)
  DMA_K(2,2*SLOTB);
  WAIT_BAR(3);
  qkt(pA0,pA1,Kbase,qr,negm,r32,hi);
#ifndef HOST_EMU
  asm volatile("s_nop 15\n\ts_nop 7":"+v"(pA0),"+v"(pA1));
#endif

  START(pA0,pA1);
  _Pragma("unroll") for(int r=0;r<16;++r)pA1[r]=__builtin_amdgcn_exp2f(pA1[r]);
  WAIT_BAR(0);
  DMA_K(3,0);DMA_V(1,SLOTB);
  ROT();
  kload8(kf,kp0+sl_cur);
  WAIT_BAR(2);
  s16x4 vlo[8],vhi[8]; u32x4 pw0,pw1,pw2,pw3;
  #define PKW(P,B) cvtpk_s(P[B],P[B+1])
  #define PAF(k) __builtin_bit_cast(bf16x8,pw##k)
  #define VFR(i) (bf16x8){vlo[i][0],vlo[i][1],vlo[i][2],vlo[i][3],vhi[i][0],vhi[i][1],vhi[i][2],vhi[i][3]}
  #define PIN(x) PINV(x)
  #define MX3(a,b,c) __builtin_fmaxf(__builtin_fmaxf((a),(b)),(c))
  #define GAPA(MF,A0,A1,A2,A3,W0,W1,PW) do{ MF; sacc+=A0; sacc+=A1; sacc+=A2; sacc+=A3; PIN(sacc); W0; W1; PIN(PW); SBAR(); }while(0)
  #define EX(v) __builtin_amdgcn_exp2f(v)
  #define GAPB(MF,X,B) do{ MF; X[B]=EX(X[B]); X[B+1]=EX(X[B+1]); X[B+2]=EX(X[B+2]); X[B+3]=EX(X[B+3]); PIN(X); SBAR(); }while(0)
  #define VRD(i) do{ vlo[i]=vtr(vp_+(((i)>>2)*4096+((i)&3)*1024)); vhi[i]=vtr(vp_+(((i)>>2)*4096+((i)&3)*1024+512)); }while(0)
  #define KRD(G,j) do{ if(G){ kload2(kf,kp0+sl_next,j); SBAR(); } }while(0)
  #define STEP(C0,C1,P0,P1,t,GK,GV,GL) do{ SBAR(); \
    const lds_cptr vp_=vp0+sl_prev; \
    VRD(0); SBAR(); float sacc=(P0[0]+P0[1]); \
    GAPA(C0=__builtin_amdgcn_mfma_f32_32x32x16_bf16(kf[0],qr[0],(Hook::USE_NEGM?negm:z16_),0,0,0), P0[2],P0[3],P0[4],P0[5],     pw0[0]=PKW(P0,0), pw0[1]=PKW(P0,2), pw0); \
    VRD(4); SBAR(); GAPA(C1=__builtin_amdgcn_mfma_f32_32x32x16_bf16(kf[1],qr[0],(Hook::USE_NEGM?negm:z16_),0,0,0), P0[6],P0[7],P0[8],P0[9],     pw0[2]=PKW(P0,4), pw0[3]=PKW(P0,6), pw0); \
    VRD(1); SBAR(); GAPA(C0=__builtin_amdgcn_mfma_f32_32x32x16_bf16(kf[2],qr[1],C0,0,0,0),   P0[10],P0[11],P0[12],P0[13], pw1[0]=PKW(P0,8), pw1[1]=PKW(P0,10), pw1); \
    VRD(5); SBAR(); GAPA(C1=__builtin_amdgcn_mfma_f32_32x32x16_bf16(kf[3],qr[1],C1,0,0,0),   P0[14],P0[15],P1[0],P1[1],   pw1[2]=PKW(P0,12),pw1[3]=PKW(P0,14), pw1); \
    VRD(2); SBAR(); GAPA(C0=__builtin_amdgcn_mfma_f32_32x32x16_bf16(kf[4],qr[2],C0,0,0,0),   P1[2],P1[3],P1[4],P1[5],     pw2[0]=PKW(P1,0), pw2[1]=PKW(P1,2), pw2); \
    VRD(6); SBAR(); GAPA(C1=__builtin_amdgcn_mfma_f32_32x32x16_bf16(kf[5],qr[2],C1,0,0,0),   P1[6],P1[7],P1[8],P1[9],     pw2[2]=PKW(P1,4), pw2[3]=PKW(P1,6), pw2); \
    VRD(3); SBAR(); GAPA(C0=__builtin_amdgcn_mfma_f32_32x32x16_bf16(kf[6],qr[3],C0,0,0,0),   P1[10],P1[11],P1[12],P1[13], pw3[0]=PKW(P1,8), pw3[1]=PKW(P1,10), pw3); \
    VRD(7); SBAR(); GAPA(C1=__builtin_amdgcn_mfma_f32_32x32x16_bf16(kf[7],qr[3],C1,0,0,0),   P1[14],P1[15],0.f,0.f,       pw3[2]=PKW(P1,12),pw3[3]=PKW(P1,14), pw3); \
    l_reg+=sacc; \
    if(GK){DMA_K((t)+3,sl_cur);} if(GV){DMA_V((t)+1,sl_next);} \
    if constexpr (!Hook::USE_NEGM) { _Pragma("unroll") for(int r=0;r<16;++r){C0[r]-=mhat;C1[r]-=mhat;} } \
    CMASK(C0,C1,t); \
    { float a=MX3(C0[0],C0[1],C1[0]),b=MX3(C0[2],C0[3],C1[1]); a=MX3(a,C1[2],C1[3]); \
      _Pragma("unroll") for(int r=4;r<16;r+=4){a=MX3(a,C0[r],C0[r+1]);b=MX3(b,C0[r+2],C0[r+3]);a=MX3(a,C1[r],C1[r+1]);b=MX3(b,C1[r+2],C1[r+3]);} \
      float rm=__builtin_fmaxf(a,b); { auto rr=__builtin_amdgcn_permlane32_swap(__float_as_uint(rm),__float_as_uint(rm),false,false); rm=__builtin_fmaxf(__uint_as_float(rr[0]),__uint_as_float(rr[1])); } \
      resc=false; \
      if(__builtin_expect(__any(rm>(float)THRL),0)){ const float dl=__builtin_fmaxf(rm,0.f); mhat+=dl; \
        _Pragma("unroll") for(int r=0;r<16;++r){C0[r]-=dl;C1[r]-=dl;} \
        if constexpr (Hook::USE_NEGM) { _Pragma("unroll") for(int r=0;r<16;++r)negm[r]=-mhat; PINV(negm); } \
        const float f=__builtin_amdgcn_exp2f(-dl); l_reg*=f; if(hi==0)wsf[r32]=f; resc=true; } } \
    SBAR(); \
    GAPB(o[0]=__builtin_amdgcn_mfma_f32_32x32x16_bf16(PAF(0),VFR(0),o[0],0,0,0), C0,0); \
    GAPB(o[1]=__builtin_amdgcn_mfma_f32_32x32x16_bf16(PAF(0),VFR(4),o[1],0,0,0), C0,4); \
    KRD(GL,0); GAPB(o[0]=__builtin_amdgcn_mfma_f32_32x32x16_bf16(PAF(1),VFR(1),o[0],0,0,0), C0,8); \
    KRD(GL,1); GAPB(o[1]=__builtin_amdgcn_mfma_f32_32x32x16_bf16(PAF(1),VFR(5),o[1],0,0,0), C0,12); \
    KRD(GL,2); GAPB(o[0]=__builtin_amdgcn_mfma_f32_32x32x16_bf16(PAF(2),VFR(2),o[0],0,0,0), C1,0); \
    KRD(GL,3); GAPB(o[1]=__builtin_amdgcn_mfma_f32_32x32x16_bf16(PAF(2),VFR(6),o[1],0,0,0), C1,4); \
    GAPB(o[0]=__builtin_amdgcn_mfma_f32_32x32x16_bf16(PAF(3),VFR(3),o[0],0,0,0), C1,8); \
    GAPB(o[1]=__builtin_amdgcn_mfma_f32_32x32x16_bf16(PAF(3),VFR(7),o[1],0,0,0), C1,12); \
    }while(0)
  int t=1;
  #undef CMASK
  #define CMASK(P0,P1,t) do{ H.mask(P0,P1,(t)); }while(0)
  for(;t+5<NT;t+=2){
    STEP(pB0,pB1,pA0,pA1,t,true,true,true);     WAIT_BAR(2); RESC(); ROT();
    STEP(pA0,pA1,pB0,pB1,t+1,true,true,true);   WAIT_BAR(2); RESC(); ROT();
  }
  #undef CMASK
  #define CMASK(P0,P1,t) do{ H.mask(P0,P1,(t)); }while(0)
  #define ENDW(tt) do{ if((tt)+3<NT){WAIT_BAR(2);} else if((tt)+2<NT){WAIT_BAR(1);} else {WAIT_BAR(0);} }while(0)
  for(;t+1<NT;t+=2){
    STEP(pB0,pB1,pA0,pA1,t,(t+3<NT),(t+1<NT),(t+1<NT));       ENDW(t);   RESC(); ROT();
    STEP(pA0,pA1,pB0,pB1,t+1,(t+4<NT),(t+2<NT),(t+2<NT));     ENDW(t+1); RESC(); ROT();
  }
  STEP(pB0,pB1,pA0,pA1,NT-1,false,false,false); RESC();
  { float sacc=pB0[0]+pB0[1]; _Pragma("unroll") for(int r=2;r<16;++r)sacc+=pB0[r]; _Pragma("unroll") for(int r=0;r<16;++r)sacc+=pB1[r]; l_reg+=sacc;
    pw0=(u32x4){PKW(pB0,0),PKW(pB0,2),PKW(pB0,4),PKW(pB0,6)};pw1=(u32x4){PKW(pB0,8),PKW(pB0,10),PKW(pB0,12),PKW(pB0,14)};pw2=(u32x4){PKW(pB1,0),PKW(pB1,2),PKW(pB1,4),PKW(pB1,6)};pw3=(u32x4){PKW(pB1,8),PKW(pB1,10),PKW(pB1,12),PKW(pB1,14)};
    SBAR(); pv(o,vb0+sl_cur,PAF(0),PAF(1),PAF(2),PAF(3)); }
  #undef PKW
  #undef PAF
  #undef VFR
  #undef PIN
  #undef MX3
  #undef GAPA
  #undef GAPB
  #undef EX
  #undef VRD
  #undef KRD
  #undef STEP
  #undef ENDW
  {auto rr=__builtin_amdgcn_permlane32_swap(__float_as_uint(l_reg),__float_as_uint(l_reg),false,false);l_reg=__uint_as_float(rr[0])+__uint_as_float(rr[1]);}
  if(hi==0)wsf[32+r32]=l_reg;ASM_("s_waitcnt lgkmcnt(0)":::"memory");WAVE_SYNC();
  float rli[16];
  #pragma unroll
  for(int r=0;r<16;++r)rli[r]=__builtin_amdgcn_rcpf(wsf[32+crow(r,hi)]);
  bf16*Ow=Ow0+(long)(wid*QBLK)*OP;
  { LAS bf16*stg=(LAS bf16*)(shm+LDS_OST)+wid*2048;
    #pragma unroll
    for(int r=0;r<16;++r){const int orow=crow(r,hi);
      #pragma unroll
      for(int d0=0;d0<2;++d0)stg[orow*64+d0*32+r32]=(bf16)f2bf(o[d0][r]*rli[r]);}
    ASM_("s_waitcnt lgkmcnt(0)":::"memory");WAVE_SYNC();
    #pragma unroll
    for(int i=0;i<4;++i){const int row=i*8+(lane>>3),ch=lane&7; const u32x4 v=*(const LAS u32x4*)(stg+row*64+ch*8); ATTN_STORE16(Ow+(long)row*OP+ch*8,v);} }
#ifdef HOST_EMU
  __syncthreads();
#else
  asm volatile("s_waitcnt lgkmcnt(0)\n\ts_barrier":::"memory");
#endif
  #undef DMA_K
  #undef DMA_V
  #undef CMASK
  #undef START
  #undef RESC
  #undef ROT
}
constexpr int ATTN_LDS_BYTES=LDS_BYTES;

struct NaHook { static constexpr bool USE_NEGM = false;
  static constexpr bool QSCALE = true, QPREP = false; static constexpr int QPITCH = INC, KPITCH = INC, VPITCH = INC;
  long ctx_off, lat_off;
  int krlo, nwin, rsq, qrow, pk; const LAS float* tbl;
  __device__ __forceinline__ long voff(int t) const { return koff(t); }
  __device__ __forceinline__ long koff(int t) const { constexpr int NC4 = TC / 64; if (t < NC4) return ctx_off + (long)t * 64 * INC; const int w = t - NC4; return lat_off + (long)(krlo + (w < nwin ? w : 0)) * 64 * INC; }
  __device__ __forceinline__ void mask(f32x16& p0, f32x16& p1, int t) const { constexpr int NC4 = TC / 64;
    const int w = t - NC4, kr = krlo + w; const bool win = t >= NC4, part = win && w < nwin && kr >= rsq && kr < rsq + 8;
    const LAS float* trow = tbl + (part ? kr - qrow + 7 : 15) * 128 + (pk >> 16);
    const LAS float* prow = tbl + (win ? 16 * 128 + (part ? 64 + (int)(short)(pk & 0xffff) : 0) : 15 * 128);
    #pragma unroll
    for (int r = 0; r < 16; ++r) { const int kk = (r & 3) + 8 * (r >> 2); p0[r] = p0[r] + trow[kk] + prow[kk]; p1[r] = p1[r] + trow[kk + 32] + prow[kk + 32]; } } };
constexpr int LDS_RPB = LDS_BYTES;
constexpr int NA_TS = 128, NA_PAD = 48;
constexpr int NA_LDS_BYTES = LDS_RPB + 17 * NA_TS * 4;
__device__ __forceinline__ void na_unit(const bf16* __restrict__ P, const bf16* __restrict__ NAKV, const float* __restrict__ rpb_h, int b, int h, int r0, bool is_ctx, bf16* Ow0, LAS char* shm) {
  const int tid=threadIdx.x,lane=tid&63,r32=lane&31,hi=lane>>5; const int wid=__builtin_amdgcn_readfirstlane(tid>>6);
  const unsigned lds0=LDSADDR(shm);
  LAS float*wsf=(LAS float*)(shm+LDS_WS)+wid*64; LAS float* tbl=(LAS float*)(shm+LDS_RPB);
  const int qrow = r0 + (wid>>1), qc = (wid&1)*32 + r32;
  const size_t qtok0 = is_ctx ? (size_t)(MLAT + b*TC) : (size_t)(b*T + r0*GW);
  const bf16* Qw = P + (qtok0 + wid*32) * INC + PC_NAQ + h*64;
  int rs0 = r0 - 4; rs0 = rs0 < 0 ? 0 : (rs0 > NROWS-8 ? NROWS-8 : rs0); int rs3 = r0 + 3 - 4; rs3 = rs3 < 0 ? 0 : (rs3 > NROWS-8 ? NROWS-8 : rs3);
  const int krlo = rs0, nwin = is_ctx ? 0 : (rs3 + 8 - rs0), ntile = nwin + TC/64;
  int rsq = qrow - 4; rsq = rsq < 0 ? 0 : (rsq > NROWS-8 ? NROWS-8 : rsq);
  int csq = qc - 8; csq = csq < 0 ? 0 : (csq > GW-16 ? GW-16 : csq);
  const unsigned kdst=lds0+LDS_K+wid*1024, vdst=lds0+LDS_V+wid*1024;
  const bf16* Kc = (const bf16*)(NAKV) + (size_t)(b*NH + h)*(TC+T)*64; const bf16* Vc = Kc + (size_t)M*GWD;
  #define NA_TILE_ROW0(i) ((i) < nwin ? (size_t)(TC + (krlo+(i))*GW) : (size_t)(((i)-nwin)*64))
  #define NA_DMA(i,slot) do{ const size_t p0_=NA_TILE_ROW0(i)*64; \
      glds16(Kc + p0_ + (size_t)lane*64 + wid*8, (unsigned)__builtin_amdgcn_readfirstlane(kdst+(slot))); \
      glds16(Vc + p0_ + (size_t)(16*(wid&3)+(lane>>2))*64 + (wid>>2)*32 + (lane&3)*8, (unsigned)__builtin_amdgcn_readfirstlane(vdst+(slot))); }while(0)
  NA_DMA(0,0);
  for (int i = tid; i < 15*NA_TS; i += 512) { const int j = (i % NA_TS) - NA_PAD; tbl[i] = (is_ctx || j < 0 || j > 30) ? 0.f : rpb_h[(i / NA_TS) * 31 + j] * 1.4426950408889634f; }
  const LAS float* tb = tbl + NA_PAD + (4*hi - qc + 15); const int d0 = 4*hi - csq;
  bf16x8 qr[4];
  #pragma unroll
  for(int d0=0;d0<4;++d0){ float t[8]; ld8bf(&Qw[(size_t)r32*INC+d0*16+hi*8], t); u32x4 w; w.x=pk2(t[0]*ATT_C2,t[1]*ATT_C2); w.y=pk2(t[2]*ATT_C2,t[3]*ATT_C2); w.z=pk2(t[4]*ATT_C2,t[5]*ATT_C2); w.w=pk2(t[6]*ATT_C2,t[7]*ATT_C2); qr[d0]=__builtin_bit_cast(bf16x8,w); }
  float m_run=-1e30f, l_run=0.f; f32x16 o[2]; o[0]=f32x16{}; o[1]=f32x16{}; const f32x16 zero16=f32x16{};
  const int vb0=(int)(lds0+LDS_V)+((lane>>4)&1)*32+(lane&3)*8+(4*hi+((lane&15)>>2))*64;
  NA_DMA(1, SLOTB);
  int slot = 0, slot2 = 2*SLOTB;
  for (int i = 0; i < ntile; ++i) {
    if (i+1 < ntile) { WAIT_BAR(2); } else { WAIT_BAR(0); }
    if (i+2 < ntile) NA_DMA(i+2, slot2);
    const bool win = i < nwin; const int kr = krlo + i;
    if (!win || (kr >= rsq && kr < rsq + 8)) {
      f32x16 p0,p1; qkt(p0,p1,(LAS const char*)(shm+LDS_K+slot),qr,zero16,r32,hi);
      if (win) { const LAS float* trow = tb + (kr - qrow + 7)*NA_TS;
        #pragma unroll
        for(int r=0;r<16;++r){ const int kk=(r&3)+8*(r>>2); p0[r] = ((unsigned)(d0+kk) < 16u) ? p0[r]+trow[kk] : -1e30f; }
        #pragma unroll
        for(int r=0;r<16;++r){ const int kk=(r&3)+8*(r>>2)+32; p1[r] = ((unsigned)(d0+kk) < 16u) ? p1[r]+trow[kk] : -1e30f; } }
      const float rm = rowmax(p0,p1); const bool grow = __any(rm > m_run); const float mn = fmaxf(m_run, rm); const float alpha = exp2f(m_run - mn); m_run = mn;
      float sacc = 0.f;
      #pragma unroll
      for(int r=0;r<16;++r){ p0[r]=exp2f(p0[r]-mn); p1[r]=exp2f(p1[r]-mn); sacc += p0[r]+p1[r]; }
      l_run = l_run*alpha + sacc;
      if (grow) {
        if(hi==0) wsf[r32]=alpha;
        ASM_("s_waitcnt lgkmcnt(0)":::"memory"); WAVE_SYNC();
        #pragma unroll
        for(int d_=0;d_<2;++d_)
          #pragma unroll
          for(int r=0;r<16;++r) o[d_][r]*=wsf[crow(r,hi)];
        WAVE_SYNC(); }
      u32x4 pw0,pw1,pw2,pw3;
      pw0=(u32x4){cvtpk_s(p0[0],p0[1]),cvtpk_s(p0[2],p0[3]),cvtpk_s(p0[4],p0[5]),cvtpk_s(p0[6],p0[7])}; pw1=(u32x4){cvtpk_s(p0[8],p0[9]),cvtpk_s(p0[10],p0[11]),cvtpk_s(p0[12],p0[13]),cvtpk_s(p0[14],p0[15])};
      pw2=(u32x4){cvtpk_s(p1[0],p1[1]),cvtpk_s(p1[2],p1[3]),cvtpk_s(p1[4],p1[5]),cvtpk_s(p1[6],p1[7])}; pw3=(u32x4){cvtpk_s(p1[8],p1[9]),cvtpk_s(p1[10],p1[11]),cvtpk_s(p1[12],p1[13]),cvtpk_s(p1[14],p1[15])};
      SBAR(); pv(o,vb0+slot,__builtin_bit_cast(bf16x8,pw0),__builtin_bit_cast(bf16x8,pw1),__builtin_bit_cast(bf16x8,pw2),__builtin_bit_cast(bf16x8,pw3));
    }
    slot = (slot == 2*SLOTB) ? 0 : slot + SLOTB; slot2 = (slot2 == 2*SLOTB) ? 0 : slot2 + SLOTB;
  }
  #undef NA_DMA
  #undef NA_TILE_ROW0
  {auto rr=__builtin_amdgcn_permlane32_swap(__float_as_uint(l_run),__float_as_uint(l_run),false,false);l_run=__uint_as_float(rr[0])+__uint_as_float(rr[1]);}
  if(hi==0)wsf[32+r32]=l_run;ASM_("s_waitcnt lgkmcnt(0)":::"memory");WAVE_SYNC();
  float rli[16];
  #pragma unroll
  for(int r=0;r<16;++r)rli[r]=1.f/wsf[32+crow(r,hi)];
  bf16*Ow=Ow0+(long)(wid*32)*OP;
  { LAS bf16*stg=(LAS bf16*)(shm+LDS_OST)+wid*2048;
    #pragma unroll
    for(int r=0;r<16;++r){const int orow=crow(r,hi);
      #pragma unroll
      for(int d0=0;d0<2;++d0)stg[orow*64+d0*32+r32]=(bf16)f2bf(o[d0][r]*rli[r]);}
    ASM_("s_waitcnt lgkmcnt(0)":::"memory");WAVE_SYNC();
    #pragma unroll
    for(int i=0;i<4;++i){const int row=i*8+(lane>>3),ch=lane&7; const u32x4 v=*(const LAS u32x4*)(stg+row*64+ch*8); *(u32x4*)(Ow+(long)row*OP+ch*8)=v;} }
#ifdef HOST_EMU
  __syncthreads();
#else
  asm volatile("s_waitcnt lgkmcnt(0)\n\ts_barrier":::"memory");
#endif
}
#undef SBAR
#undef WAIT_BAR
}

namespace s5m {
#ifdef HOST_EMU
using attn_body::emu_permlane32_swap;
#endif
using attn_body::bf16x8; using attn_body::f32x16; using attn_body::s16x4; using attn_body::vtr; using attn_body::cvtpk_s; using attn_body::crow; using attn_body::lds_cptr;
constexpr int NFR = 12, NCN = 10, OFF_FR = 0, OFF_CN = 2 * NFR * 64 * 16, OFF_IMG = OFF_CN + 2 * 2 * NCN * 64 * 8, IMG_W = 8192, LDS_TOTAL = OFF_IMG + 8 * IMG_W;
static_assert(LDS_TOTAL <= 131072, "S5 LDS");
struct cx { float r, i; };
__device__ __forceinline__ cx cmul(cx a, cx b) { return cx{a.r * b.r - a.i * b.i, a.r * b.i + a.i * b.r}; }
__device__ __forceinline__ void disc(const Ctx& c, int l, int dir, int g, int p, cx& a, cx& f) {
    const size_t gi = ((size_t)(l * 2 + dir) * S5G + g);
    const float lr = c.in(I_S5LRE)[gi * 64 + p], li = c.in(I_S5LIM)[gi * 64 + p], dt = expf(c.in(I_S5STEP)[gi]);
    const float th = li * dt, em1 = expm1f(lr * dt), cs = cosf(th), sn = sinf(th), sh = sinf(0.5f * th);
    const float arm1 = em1 * cs - 2.f * sh * sh; a.r = 1.f + arm1; a.i = (em1 + 1.f) * sn;
    const float den = lr * lr + li * li; f.r = (arm1 * lr + a.i * li) / den; f.i = (a.i * lr - arm1 * li) / den;
}
__device__ __forceinline__ void build_item(const Ctx& c, int l, int g, int item) {
    unsigned char* L = c.ws + WS_S5T + (size_t)(l * S5G + g) * S5T_BYTES; static_assert(S5T_BYTES == (size_t)OFF_IMG, "table size");
    if (item < 256) { const int tid_ = item; const int dir = tid_ >> 7, sp = (tid_ >> 6) & 1, ln = tid_ & 63, hi = ln >> 5, p = 32 * sp + (ln & 31);
        cx a, f; disc(c, l, dir, g, p, a, f); const float n2 = 1.f / (a.r * a.r + a.i * a.i); const cx ai{a.r * n2, -a.i * n2};
        const cx a2 = cmul(a, a), a4 = cmul(a2, a2), a8 = cmul(a4, a4), a16 = cmul(a8, a8), a32 = cmul(a16, a16);
        const cx i2 = cmul(ai, ai), i4 = cmul(i2, i2), i8 = cmul(i4, i4), i16 = cmul(i8, i8), i32 = cmul(i16, i16);
        const cx a63 = cmul(cmul(cmul(a32, a16), cmul(a8, a4)), cmul(a2, a)), i63 = cmul(cmul(cmul(i32, i16), cmul(i8, i4)), cmul(i2, ai));
        const cx one{1.f, 0.f}; const cx a4h = hi ? a4 : one, i4h = hi ? i4 : one;
        cx k[NCN];
        if (dir == 0) { k[0] = i4h; k[1] = cmul(i32, i4h); k[2] = ai; k[3] = i8; k[4] = a4h; k[5] = cmul(a32, a4h); k[6] = a; k[7] = a8; }
        else { k[0] = cmul(i63, a4h); k[1] = cmul(i63, cmul(a32, a4h)); k[2] = a; k[3] = a8; k[4] = cmul(a63, i4h); k[5] = cmul(a63, cmul(i32, i4h)); k[6] = ai; k[7] = i8; }
        k[8] = a; k[9] = a63;
        float* cn = (float*)(L + OFF_CN) + ((size_t)(dir * 2 + sp) * NCN * 64 + ln) * 2;
#pragma unroll
        for (int q = 0; q < NCN; ++q) { cn[q * 128] = k[q].r; cn[q * 128 + 1] = k[q].i; } }
    else { const int e = item - 256; const int ln = e & 63, fr = (e >> 6) % NFR, dir = e / (64 * NFR), col = ln & 31, hi = ln >> 5; float v[8];
        const size_t gi = ((size_t)(l * 2 + dir) * S5G + g);
        if (fr < 4) { const int sp = fr >> 1, im = fr & 1, p = 32 * sp + col; cx a, f; disc(c, l, dir, g, p, a, f);
            const float* br = c.in(I_S5BRE) + (gi * 64 + p) * 16 + 8 * hi; const float* bi = c.in(I_S5BIM) + (gi * 64 + p) * 16 + 8 * hi;
#pragma unroll
            for (int j = 0; j < 8; ++j) v[j] = im ? (f.r * bi[j] + f.i * br[j]) : (f.r * br[j] - f.i * bi[j]); }
        else { const int idx = fr - 4, n = idx >> 1, sk = idx & 1, sp = n >> 1, im = n & 1, p0 = 32 * sp + 16 * sk + 8 * hi;
            const float* cp = (im ? c.in(I_S5CIM) : c.in(I_S5CRE)) + (gi * 16 + (col & 15)) * 64 + p0;
#pragma unroll
            for (int j = 0; j < 8; ++j) v[j] = col < 16 ? (im ? -cp[j] : cp[j]) : 0.f; }
        u32x4 w; w.x = pk2(v[0], v[1]); w.y = pk2(v[2], v[3]); w.z = pk2(v[4], v[5]); w.w = pk2(v[6], v[7]);
        *(u32x4*)(L + OFF_FR + ((size_t)(dir * NFR + fr) * 64 + ln) * 16) = w; }
}
__device__ __forceinline__ void build_all(const Ctx& c) { constexpr int PER = 256 + 2 * NFR * 64; for (int i = c.gt; i < NL * S5G * PER; i += c.NGT) build_item(c, i / (PER * S5G), (i / PER) % S5G, i % PER); }
__device__ __forceinline__ void setup(const Ctx& c, int l, int g) { const u32x4* src = (const u32x4*)(c.ws + WS_S5T + (size_t)(l * S5G + g) * S5T_BYTES);
    for (int i = c.tid; i < OFF_IMG / 16; i += NT) *(LAS u32x4*)(c.lds + i * 16) = src[i]; }
__device__ __forceinline__ bf16x8 frag(const Ctx& c, int dir, int fr) { return *(const LAS bf16x8*)(c.lds + OFF_FR + ((size_t)(dir * NFR + fr) * 64 + c.lane) * 16); }
__device__ __forceinline__ cx cnst(const Ctx& c, int dir, int sp, int q) { const LAS float* p = (const LAS float*)(c.lds + OFF_CN) + ((size_t)((dir * 2 + sp) * NCN + q) * 64 + c.lane) * 2; return cx{p[0], p[1]}; }
constexpr int NCTX5 = TC / 64;
__device__ __forceinline__ int rowbase(int b, int nc) { return nc < NCTX5 ? MLAT + b * TC + nc * 64 : b * T + (nc - NCTX5) * 64; }
__device__ __forceinline__ int pchunk(int dir, int nc) { return dir == 0 ? nc : (nc < NCTX5 ? NCTX5 - 1 - nc : NCTX5 + (NCH5 - NCTX5 - 1) - (nc - NCTX5)); }
__device__ __forceinline__ void proj_scale(const Ctx& c, int dir, int sp, const bf16x8 (&ua)[2], f32x16 (&xr)[2], f32x16 (&xi)[2]) {
    const bf16x8 Bre = frag(c, dir, 2 * sp), Bim = frag(c, dir, 2 * sp + 1); const f32x16 z16 = f32x16{};
#pragma unroll
    for (int m = 0; m < 2; ++m) { xr[m] = __builtin_amdgcn_mfma_f32_32x32x16_bf16(ua[m], Bre, z16, 0, 0, 0); xi[m] = __builtin_amdgcn_mfma_f32_32x32x16_bf16(ua[m], Bim, z16, 0, 0, 0); }
    const cx s1 = cnst(c, dir, sp, 2), s8 = cnst(c, dir, sp, 3);
#pragma unroll
    for (int m = 0; m < 2; ++m) { cx pq = cnst(c, dir, sp, m);
#pragma unroll
        for (int q = 0; q < 4; ++q) { cx p = pq;
#pragma unroll
            for (int i = 0; i < 4; ++i) { const int r = 4 * q + i; const float vr = xr[m][r], vi = xi[m][r]; xr[m][r] = p.r * vr - p.i * vi; xi[m][r] = p.r * vi + p.i * vr; p = cmul(p, s1); }
            pq = cmul(pq, s8); } }
}
__device__ __forceinline__ float half_swap_add(float v) { const unsigned u = __builtin_bit_cast(unsigned, v); auto rr = __builtin_amdgcn_permlane32_swap(u, u, false, false); const unsigned r0 = rr[0], r1 = rr[1]; return __builtin_bit_cast(float, r0) + __builtin_bit_cast(float, r1); }
__device__ __forceinline__ void load_u(const Ctx& c, int g, int rb, bf16x8 (&ua)[2]) {
    const bf16* P = (const bf16*)(c.ws + WS_BIG + BIG_P); const int r32 = c.lane & 31, hi = c.lane >> 5;
#pragma unroll
    for (int m = 0; m < 2; ++m) ua[m] = *(const bf16x8*)(P + (size_t)(rb + 32 * m + r32) * INC + PC_S5 + g * 16 + 8 * hi);
}
#ifndef S5DBG_DIRMASK
#define S5DBG_DIRMASK 3
#define S5DBG_SKIP 1
#define S5DBG_GELU 1
#endif
template <bool PASS_B, int dir> __device__ __forceinline__ void dir_body(const Ctx& c, int g, int b, int nc, float* E, const bf16x8 (&ua)[2], f32x16 (&yacc)[2]) {
    const int r32 = c.lane & 31, hi = c.lane >> 5; const int pc = pchunk(dir, nc); if (PASS_B && !((S5DBG_DIRMASK >> dir) & 1)) return;
                float* e = E + ((((size_t)(b * S5G + g) * 2 + dir) * NCH5 + pc) * 64) * 2;
                bf16x8 Lt0, Lt1, Lon;
                if (PASS_B) {
#pragma unroll
                    for (int j = 0; j < 8; ++j) { const int k0 = 8 * (j >> 2) + 4 * hi + (j & 3), k1 = 16 + k0; const short one = (short)0x3F80;
                        Lt0[j] = ((dir == 0) ? (k0 <= r32) : (k0 >= r32)) ? one : (short)0; Lt1[j] = ((dir == 0) ? (k1 <= r32) : (k1 >= r32)) ? one : (short)0; Lon[j] = one; } }
#pragma unroll 1
                for (int sp = 0; sp < 2; ++sp) {
                    f32x16 xr[2], xi[2]; proj_scale(c, dir, sp, ua, xr, xi);
                    if (!PASS_B) { float sr = 0.f, si = 0.f;
#pragma unroll
                        for (int m = 0; m < 2; ++m)
#pragma unroll
                            for (int r = 0; r < 16; ++r) { sr += xr[m][r]; si += xi[m][r]; }
#ifdef S5DBG_PRINT
                        if (g == 0 && b == 0 && nc == 0 && (c.lane & 31) == 0 && dir == 0 && sp == 0) printf("pre-swap lane %d: %g %g\n", c.lane, sr, si);
#endif
                        sr = half_swap_add(sr); si = half_swap_add(si); const cx a63 = cnst(c, dir, sp, 9);
#ifdef S5DBG_PRINT
                        if (g == 0 && b == 0 && nc == 0 && c.lane < 2) printf("passA dir %d sp %d lane %d: sum %g %g a63 %g %g x0 %g %g x1 %g %g\n", dir, sp, c.lane, sr, si, a63.r, a63.i, xr[0][0], xi[0][0], xr[0][1], xi[0][1]);
#endif
                        if (hi == 0) { e[(32 * sp + r32) * 2] = a63.r * sr - a63.i * si; e[(32 * sp + r32) * 2 + 1] = a63.r * si + a63.i * sr; }
                    } else {
                        bf16x8 xb[2][2][2];
#pragma unroll
                        for (int m = 0; m < 2; ++m)
#pragma unroll
                            for (int sk = 0; sk < 2; ++sk) { u32x4 wr, wi;
#pragma unroll
                                for (int q = 0; q < 4; ++q) { wr[q] = cvtpk_s(xr[m][8 * sk + 2 * q], xr[m][8 * sk + 2 * q + 1]); wi[q] = cvtpk_s(xi[m][8 * sk + 2 * q], xi[m][8 * sk + 2 * q + 1]); }
                                xb[m][0][sk] = __builtin_bit_cast(bf16x8, wr); xb[m][1][sk] = __builtin_bit_cast(bf16x8, wi); }
                        constexpr int mf = dir == 0 ? 0 : 1, ml = 1 - mf;
                        f32x16 cs[2][2]; const f32x16 z16 = f32x16{};
#pragma unroll
                        for (int nn = 0; nn < 2; ++nn) {
                            cs[mf][nn] = __builtin_amdgcn_mfma_f32_32x32x16_bf16(Lt0, xb[mf][nn][0], z16, 0, 0, 0); cs[mf][nn] = __builtin_amdgcn_mfma_f32_32x32x16_bf16(Lt1, xb[mf][nn][1], cs[mf][nn], 0, 0, 0);
                            cs[ml][nn] = __builtin_amdgcn_mfma_f32_32x32x16_bf16(Lon, xb[mf][nn][0], z16, 0, 0, 0); cs[ml][nn] = __builtin_amdgcn_mfma_f32_32x32x16_bf16(Lon, xb[mf][nn][1], cs[ml][nn], 0, 0, 0);
                            cs[ml][nn] = __builtin_amdgcn_mfma_f32_32x32x16_bf16(Lt0, xb[ml][nn][0], cs[ml][nn], 0, 0, 0); cs[ml][nn] = __builtin_amdgcn_mfma_f32_32x32x16_bf16(Lt1, xb[ml][nn][1], cs[ml][nn], 0, 0, 0); }
                        const cx hin{e[(32 * sp + r32) * 2], e[(32 * sp + r32) * 2 + 1]}; const cx gi_ = cmul(cnst(c, dir, sp, 8), hin);
                        const cx s1 = cnst(c, dir, sp, 6), s8 = cnst(c, dir, sp, 7);
                        LAS unsigned char* img = c.lds + OFF_IMG + c.wave * IMG_W;
#pragma unroll
                        for (int m = 0; m < 2; ++m) { cx pq = cnst(c, dir, sp, 4 + m);
#pragma unroll
                            for (int q = 0; q < 4; ++q) { cx p = pq; float or_[4], oi_[4];
#pragma unroll
                                for (int i = 0; i < 4; ++i) { const int r = 4 * q + i; const float vr = cs[m][0][r] + gi_.r, vi = cs[m][1][r] + gi_.i; or_[i] = p.r * vr - p.i * vi; oi_[i] = p.r * vi + p.i * vr; p = cmul(p, s1); }
                                pq = cmul(pq, s8);
                                u32x2 wr, wi; wr.x = cvtpk_s(or_[0], or_[1]); wr.y = cvtpk_s(or_[2], or_[3]); wi.x = cvtpk_s(oi_[0], oi_[1]); wi.y = cvtpk_s(oi_[2], oi_[3]);
                                *(LAS u32x2*)(img + (m * 2 + 0) * 2048 + r32 * 64 + 8 * (2 * q + hi)) = wr; *(LAS u32x2*)(img + (m * 2 + 1) * 2048 + r32 * 64 + 8 * (2 * q + hi)) = wi; } }
                        WAVE_SYNC();
                        const int i16 = c.lane & 15, qq = i16 >> 2, pp = i16 & 3, blk = (c.lane >> 4) & 1;
#pragma unroll
                        for (int m = 0; m < 2; ++m)
#pragma unroll
                            for (int nn = 0; nn < 2; ++nn)
#pragma unroll
                                for (int sk = 0; sk < 2; ++sk) { const lds_cptr tb = (lds_cptr)(img + (m * 2 + nn) * 2048);
                                    const s16x4 lo = vtr(tb + (16 * sk + 8 * hi + qq) * 64 + 8 * (4 * blk + pp)), hi4 = vtr(tb + (16 * sk + 8 * hi + 4 + qq) * 64 + 8 * (4 * blk + pp));
                                    const bf16x8 xa = (bf16x8){lo[0], lo[1], lo[2], lo[3], hi4[0], hi4[1], hi4[2], hi4[3]};
                                    yacc[m] = __builtin_amdgcn_mfma_f32_32x32x16_bf16(xa, frag(c, dir, 4 + 2 * (2 * sp + nn) + sk), yacc[m], 0, 0, 0); }
                        WAVE_SYNC();
                    }
                }
}
template <bool PASS_B> __device__ __forceinline__ void run(const Ctx& c, int l, int mrows, int nblk = 0) {
    float* E = (float*)(c.ws + WS_S5E); bf16* Y = (bf16*)(c.ws + WS_Y);
    const int r32 = c.lane & 31, hi = c.lane >> 5;
    const int GG = nblk ? nblk : c.G; if (c.bx >= GG) return;
    const int gstep = GG < S5G ? GG : S5G, nbg = GG < S5G ? 1 : GG / S5G, jb = c.bx / S5G;
    if (GG >= S5G && jb >= nbg) return;
    for (int g = c.bx % S5G; g < S5G; g += gstep) {
        __syncthreads(); setup(c, l, g); __syncthreads();
        const bool skip_ctx = PASS_B && mrows <= MLAT;
        const int ncl = skip_ctx ? NCH5 - NCTX5 : NCH5, nc0 = skip_ctx ? NCTX5 : 0;
        const int nw = 8 * nbg, w0 = jb * 8 + c.wave, nitems = NB * ncl;
        for (int it = w0; it < nitems; it += nw) { const int nc = nc0 + it % ncl, b = it / ncl; const int rb = rowbase(b, nc);
            bf16x8 ua[2]; load_u(c, g, rb, ua);
            f32x16 yacc[2]; yacc[0] = f32x16{}; yacc[1] = f32x16{};
            dir_body<PASS_B, 0>(c, g, b, nc, E, ua, yacc); dir_body<PASS_B, 1>(c, g, b, nc, E, ua, yacc);
            if (PASS_B) {
                const float dv = c.in(I_S5D)[(size_t)l * GWD + g * 16 + (r32 & 15)]; bf16x8 Bd;
#pragma unroll
                for (int j = 0; j < 8; ++j) Bd[j] = (r32 < 16 && 8 * hi + j == r32) ? (short)f2bf(dv) : (short)0;
#pragma unroll
                for (int m = 0; m < 2; ++m) { if (S5DBG_SKIP) yacc[m] = __builtin_amdgcn_mfma_f32_32x32x16_bf16(ua[m], Bd, yacc[m], 0, 0, 0);
                    if (r32 < 16) {
#pragma unroll
                        for (int r = 0; r < 16; ++r) Y[(size_t)(rb + 32 * m + crow(r, hi)) * DM + g * 16 + r32] = (bf16)f2bf(S5DBG_GELU ? geluf_(yacc[m][r]) : yacc[m][r]); } }
            }
        }
    }
    __syncthreads();
}
}

namespace lrum {
#ifdef HOST_EMU
__device__ __forceinline__ float fast_sqrtf(float x) { return sqrtf(x); }
#else
__device__ __forceinline__ float fast_sqrtf(float x) { return __builtin_amdgcn_sqrtf(x); }
#endif
using attn_body::bf16x8; using attn_body::f32x16; using attn_body::cvtpk_s;
#ifdef HOST_EMU
using attn_body::emu_permlane32_swap;
#endif
constexpr int XROW = GWD * 2 + 16;
static_assert(32 * XROW <= 131072 && GWD == 4 * 64 && LL == 32, "LRU MFMA geometry: 8 waves = 4 channel blocks x 2 halves");
__device__ __forceinline__ float partner(float v, int hi) { const unsigned u = __builtin_bit_cast(unsigned, v); auto rr = __builtin_amdgcn_permlane32_swap(u, u, false, false); const unsigned r0 = rr[0], r1 = rr[1]; return __builtin_bit_cast(float, hi ? r0 : r1); }
__device__ __forceinline__ void decay(float la, float& a, float& sq) { a = __builtin_amdgcn_exp2f(1.4426950408889634f * la); const float x2 = 2.f * la;
    const float big = 1.f - a * a, small = -x2 * (1.f + x2 * (0.5f + x2 * (0.16666667f + x2 * 0.041666668f))); sq = fast_sqrtf(x2 > -0.1f ? small : big); }
template <bool PASS_B> __device__ __forceinline__ void run(const Ctx& c, int l, bool need_ctx, int blk0 = 0) {
    const bf16* P = (const bf16*)(c.ws + WS_BIG + BIG_P); float* E = (float*)(c.ws + WS_LRUE); bf16* Y = (bf16*)(c.ws + WS_Y);
    LAS unsigned char* XC = c.lds;
    const int r32 = c.lane & 31, hi = c.lane >> 5, blk = c.wave >> 1, half = c.wave & 1, e = blk * 64 + half * 32 + r32;
    bf16x8 Wa[2][4], Wx[2][4]; float ba[2], bx[2], sp[2];
    { const bf16x8* lw = (const bf16x8*)(c.ws + WS_LRUW);
#pragma unroll
      for (int dir = 0; dir < 2; ++dir) {
#pragma unroll
        for (int ks = 0; ks < 4; ++ks) { Wa[dir][ks] = lw[((((size_t)((l * 2 + dir) * 2 + 0) * NH + blk) * 2 + half) * 4 + ks) * 64 + c.lane]; Wx[dir][ks] = lw[((((size_t)((l * 2 + dir) * 2 + 1) * NH + blk) * 2 + half) * 4 + ks) * 64 + c.lane]; }
        ba[dir] = c.in(I_LBA)[(size_t)(l * 2 + dir) * GWD + e]; bx[dir] = c.in(I_LBX)[(size_t)(l * 2 + dir) * GWD + e]; sp[dir] = softplusf_(-c.in(I_LLAM)[(size_t)(l * 2 + dir) * GWD + e]); } }
    bf16x8 I0, I1;
#pragma unroll
    for (int j = 0; j < 8; ++j) { I0[j] = (8 * hi + j == r32) ? (short)0x3F80 : (short)0; I1[j] = (16 + 8 * hi + j == r32) ? (short)0x3F80 : (short)0; }
    const bool skip_ctx = PASS_B && !need_ctx;
    const int ntl = skip_ctx ? NTL - NCT : NTL, tl0 = skip_ctx ? NCT : 0; const int nitems = NB * ntl;
    if (c.bx < blk0) return;
    for (int it = c.G - 1 - c.bx; it < nitems; it += c.G - blk0) { const int tile = tl0 + it % ntl, b = it / ntl; const bool is_ctx = tile < NCT;
        const int row0 = lru_tile_row0(b, tile); const int t0 = (is_ctx ? tile : tile - NCT) * LL, tlen = is_ctx ? TC : T; const int seq0 = row0 - t0;
        __syncthreads();
        for (int i = c.tid; i < LL * GWD / 8; i += NT) { const int t = i / (GWD / 8), ch = (i % (GWD / 8)) * 8; float acc8[8];
            { const f32x4 b0 = *(const f32x4*)(c.in(I_LCB) + (size_t)l * GWD + ch), b1 = *(const f32x4*)(c.in(I_LCB) + (size_t)l * GWD + ch + 4);
#pragma unroll
              for (int j = 0; j < 4; ++j) { acc8[j] = b0[j]; acc8[4 + j] = b1[j]; } }
#pragma unroll
            for (int k = 0; k < 4; ++k) { const int tt = t0 + t + k - 2; if (tt >= 0 && tt < tlen) { float xv8[8]; ld8bf(P + (size_t)(seq0 + tt) * INC + PC_LX + ch, xv8);
                const f32x4 w0 = *(const f32x4*)(c.in(I_LCW) + ((size_t)l * 4 + k) * GWD + ch), w1 = *(const f32x4*)(c.in(I_LCW) + ((size_t)l * 4 + k) * GWD + ch + 4);
#pragma unroll
                for (int j = 0; j < 4; ++j) { acc8[j] += w0[j] * xv8[j]; acc8[4 + j] += w1[j] * xv8[4 + j]; } } }
            u32x4 o; o.x = pk2(acc8[0], acc8[1]); o.y = pk2(acc8[2], acc8[3]); o.z = pk2(acc8[4], acc8[5]); o.w = pk2(acc8[6], acc8[7]); *(LAS u32x4*)(XC + t * XROW + ch * 2) = o; }
        __syncthreads();
        bf16x8 A[4];
#pragma unroll
        for (int ks = 0; ks < 4; ++ks) A[ks] = *(const LAS bf16x8*)(XC + r32 * XROW + (blk * 64 + 16 * ks + 8 * hi) * 2);
        const bf16x8 Ax0 = *(const LAS bf16x8*)(XC + r32 * XROW + (blk * 64 + half * 32 + 8 * hi) * 2), Ax1 = *(const LAS bf16x8*)(XC + r32 * XROW + (blk * 64 + half * 32 + 16 + 8 * hi) * 2);
        const f32x16 z16 = f32x16{};
        f32x16 xv = __builtin_amdgcn_mfma_f32_32x32x16_bf16(Ax0, I0, z16, 0, 0, 0); xv = __builtin_amdgcn_mfma_f32_32x32x16_bf16(Ax1, I1, xv, 0, 0, 0);
        f32x16 av[2], bv[2];
#pragma unroll
        for (int dir = 0; dir < 2; ++dir) { f32x16 r = z16, g = z16;
#pragma unroll
            for (int ks = 0; ks < 4; ++ks) { r = __builtin_amdgcn_mfma_f32_32x32x16_bf16(A[ks], Wa[dir][ks], r, 0, 0, 0); g = __builtin_amdgcn_mfma_f32_32x32x16_bf16(A[ks], Wx[dir][ks], g, 0, 0, 0); }
#pragma unroll
            for (int k = 0; k < 16; ++k) { const float rr = sigmoidf_(r[k] + ba[dir]), ii = sigmoidf_(g[k] + bx[dir]); float a, sq; decay(-8.f * rr * sp[dir], a, sq); av[dir][k] = a; bv[dir][k] = sq * (ii * xv[k]); } }
        float hf[16], hb[16];
        { float RA[4], RB[4], PA[4], PB[4], st[4];
#pragma unroll
          for (int q = 0; q < 4; ++q) { float Aq = 1.f, Bq = 0.f;
#pragma unroll
              for (int i = 0; i < 4; ++i) { Bq = av[0][4 * q + i] * Bq + bv[0][4 * q + i]; Aq *= av[0][4 * q + i]; }
              RA[q] = Aq; RB[q] = Bq; PA[q] = partner(Aq, hi); PB[q] = partner(Bq, hi); }
          float* eo = E + (((size_t)(b * 2 + 0) * NTL + tile) * GWD + e) * 2;
          float sst = PASS_B ? eo[1] : 0.f, tot = 1.f;
#pragma unroll
          for (int q = 0; q < 4; ++q) { const float fA = hi ? PA[q] : RA[q], fB = hi ? PB[q] : RB[q], sA = hi ? RA[q] : PA[q], sB = hi ? RB[q] : PB[q];
              const float mid = fA * sst + fB; st[q] = hi ? mid : sst; sst = sA * mid + sB; tot *= fA * sA; }
          if (!PASS_B) { if (hi == 0) { eo[0] = tot; eo[1] = sst; } }
          else {
#pragma unroll
              for (int q = 0; q < 4; ++q) { float h = st[q];
#pragma unroll
                  for (int i = 0; i < 4; ++i) { h = av[0][4 * q + i] * h + bv[0][4 * q + i]; hf[4 * q + i] = h; } } } }
        { float RA[4], RB[4], PA[4], PB[4], st[4];
#pragma unroll
          for (int q = 0; q < 4; ++q) { float Aq = 1.f, Bq = 0.f;
#pragma unroll
              for (int i = 3; i >= 0; --i) { Bq = av[1][4 * q + i] * Bq + bv[1][4 * q + i]; Aq *= av[1][4 * q + i]; }
              RA[q] = Aq; RB[q] = Bq; PA[q] = partner(Aq, hi); PB[q] = partner(Bq, hi); }
          float* eo = E + (((size_t)(b * 2 + 1) * NTL + tile) * GWD + e) * 2;
          float sst = PASS_B ? eo[1] : 0.f, tot = 1.f;
#pragma unroll
          for (int q = 3; q >= 0; --q) { const float fA = hi ? RA[q] : PA[q], fB = hi ? RB[q] : PB[q], sA = hi ? PA[q] : RA[q], sB = hi ? PB[q] : RB[q];
              const float mid = fA * sst + fB; st[q] = hi ? sst : mid; sst = sA * mid + sB; tot *= fA * sA; }
          if (!PASS_B) { if (hi == 0) { eo[0] = tot; eo[1] = sst; } }
          else {
#pragma unroll
              for (int q = 0; q < 4; ++q) { float h = st[q];
#pragma unroll
                  for (int i = 3; i >= 0; --i) { h = av[1][4 * q + i] * h + bv[1][4 * q + i]; hb[4 * q + i] = h; } } } }
        if (PASS_B && (!is_ctx || need_ctx)) {
#pragma unroll
            for (int k = 0; k < 16; ++k) { const int row = row0 + 8 * (k >> 2) + 4 * hi + (k & 3); const float gt = bf2f(P[(size_t)row * INC + PC_LG + e]);
                Y[(size_t)row * DM + 3 * GWD + e] = (bf16)f2bf((hf[k] + hb[k]) * geluf_(gt)); } }
    }
    __syncthreads();
}
}

#ifndef USE_FLASH_GQA
#define USE_FLASH_GQA 1
#endif
__device__ __forceinline__ void gqa_flash_unit(const Ctx& c, int l, int u) {
    const bf16* P = (const bf16*)(c.ws + WS_BIG + BIG_P); const bf16* KN = (const bf16*)(c.ws + WS_BIG + BIG_KN); bf16* Y = (bf16*)(c.ws + WS_Y);
    constexpr int NQB = T / 256, NLU = NB * NH * NQB, NCQ = TC / 256; int b, h, qrow0, ntk;
    if (u < NLU) { b = u / (NH * NQB); h = (u / NQB) % NH; qrow0 = b * T + (u % NQB) * 256; ntk = (TC + T) / 64; }
    else { const int v = u - NLU; b = v / (NH * NCQ); h = (v / NCQ) % NH; qrow0 = MLAT + b * TC + (v % NCQ) * 256; ntk = TC / 64; }
    const size_t kb = (size_t)(b * NKV + h / GQG) * (TC + T) * 64;
    attn_body::GqaHook H; H.ctx_off = (long)(MLAT + b * TC) * INC; H.lat_off = (long)b * T * INC; H.gq = c.in(I_GQN) + l * 64; H.rope = (const float*)(c.ws + WS_ROPE); H.t0 = u < NLU ? (u % NQB) * 256 : -1;
    attn_body::attn_unit<8, attn_body::GqaHook>(P + (size_t)qrow0 * INC + PC_GQ + h * 64, KN + kb, P + PC_GV + (h / GQG) * 64, Y + (size_t)qrow0 * DM + 2 * GWD + h * 64, ntk, (LAS char*)c.lds, H);
}
__device__ __forceinline__ void ph_gqa_flash(const Ctx& c, int l, bool need_ctx) {
    constexpr int NQB = T / 256, NLU = NB * NH * NQB, NCQ = TC / 256, NCU = NB * NH * NCQ; static_assert(T % 256 == 0 && TC % 256 == 0 && ((TC + T) / 64) % 2 == 0 && TC / 64 >= 4 && (TC / 64) % 2 == 0, "attention unit geometry");
    const int nctx = need_ctx ? NCU : 0;
    const int vcu = (c.G % 8 == 0) ? (c.bx % 8) * (c.G / 8) + c.bx / 8 : c.bx;
    __syncthreads();
    for (int u = vcu; u < NLU; u += c.G) gqa_flash_unit(c, l, u);
    for (int cv = (vcu + c.G - c.G / 2) % c.G; cv < nctx; cv += c.G) gqa_flash_unit(c, l, NLU + cv);
}

#ifndef USE_NA_FLASHBODY
#define USE_NA_FLASHBODY 1
#endif
__device__ __forceinline__ void ph_na_flash(const Ctx& c, int l, bool need_ctx) {
    static_assert(GW == 64 && NROWS % 4 == 0 && NROWS >= 8 && TC == 256, "NA unit geometry");
    const bf16* P = (const bf16*)(c.ws + WS_BIG + BIG_P); bf16* Y = (bf16*)(c.ws + WS_Y);
    const float* rpb = c.in(I_RPB) + (size_t)l * NH * 15 * 31;
    constexpr int NRQ = NROWS / 4, NLU = NB * NH * NRQ, NCU = NB * NH;
    const int nunits = NLU + (need_ctx ? NCU : 0);
    const int vcu = (c.G % 8 == 0) ? (c.bx % 8) * (c.G / 8) + c.bx / 8 : c.bx;
    LAS float* tbl = (LAS float*)(c.lds + attn_body::LDS_RPB); const int r32 = c.lane & 31, hi = c.lane >> 5;
    __syncthreads();
    for (int u = vcu; u < nunits; u += c.G) { const bool is_ctx = u >= NLU; int b, h, r0;
        if (!is_ctx) { b = u / (NH * NRQ); h = (u / NRQ) % NH; r0 = (u % NRQ) * 4; } else { const int v = u - NLU; b = v / NH; h = v % NH; r0 = 0; }
        attn_body::NaHook H;
        int rs0 = r0 - 4; rs0 = rs0 < 0 ? 0 : (rs0 > NROWS - 8 ? NROWS - 8 : rs0); int rs3 = r0 + 3 - 4; rs3 = rs3 < 0 ? 0 : (rs3 > NROWS - 8 ? NROWS - 8 : rs3);
        H.krlo = __builtin_amdgcn_readfirstlane(rs0); H.nwin = __builtin_amdgcn_readfirstlane(is_ctx ? 0 : rs3 + 8 - rs0); H.qrow = __builtin_amdgcn_readfirstlane(r0 + (c.wave >> 1)); const int qc = (c.wave & 1) * 32 + r32;
        int rsq = H.qrow - 4; rsq = rsq < 0 ? 0 : (rsq > NROWS - 8 ? NROWS - 8 : rsq); H.rsq = __builtin_amdgcn_readfirstlane(rsq); int csq = qc - 8; csq = csq < 0 ? 0 : (csq > GW - 16 ? GW - 16 : csq);
        H.pk = ((4 * hi - csq) & 0xffff) | ((attn_body::NA_PAD + 4 * hi - qc + 15) << 16); H.tbl = tbl;
        { const float* rh = rpb + (size_t)h * 15 * 31;
            for (int i = is_ctx ? 15 * attn_body::NA_TS + c.tid : c.tid; i < 17 * attn_body::NA_TS; i += NT) { const int jj = i % attn_body::NA_TS, j = jj - attn_body::NA_PAD, rr = i / attn_body::NA_TS;
                tbl[i] = rr == 16 ? ((jj >= 64 && jj < 80) ? 0.f : -INFINITY) : ((rr > 14 || j < 0 || j > 30) ? 0.f : rh[rr * 31 + j] * 1.4426950408889634f); } }
        const int nt0 = TC / 64 + H.nwin, ntk = nt0 + (nt0 & 1);
        const size_t row0 = is_ctx ? (size_t)(MLAT + b * TC) : (size_t)(b * T + r0 * GW); H.ctx_off = (long)(MLAT + b * TC) * INC; H.lat_off = (long)b * T * INC;
        attn_body::attn_unit<8, attn_body::NaHook>(P + row0 * INC + PC_NAQ + h * 64, P + PC_NAK + h * 64, P + PC_NAV + h * 64, Y + row0 * DM + GWD + h * 64, ntk, (LAS char*)c.lds, H); }
}

#ifndef USE_MFMA_NA
#define USE_MFMA_NA 1
#endif
__device__ __forceinline__ void ph_na_mfma(const Ctx& c, int l, bool need_ctx) {
    static_assert(GW == 64 && NROWS % 4 == 0 && NROWS >= 8 && TC % 256 == 0, "NA unit geometry");
    const bf16* P = (const bf16*)(c.ws + WS_BIG + BIG_P); bf16* Y = (bf16*)(c.ws + WS_Y); const float* rpb = c.in(I_RPB) + (size_t)l * NH * 15 * 31;
    constexpr int NRQ = NROWS / 4, NLU = NB * NH * NRQ, NCQ = TC / 256, NCU = NB * NH * NCQ;
    const int nunits = NLU + (need_ctx ? NCU : 0);
    const int vcu = (c.G % 8 == 0) ? (c.bx % 8) * (c.G / 8) + c.bx / 8 : c.bx;
    __syncthreads();
    for (int u = vcu; u < nunits; u += c.G) {
        if (u < NLU) { const int b = u / (NH * NRQ), h = (u / NRQ) % NH, r0 = (u % NRQ) * 4;
            attn_body::na_unit(P, (const bf16*)(c.ws + WS_XN), rpb + (size_t)h * 15 * 31, b, h, r0, false, Y + (size_t)(b * T + r0 * GW) * DM + GWD + h * 64, (LAS char*)c.lds); }
        else { const int v = u - NLU; const int b = v / (NH * NCQ), h = (v / NCQ) % NH;
            attn_body::na_unit(P, (const bf16*)(c.ws + WS_XN), rpb, b, h, 0, true, Y + (size_t)(MLAT + b * TC + (v % NCQ) * 256) * DM + GWD + h * 64, (LAS char*)c.lds); }
    }
}

#ifndef PROBE_MASK
#define PROBE_MASK 0
#endif
#define RUNP(bit, call) do { call; if (PROBE_MASK & (1 << (bit))) { __syncthreads(); call; } } while (0)
#ifndef USE_MFMA_LRU
#define USE_MFMA_LRU 1
#endif
#if USE_MFMA_LRU
#define LRU_RUN(B) lrum::run<B>(c, l, need_ctx)
#define LRU_RUN_FROM(B, b0) lrum::run<B>(c, l, need_ctx, (b0))
#else
#define LRU_RUN(B) ph_lru<B>(c, l, need_ctx)
#endif
#ifndef S5B_SHARE_16THS
#define S5B_SHARE_16THS 0
#endif
__device__ __forceinline__ int s5b_blocks(int G) { return (S5B_SHARE_16THS > 0 && G >= 64 && G % S5G == 0) ? (G / S5G) * S5B_SHARE_16THS : 0; }
constexpr int PH_INIT = 0, PH_MODS = 1, PH_L0 = 2, NPL = 13, PH_FINAL = PH_L0 + NL * NPL, N_PHASES = PH_FINAL + 1;
template <int ph> __device__ __forceinline__ void run_phase(const Ctx& c) {
    if (ph == PH_INIT) { RUNP(0, ph_ada_partial(c)); RUNP(1, ph_cvt_all(c)); ph_tables(c); s5m::build_all(c); return; }
    if (ph == PH_MODS) { ph_mods_reduce(c); return; }
    if (ph == PH_FINAL) { ph_norm_final(c); return; }
    constexpr int l = (ph - PH_L0) / NPL, s = (ph - PH_L0) % NPL; constexpr bool need_ctx = l < NL - 1; constexpr int mrows2 = need_ctx ? M : MLAT;
    bf16* PARTY = (bf16*)(c.ws + WS_Y); bf16* PARTB = (bf16*)(c.ws + WS_BIG);
    static_assert((size_t)(DFF / 256) * MCTX * DM * 4 <= Y_BYTES && (size_t)(DM / 256) * MCTX * DM * 4 <= BIG_BYTES && DFF % 256 == 0, "slab regions");
    bf16* XN = (bf16*)(c.ws + WS_XN); bf16* G = (bf16*)(c.ws + WS_BIG); bf16* Pb = (bf16*)(c.ws + WS_BIG + BIG_P); bf16* Y = (bf16*)(c.ws + WS_Y);
    switch (s) {
    case 0: ph_norm_mod(c, l, c.in(I_GFFN1) + (size_t)l * DM, 0, 1, M, l > 0 ? Pending{PARTY, DFF / 256, l - 1, 8, 0.5f} : Pending{nullptr, 0, 0, 0, 0.f}, l == 0 ? 1 : 0); break;
    case 1: { EpiSwiglu E{G}; RUNP(10, gemm_run_swiglu(c, XN, c.wl(l, W_1I), M, DM, E)); } break;
    case 2: gemm_resid_all<l == 0>(c, G, c.wl(l, W_1O), DM, DFF, l, 2, 0.5f, true, PARTY, c.in(I_X)); break;
    case 3: ph_norm_mod(c, l, c.in(I_GMIX) + (size_t)l * DM, 3, 4, M, Pending{PARTY, DFF / 256, l, 2, 0.5f}, l == 0 ? 2 : 0); break;
    case 4: { EpiP E{Pb}; RUNP(11, gemm_run(c, XN, c.wl(l, W_IN), M, INC, DM, E)); } break;
#ifndef USE_MFMA_S5
#define USE_MFMA_S5 1
#endif
    case 5:
#if USE_MFMA_S5 && !defined(S5DBG_OLD_A)
        RUNP(3, s5m::run<false>(c, l, M));
#else
        RUNP(3, ph_s5_a(c, l));
#endif
        RUNP(4, LRU_RUN(false)); RUNP(5, ph_gqa_prep(c, l)); break;
    case 6: ph_carries(c, l);
#if USE_MFMA_NA
#if USE_NA_FLASHBODY
        RUNP(6, ph_na_flash(c, l, need_ctx));
#else
        RUNP(6, ph_na_mfma(c, l, need_ctx));
#endif
#else
        ph_na_naive(c, l, need_ctx);
#endif
#if USE_FLASH_GQA
        RUNP(7, ph_gqa_flash(c, l, need_ctx));
#else
        ph_gqa_naive(c, need_ctx);
#endif
        break;
    case 7: { const int sb = s5b_blocks(c.G); RUNP(3, s5m::run<true>(c, l, mrows2, sb)); RUNP(4, LRU_RUN_FROM(true, sb)); } break;
    case 8: { EpiGlu E{Y}; pg8::Gemm g{Y, c.wl(l, W_GLU), mrows2, GWD, GWD, DM, GWD}; pg8::StaticOrder S; S.init(mrows2, GWD, c.G, c.bx); PgEpi<EpiGlu> PE{E};
              pg8::gemm_phase<PgEpi<EpiGlu>, pg8::StaticOrder, true, true>(c.lds, g, S, PE); } break;
    case 9: gemm_resid_all(c, Y, c.wl(l, W_OUT), DM, DM, l, 5, 1.0f, need_ctx, PARTB); break;
    case 10: ph_norm_mod(c, l, c.in(I_GFFN2) + (size_t)l * DM, 6, 7, mrows2, need_ctx ? Pending{PARTB, DM / 256, l, 5, 1.0f} : Pending{nullptr, 0, 0, 0, 0.f}); break;
    case 11: { EpiSwiglu E{G}; gemm_run_swiglu(c, XN, c.wl(l, W_2I), mrows2, DM, E); } break;
    case 12: gemm_resid_all<false, l == NL - 1>(c, G, c.wl(l, W_2O), DM, DFF, l, 8, 0.5f, need_ctx, PARTY); break;
    }
}

#ifndef HOST_EMU
#define XB_TMO      128
#define XB_XCNT(j)  (256  + 64 * (j))
#define XB_XSUB(j)  (1280 + 64 * (j))
#define XB_XGEN(j)  (2304 + 64 * (j))
#define XB_TOP      3328
#define XB_TOPGEN   3392
#define XCD_BAR_WORDS 3456
#define XB_SPIN_CAP (1u << 22)
__device__ __forceinline__ unsigned xb_ld(unsigned* p)              { return __hip_atomic_load(p, __ATOMIC_RELAXED, __HIP_MEMORY_SCOPE_AGENT); }
__device__ __forceinline__ unsigned xb_add(unsigned* p, unsigned v) { return __hip_atomic_fetch_add(p, v, __ATOMIC_RELAXED, __HIP_MEMORY_SCOPE_AGENT); }
__device__ __forceinline__ unsigned xb_xcc_id() { return (unsigned)__builtin_amdgcn_s_getreg((3 << 11) | 20) & 0xFu; }
#define XB_SPIN(cond, bar) do { unsigned _sp = 0; while (cond) { __builtin_amdgcn_s_sleep(1); \
    if ((++_sp & 255u) == 0u) { if (xb_ld(&(bar)[XB_TMO])) break; if (_sp > XB_SPIN_CAP) { atomicAdd(&(bar)[XB_TMO], 1u); break; } } } } while (0)
struct XcdBarrier { unsigned* bar; unsigned x; volatile LAS unsigned* st; };
__device__ __forceinline__ XcdBarrier xcd_barrier_post(unsigned* bar, volatile LAS unsigned* st) {
    XcdBarrier b; b.bar = bar; b.x = xb_xcc_id(); b.st = st;
    if (threadIdx.x == 0) (void)xb_add(&bar[XB_XCNT(b.x)], 1u);
    return b;
}
__device__ __forceinline__ void xcd_barrier_complete(unsigned* bar, unsigned x, unsigned& nloc, unsigned& nx) {
    const unsigned G = gridDim.x * gridDim.y * gridDim.z;
    unsigned sum, cnt, mine, sp = 0u;
    for (;;) {
        sum = 0u; cnt = 0u; mine = 0u;
#pragma unroll
        for (unsigned j = 0; j < 16; ++j) { const unsigned cj = xb_ld(&bar[XB_XCNT(j)]); sum += cj; cnt += (cj > 0u) ? 1u : 0u; mine = (j == x) ? cj : mine; }
        if (sum == G) break;
        __builtin_amdgcn_s_sleep(1);
        if ((++sp & 255u) == 0u) { if (xb_ld(&bar[XB_TMO])) break; if (sp > XB_SPIN_CAP) { atomicAdd(&bar[XB_TMO], 1u); break; } }
    }
    nloc = mine > 0u ? mine : 1u; nx = cnt > 0u ? cnt : 1u;
}
__device__ __forceinline__ void xcd_barrier(const XcdBarrier& b) {
    asm volatile("s_waitcnt vmcnt(0)" ::: "memory");
    __syncthreads();
    if (threadIdx.x == 0) {
        unsigned* bar = b.bar;
        __builtin_amdgcn_s_waitcnt(0);
        unsigned nloc = b.st[0], nx = b.st[1];
        if (nloc == 0u) { xcd_barrier_complete(bar, b.x, nloc, nx); b.st[0] = nloc; b.st[1] = nx; }
        const unsigned old = xb_add(&bar[XB_XSUB(b.x)], 1u);
        const unsigned gen = old / nloc;
        if (old + 1u == (gen + 1u) * nloc) {
            __builtin_amdgcn_fence(__ATOMIC_RELEASE, "agent");
            asm volatile("s_waitcnt vmcnt(0)" ::: "memory");
            const unsigned og = xb_add(&bar[XB_TOP], 1u);
            const unsigned tg = og / nx;
            if (og + 1u == (tg + 1u) * nx) xb_add(&bar[XB_TOPGEN], 1u);
            else XB_SPIN(xb_ld(&bar[XB_TOPGEN]) == tg, bar);
            __builtin_amdgcn_fence(__ATOMIC_ACQUIRE, "agent");
            xb_add(&bar[XB_XGEN(b.x)], 1u);
            asm volatile("s_waitcnt vmcnt(0)" ::: "memory");
        } else {
            XB_SPIN(xb_ld(&bar[XB_XGEN(b.x)]) == gen, bar);
            __builtin_amdgcn_fence(__ATOMIC_ACQUIRE, "agent");
            asm volatile("s_waitcnt vmcnt(0)" ::: "memory");
        }
    }
    __syncthreads();
}
#endif

#ifdef HOST_EMU
template <int PH> __device__ __forceinline__ void phases_from(const Ctx& c, int lo, int hi) {
    if constexpr (PH < N_PHASES) { if (lo <= PH && PH < hi) run_phase<PH>(c); phases_from<PH + 1>(c, lo, hi); }
}
#else
template <int PH> __device__ __forceinline__ void phases_from(const Ctx& c, int lo, int hi, const XcdBarrier& bar) {
    if constexpr (PH < N_PHASES) { if (lo <= PH && PH < hi) { run_phase<PH>(c); if (PH + 1 < hi) xcd_barrier(bar); } phases_from<PH + 1>(c, lo, hi, bar); }
}
#endif
#ifdef HOST_EMU
static void mega_body(const Params& prm) {
    unsigned char* lds_raw = emu_lds();
#else
__global__ void __launch_bounds__(NT, 2) mega_kernel(Params prm) {
    extern __shared__ __attribute__((aligned(16))) unsigned char lds_raw[];
#endif
    Ctx c; c.p = &prm; c.ws = prm.ws; c.lds = (LAS unsigned char*)lds_raw;
    c.tid = threadIdx.x; c.lane = c.tid & 63; c.wave = __builtin_amdgcn_readfirstlane(c.tid >> 6);
    c.G = gridDim.x; c.bx = blockIdx.x; c.gw = c.bx * NWAVES + c.wave; c.NGW = c.G * NWAVES; c.gt = c.bx * NT + c.tid; c.NGT = c.G * NT;
#ifndef HOST_EMU
    volatile LAS unsigned* misc = (volatile LAS unsigned*)(c.lds + LDS_MISC);
    if (c.tid < 16) misc[c.tid] = 0u;
    __syncthreads();
    XcdBarrier bar; bar.bar = (unsigned*)(c.ws + WS_CTL) + 4096; bar.x = 0; bar.st = nullptr;
    const bool multi = prm.ph_hi - prm.ph_lo > 1;
    if (multi) bar = xcd_barrier_post((unsigned*)(c.ws + WS_CTL) + 4096, misc + 8);
#endif
    phases_from<0>(c, prm.ph_lo, prm.ph_hi
#ifndef HOST_EMU
        , bar
#endif
        );
}

#ifndef HOST_EMU
#ifndef MK_PER_PHASE
#define MK_PER_PHASE 0
#endif
extern "C" void kernel_launch(void* const* d_in, const int* in_sizes, int n_in, void* d_out, int out_size, void* d_ws, size_t ws_size, hipStream_t stream) {
    static int grid = 0;
    if (grid == 0) {
        if (n_in != N_IN || out_size != MLAT * DM || ws_size < WS_END) { fprintf(stderr, "kernel_launch: unexpected shapes (n_in %d out %d ws %zu need %zu)\n", n_in, out_size, ws_size, (size_t)WS_END); grid = -1; return; }
        int dev = 0, cus = 0, per_cu = 0;
        if (hipGetDevice(&dev) != hipSuccess || hipDeviceGetAttribute(&cus, hipDeviceAttributeMultiprocessorCount, dev) != hipSuccess) { grid = -1; return; }
        if (hipFuncSetAttribute((const void*)mega_kernel, hipFuncAttributeMaxDynamicSharedMemorySize, LDS_BYTES) != hipSuccess) { fprintf(stderr, "kernel_launch: hipFuncSetAttribute failed\n"); grid = -1; return; }
        if (hipOccupancyMaxActiveBlocksPerMultiprocessor(&per_cu, (const void*)mega_kernel, NT, LDS_BYTES) != hipSuccess || per_cu < 1) fprintf(stderr, "kernel_launch: occupancy query says %d\n", per_cu);
        (void)hipGetLastError();
        grid = cus;
    }
    if (grid < 0) return;
    (void)hipMemsetAsync((char*)d_ws + WS_CTL, 0, CTL_ZERO_BYTES, stream);
    Params p{};
    for (int i = 0; i < N_IN; ++i) p.in[i] = (const float*)d_in[i];
    p.out = (float*)d_out; p.ws = (unsigned char*)d_ws;
#if MK_PER_PHASE
    for (int ph = 0; ph < N_PHASES; ++ph) { p.ph_lo = ph; p.ph_hi = ph + 1; hipLaunchKernelGGL(mega_kernel, dim3(grid), dim3(NT), LDS_BYTES, stream, p); }
#else
    p.ph_lo = 0; p.ph_hi = N_PHASES; hipLaunchKernelGGL(mega_kernel, dim3(grid), dim3(NT), LDS_BYTES, stream, p);
#endif
}
#endif
```
